# Optimizing an MI355X kernel written in HIP

```python
import math
import jax, jax.numpy as jnp
from jax import lax
import numpy as np

D_MODEL = 1024
BATCH = 16
SEQ = 4096
DEPTH = 4

N_MIXERS = 2
N_ATTN_LAYERS = (DEPTH + 1) // 2
N_POOL_LAYERS = DEPTH // 2
EPS = 1e-6
HEAD_DIM = 64
N_HEADS = D_MODEL // (2 * HEAD_DIM)
ATTN_WIDTH = N_HEADS * 2 * HEAD_DIM
Q_BLOCK = 128
NUM_BUCKETS = 32
MAX_EXACT = NUM_BUCKETS // 2
MAX_DISTANCE = 128
POOL_WINDOWS = (2, 4, 8, 16)
N_POOL_GROUPS = len(POOL_WINDOWS)
GROUP_WIDTH = D_MODEL // N_POOL_GROUPS
N_EXPERT_GROUPS = 4
EXPERTS_PER_GROUP = 8
N_EXPERTS = N_EXPERT_GROUPS * EXPERTS_PER_GROUP
TOP_K = 2
EXPERT_FF = D_MODEL // 2
EXPERT_BLOCK = 128

kernel_name = "hybrid_diffattn_pool_hmoe"


def rms_norm(x, gain):
    xf = x.astype(jnp.float32)
    y = xf * lax.rsqrt(jnp.mean(xf * xf, axis=-1, keepdims=True) + EPS)
    return (y * gain.astype(jnp.float32)).astype(x.dtype)


def rel_bucket(dist):
    n = jnp.maximum(dist, 0)
    nf = jnp.maximum(n, 1).astype(jnp.float32)
    large = MAX_EXACT + (jnp.log(nf / MAX_EXACT) / math.log(MAX_DISTANCE / MAX_EXACT)
                         * (NUM_BUCKETS - MAX_EXACT)).astype(jnp.int32)
    large = jnp.minimum(large, NUM_BUCKETS - 1)
    return jnp.where(n < MAX_EXACT, n, large)


def diff_attention(h, w_qkv, q_gain, k_gain, lq1, lk1, lq2, lk2, subln_gain, w_o, rel_bias, lambda_init):
    B, S, _ = h.shape
    qkv = h @ w_qkv
    q, k, v = jnp.split(qkv, 3, axis=-1)
    q = rms_norm(q.reshape(B, S, N_HEADS, 2, HEAD_DIM), q_gain) * (HEAD_DIM ** -0.5)
    k = rms_norm(k.reshape(B, S, N_HEADS, 2, HEAD_DIM), k_gain)
    v = v.reshape(B, S, N_HEADS, 2 * HEAD_DIM)
    lam = (jnp.exp(jnp.sum(lq1.astype(jnp.float32) * lk1.astype(jnp.float32)))
           - jnp.exp(jnp.sum(lq2.astype(jnp.float32) * lk2.astype(jnp.float32))) + lambda_init)
    n_blk = S // Q_BLOCK
    qb = q.reshape(B, n_blk, Q_BLOCK, N_HEADS, 2, HEAD_DIM).transpose(1, 0, 2, 3, 4, 5)
    k_pos = jnp.arange(S)

    def one_block(args):
        qi, bi = args
        q_pos = bi * Q_BLOCK + jnp.arange(Q_BLOCK)
        dist = q_pos[:, None] - k_pos[None, :]
        bias = rel_bias.astype(jnp.float32)[rel_bucket(dist)].transpose(2, 0, 1)
        logits = jnp.einsum('bqhcd,bkhcd->bhcqk', qi, k).astype(jnp.float32) + bias[None, :, None]
        logits = jnp.where((dist >= 0)[None, None, None], logits, -jnp.inf)
        p = jax.nn.softmax(logits, axis=-1)
        a = p[:, :, 0] - lam * p[:, :, 1]
        return jnp.einsum('bhqk,bkhe->bqhe', a.astype(v.dtype), v)

    o = lax.map(one_block, (qb, jnp.arange(n_blk)))
    o = o.transpose(1, 0, 2, 3, 4).reshape(B, S, N_HEADS, 2 * HEAD_DIM)
    o = rms_norm(o, subln_gain) * (1.0 - lambda_init)
    return o.reshape(B, S, ATTN_WIDTH) @ w_o


def multiscale_pool(h, w_in, w_group, w_out, scale):
    B, S, _ = h.shape
    u = (h @ w_in).reshape(B, S, N_POOL_GROUPS, GROUP_WIDTH)
    uf = u.astype(jnp.float32)
    csum = jnp.cumsum(uf, axis=1)
    pos1 = jnp.arange(1, S + 1)
    outs = []
    for g, w in enumerate(POOL_WINDOWS):
        c = csum[:, :, g]
        shifted = jnp.pad(c, ((0, 0), (w, 0), (0, 0)))[:, :S]
        cnt = jnp.minimum(pos1, w).astype(jnp.float32)[None, :, None]
        outs.append((c - shifted) / cnt - uf[:, :, g])
    pooled = jnp.stack(outs, axis=2).astype(h.dtype)
    mixed = jnp.einsum('bsgc,gce->bsge', pooled, w_group).reshape(B, S, D_MODEL)
    return (mixed @ w_out) * scale


def routed_experts(xf, expert, weight, w_gate, w_up, w_down):
    T, D = xf.shape
    A = T * TOP_K
    e_flat = expert.reshape(A)
    tok = jnp.arange(A, dtype=jnp.int32) // TOP_K
    wt = weight.reshape(A)
    order = jnp.argsort(e_flat)
    e_sorted = e_flat[order]
    counts = jnp.bincount(e_flat, length=N_EXPERTS)
    padded = (counts + EXPERT_BLOCK - 1) // EXPERT_BLOCK * EXPERT_BLOCK
    pad_end = jnp.cumsum(padded)
    pad_start = pad_end - padded
    start = jnp.cumsum(counts) - counts
    dest = pad_start[e_sorted] + jnp.arange(A) - start[e_sorted]
    n_blocks = -(-A // EXPERT_BLOCK) + N_EXPERTS
    P = n_blocks * EXPERT_BLOCK
    slot_tok = jnp.full((P,), T, jnp.int32).at[dest].set(tok[order])
    slot_w = jnp.zeros((P,), jnp.float32).at[dest].set(wt[order])
    block_expert = jnp.minimum(
        jnp.searchsorted(pad_end, jnp.arange(n_blocks) * EXPERT_BLOCK, side='right'), N_EXPERTS - 1)
    x_pad = jnp.concatenate([xf, jnp.zeros((1, D), xf.dtype)], axis=0)
    xb = x_pad[slot_tok].reshape(n_blocks, EXPERT_BLOCK, D)

    def expert_block(args):
        xe, e = args
        return (jax.nn.silu(xe @ w_gate[e]) * (xe @ w_up[e])) @ w_down[e]

    yb = lax.map(expert_block, (xb, block_expert)).reshape(P, D)
    out = jnp.zeros((T + 1, D), jnp.float32).at[slot_tok].add(yb.astype(jnp.float32) * slot_w[:, None])
    return out[:T].astype(xf.dtype)


def hier_moe(h, wg1, bg1, wg2, bg2, w_gate, w_up, w_down):
    B, S, D = h.shape
    T = B * S
    xf = h.reshape(T, D)
    g_prob = jax.nn.softmax((xf @ wg1).astype(jnp.float32) + bg1.astype(jnp.float32), axis=-1)
    gp, gidx = lax.top_k(g_prob, 1)
    e_logit = ((xf @ wg2).astype(jnp.float32) + bg2.astype(jnp.float32)).reshape(T, N_EXPERT_GROUPS, EXPERTS_PER_GROUP)
    e_sel = jnp.take_along_axis(e_logit, gidx[:, :, None], axis=1)[:, 0]
    ev, eidx = lax.top_k(e_sel, TOP_K)
    weight = jax.nn.softmax(ev, axis=-1) * gp
    expert = gidx * EXPERTS_PER_GROUP + eidx
    return routed_experts(xf, expert, weight, w_gate, w_up, w_down).reshape(B, S, D)


def setup_inputs(seed: int = 0) -> dict:
    key = jax.random.key(seed)
    ks = jax.random.split(key, 32)
    f32 = jnp.float32
    nrm = lambda k, shp, s: jax.random.normal(k, shp, f32) * s
    nA, nP, L = N_ATTN_LAYERS, N_POOL_LAYERS, DEPTH
    return {
        "x": nrm(ks[0], (BATCH, SEQ, D_MODEL), 1.0),
        "rel_bias": nrm(ks[1], (NUM_BUCKETS, N_HEADS), 0.5),
        "attn_norm": 1.0 + nrm(ks[2], (nA, D_MODEL), 0.05),
        "w_qkv": nrm(ks[3], (nA, D_MODEL, 3 * ATTN_WIDTH), D_MODEL ** -0.5),
        "q_gain": 1.0 + nrm(ks[4], (nA, HEAD_DIM), 0.05),
        "k_gain": 1.0 + nrm(ks[5], (nA, HEAD_DIM), 0.05),
        "lambda_q1": nrm(ks[6], (nA, HEAD_DIM), 0.1),
        "lambda_k1": nrm(ks[7], (nA, HEAD_DIM), 0.1),
        "lambda_q2": nrm(ks[8], (nA, HEAD_DIM), 0.1),
        "lambda_k2": nrm(ks[9], (nA, HEAD_DIM), 0.1),
        "subln_gain": 1.0 + nrm(ks[10], (nA, 2 * HEAD_DIM), 0.05),
        "w_o": nrm(ks[11], (nA, ATTN_WIDTH, D_MODEL), ATTN_WIDTH ** -0.5),
        "pool_norm": 1.0 + nrm(ks[12], (nP, D_MODEL), 0.05),
        "pool_w_in": nrm(ks[13], (nP, D_MODEL, D_MODEL), D_MODEL ** -0.5),
        "pool_w_group": nrm(ks[14], (nP, N_POOL_GROUPS, GROUP_WIDTH, GROUP_WIDTH), GROUP_WIDTH ** -0.5),
        "pool_w_out": nrm(ks[15], (nP, D_MODEL, D_MODEL), D_MODEL ** -0.5),
        "pool_scale": 1.0 + nrm(ks[16], (nP, D_MODEL), 0.1),
        "ffn_norm": 1.0 + nrm(ks[17], (L, D_MODEL), 0.05),
        "router_group_w": nrm(ks[18], (L, D_MODEL, N_EXPERT_GROUPS), D_MODEL ** -0.5),
        "router_group_b": nrm(ks[19], (L, N_EXPERT_GROUPS), 0.01),
        "router_expert_w": nrm(ks[20], (L, D_MODEL, N_EXPERTS), D_MODEL ** -0.5),
        "router_expert_b": nrm(ks[21], (L, N_EXPERTS), 0.01),
        "w_gate": nrm(ks[22], (L, N_EXPERTS, D_MODEL, EXPERT_FF), D_MODEL ** -0.5),
        "w_up": nrm(ks[23], (L, N_EXPERTS, D_MODEL, EXPERT_FF), D_MODEL ** -0.5),
        "w_down": nrm(ks[24], (L, N_EXPERTS, EXPERT_FF, D_MODEL), EXPERT_FF ** -0.5),
    }


def reference(x, rel_bias, attn_norm, w_qkv, q_gain, k_gain, lambda_q1, lambda_k1, lambda_q2, lambda_k2,
              subln_gain, w_o, pool_norm, pool_w_in, pool_w_group, pool_w_out, pool_scale,
              ffn_norm, router_group_w, router_group_b, router_expert_w, router_expert_b,
              w_gate, w_up, w_down):
    for i in range(DEPTH):
        j = i // N_MIXERS
        if i % N_MIXERS == 0:
            lambda_init = 0.8 - 0.6 * math.exp(-0.3 * i)
            h = rms_norm(x, attn_norm[j])
            x = x + diff_attention(h, w_qkv[j], q_gain[j], k_gain[j], lambda_q1[j], lambda_k1[j],
                                   lambda_q2[j], lambda_k2[j], subln_gain[j], w_o[j], rel_bias, lambda_init)
        else:
            h = rms_norm(x, pool_norm[j])
            x = x + multiscale_pool(h, pool_w_in[j], pool_w_group[j], pool_w_out[j], pool_scale[j])
        h = rms_norm(x, ffn_norm[i])
        x = x + hier_moe(h, router_group_w[i], router_group_b[i], router_expert_w[i], router_expert_b[i],
                         w_gate[i], w_up[i], w_down[i])
    return x
```

```cpp
#include <hip/hip_runtime.h>
#include <cstdio>
#include <cstdint>

#define GAS __attribute__((address_space(1)))
#define LAS __attribute__((address_space(3)))
typedef unsigned short bf16_t;
typedef short bf16x8 __attribute__((ext_vector_type(8)));
typedef short s16x4 __attribute__((ext_vector_type(4)));
typedef float f32x2 __attribute__((ext_vector_type(2)));
typedef float f32x4 __attribute__((ext_vector_type(4)));
typedef float f32x16 __attribute__((ext_vector_type(16)));
typedef unsigned u32x2 __attribute__((ext_vector_type(2)));
typedef unsigned u32x4 __attribute__((ext_vector_type(4)));
typedef int i32x8 __attribute__((ext_vector_type(8)));
typedef __bf16 bf16x2_t __attribute__((ext_vector_type(2)));

constexpr int NB = 16, SEQ = 4096, DM = 1024, NTOK = NB * SEQ, DEPTH = 4;
constexpr int NHEAD = 8, HD = 64;
constexpr int NEXP = 32, EPG = 8, NGRP = 4, EFF = 512;
constexpr int MAXSLOT = 139264;
constexpr float EPS = 1e-6f;
constexpr float LOG2E = 1.4426950408889634f;
constexpr int NWAVES = 8, NTHREADS = 512;

constexpr size_t MiB = 1u << 20;
constexpr size_t WS_CTL = 0, CTL_ZERO_BYTES = 1 * MiB;
constexpr size_t WS_RSMIX = 4 * MiB;
constexpr size_t WS_RSFFN = WS_RSMIX + 256 * 1024;
constexpr size_t WS_TOKE = WS_RSFFN + 256 * 1024;
constexpr size_t WS_TOKW = WS_TOKE + 512 * 1024;
constexpr size_t WS_TOKS = WS_TOKW + 512 * 1024;
constexpr size_t WS_SLOTTOK = WS_TOKS + 512 * 1024;
constexpr size_t WS_SLOTRS = WS_SLOTTOK + 576 * 1024;
constexpr size_t WS_CNT = WS_SLOTRS + 576 * 1024;
constexpr size_t WS_RWT = WS_CNT + 64 * 1024;
constexpr size_t WS_RWG = WS_RWT + 512 * 1024;
constexpr size_t WS_SMALL_END = WS_RWG + 64 * 1024;
static_assert(WS_SMALL_END <= 16 * MiB, "small arrays");
constexpr size_t WS_WQKV = 16 * MiB;
constexpr size_t WS_WO = WS_WQKV + 12 * MiB;
constexpr size_t WS_WPC = WS_WO + 4 * MiB;
constexpr size_t WS_WPO = WS_WPC + 4 * MiB;
constexpr size_t WS_WGU = WS_WPO + 4 * MiB;
constexpr size_t WS_WDN = WS_WGU + 256 * MiB;
constexpr size_t WS_XB = WS_WDN + 128 * MiB;
constexpr size_t WS_ACT = WS_XB + 128 * MiB;
constexpr size_t WS_END = WS_ACT + 408 * MiB;
static_assert(WS_END <= 1126807104ull, "d_ws map exceeds the guaranteed workspace");
constexpr float A8_SCALE = 8.f, WN8_SCALE = 64.f;
constexpr size_t ACT_Q = 0, ACT_K = 128 * MiB, ACT_V = 256 * MiB;
constexpr size_t ACT_U = 0, ACT_P = 128 * MiB;
constexpr size_t ACT_H = 0, ACT_Y = 136 * MiB, ACT_X8 = 288 * MiB;
constexpr int CW_BAR = 4096;
constexpr int CW_TILES = 16384;

constexpr int RING_BYTES = 131072;
constexpr int LUT_OFF = RING_BYTES;
constexpr int LUT_N = 336;
constexpr int MISC_OFF = LUT_OFF + NHEAD * LUT_N * 4;
constexpr int TS_OFF = MISC_OFF + 256;
constexpr int LDS_BYTES = 147456;
static_assert(TS_OFF + 256 <= LDS_BYTES, "LDS map");

#define RLX_AGENT __ATOMIC_RELAXED, __HIP_MEMORY_SCOPE_AGENT
__device__ __forceinline__ unsigned cvtpk(float lo, float hi) { f32x2 v = {lo, hi}; bf16x2_t b = __builtin_convertvector(v, bf16x2_t); return __builtin_bit_cast(unsigned, b); }
__device__ __forceinline__ float bf2f(unsigned short h) { return __builtin_bit_cast(float, (unsigned)h << 16); }
__device__ __forceinline__ float wave_sum(float v) {
#pragma unroll
    for (int o = 1; o < 64; o <<= 1) v += __shfl_xor(v, o);
    return v;
}

__device__ __forceinline__ int opaque_tid() { int t = threadIdx.x; asm volatile("" : "+v"(t)); return t; }

#define XB_TMO      128
#define XB_XCNT(j)  (256  + 64 * (j))
#define XB_XSUB(j)  (1280 + 64 * (j))
#define XB_XGEN(j)  (2304 + 64 * (j))
#define XB_TOP      3328
#define XB_TOPGEN   3392
#define XCD_BAR_WORDS 3456
#define XB_SPIN_CAP (1u << 18)
__device__ __forceinline__ unsigned xb_ld(unsigned* p)              { return __hip_atomic_load(p, __ATOMIC_RELAXED, __HIP_MEMORY_SCOPE_AGENT); }
__device__ __forceinline__ unsigned xb_add(unsigned* p, unsigned v) { return __hip_atomic_fetch_add(p, v, __ATOMIC_RELAXED, __HIP_MEMORY_SCOPE_AGENT); }
__device__ __forceinline__ unsigned xb_xcc_id() { return (unsigned)__builtin_amdgcn_s_getreg((3 << 11) | 20) & 0xFu; }
#define XB_SPIN(cond, bar) do { unsigned _sp = 0; while (cond) { __builtin_amdgcn_s_sleep(1); \
    if ((++_sp & 255u) == 0u) { if (xb_ld(&(bar)[XB_TMO])) break; if (_sp > XB_SPIN_CAP) { atomicAdd(&(bar)[XB_TMO], 1u); break; } } } } while (0)
struct XcdBarrier { unsigned* bar; unsigned x; volatile LAS unsigned* st; };
__device__ __forceinline__ XcdBarrier xcd_barrier_post(unsigned* bar, volatile LAS unsigned* st) {
    XcdBarrier b; b.bar = bar; b.x = xb_xcc_id(); b.st = st;
    if (threadIdx.x == 0) (void)xb_add(&bar[XB_XCNT(b.x)], 1u);
    return b;
}
__device__ __forceinline__ void xcd_barrier_complete(unsigned* bar, unsigned x, unsigned& nloc, unsigned& nx) {
    const unsigned G = gridDim.x * gridDim.y * gridDim.z;
    unsigned sum, cnt, mine, sp = 0u;
    for (;;) {
        sum = 0u; cnt = 0u; mine = 0u;
#pragma unroll
        for (unsigned j = 0; j < 16; ++j) { const unsigned c = xb_ld(&bar[XB_XCNT(j)]); sum += c; cnt += (c > 0u) ? 1u : 0u; mine = (j == x) ? c : mine; }
        if (sum == G) break;
        __builtin_amdgcn_s_sleep(1);
        if ((++sp & 255u) == 0u) { if (xb_ld(&bar[XB_TMO])) break; if (sp > XB_SPIN_CAP) { atomicAdd(&bar[XB_TMO], 1u); break; } }
    }
    nloc = mine > 0u ? mine : 1u; nx = cnt > 0u ? cnt : 1u;
}
__device__ __forceinline__ void xcd_barrier(const XcdBarrier& b) {
    asm volatile("s_waitcnt vmcnt(0)" ::: "memory");
    __syncthreads();
    if (threadIdx.x == 0) {
        unsigned* bar = b.bar;
        __builtin_amdgcn_s_waitcnt(0);
        unsigned nloc = b.st[0], nx = b.st[1];
        if (nloc == 0u) { xcd_barrier_complete(bar, b.x, nloc, nx); b.st[0] = nloc; b.st[1] = nx; }
        const unsigned old = xb_add(&bar[XB_XSUB(b.x)], 1u);
        const unsigned gen = old / nloc;
        if (old + 1u == (gen + 1u) * nloc) {
            __builtin_amdgcn_fence(__ATOMIC_RELEASE, "agent");
            asm volatile("s_waitcnt vmcnt(0)" ::: "memory");
            const unsigned og = xb_add(&bar[XB_TOP], 1u);
            const unsigned tg = og / nx;
            if (og + 1u == (tg + 1u) * nx) xb_add(&bar[XB_TOPGEN], 1u);
            else XB_SPIN(xb_ld(&bar[XB_TOPGEN]) == tg, bar);
            __builtin_amdgcn_fence(__ATOMIC_ACQUIRE, "agent");
            xb_add(&bar[XB_XGEN(b.x)], 1u);
            asm volatile("s_waitcnt vmcnt(0)" ::: "memory");
        } else {
            XB_SPIN(xb_ld(&bar[XB_XGEN(b.x)]) == gen, bar);
            __builtin_amdgcn_fence(__ATOMIC_ACQUIRE, "agent");
            asm volatile("s_waitcnt vmcnt(0)" ::: "memory");
        }
    }
    __syncthreads();
}

namespace pg8 {
constexpr int BM = 256, BK = 64, HALF = 128, HTB = HALF * BK * 2, STAGE_BYTES = 8 * HTB;
__host__ __device__ __forceinline__ int lds_byte(int r, int c) { const int st = (r >> 4) * 2 + (c >> 5), rr = r & 15, cc = c & 31, ob = rr * 64 + cc * 2; return st * 1024 + (ob ^ (((ob >> 9) & 1) << 5)); }
__host__ __device__ __forceinline__ void stage_rc(int b, int& R, int& C) { const int st = b / 1024, sb = b % 1024, swz = sb ^ (((sb >> 9) & 1) << 5); R = (st >> 1) * 16 + swz / 64; C = (st & 1) * 32 + (swz % 64) / 2; }
__host__ __device__ __forceinline__ int perm32(int rho) { const int n = rho >> 4, i = rho & 15; return 8 * (i >> 2) + 4 * n + (i & 3); }
struct Unit { int pm, pn, e; };

template <class Epi, class Sched, bool ALIGN_EPI, bool FP8 = false>
__device__ __forceinline__ void gemm_phase(LAS unsigned char* lds, const int K, const Sched& S, const Epi& E) {
    const int tid = opaque_tid(), wid = __builtin_amdgcn_readfirstlane(tid >> 6), lane = tid & 63, wr = wid >> 2, wc = wid & 3, fr = lane & 15, fq = lane >> 4;
    const int nt = FP8 ? K / 128 : K / BK;
    int RA[2], CA[2]; unsigned voffB[2];
#pragma unroll
    for (int i = 0; i < 2; ++i) { int R, C; stage_rc(tid * 16 + i * 8192, R, C); RA[i] = R; CA[i] = C * 2;
        voffB[i] = (unsigned)(tid * 16 + i * 8192); }
    const size_t kstep = (size_t)(BK * 2);
    const size_t hstepB = 16384, kstepB = 32768;
    const unsigned ldsw = (unsigned)wid * 1024u;
    const int aoff = lds_byte(wr * 64 + fr, fq * 8), boff = lds_byte(wc * 32 + fr, fq * 8);
    const int aoff8 = lds_byte(wr * 64 + fr, fq * 16), boff8 = lds_byte(wc * 32 + fr, fq * 16);
#define PG8_SA(b, h) (((b) * 2 + (h)) * HTB)
#define PG8_SB(b, h) ((4 + (b) * 2 + (h)) * HTB)
#define PG8_STAGE(bufoff, gbase, v0, v1) do { const char* gb_ = (const char*)(gbase); unsigned v0_ = (v0), v1_ = (v1); asm volatile("" : "+s"(gb_), "+v"(v0_), "+v"(v1_)); \
        __builtin_amdgcn_global_load_lds((const unsigned*)(gb_ + v0_), (LAS unsigned*)(lds + (bufoff) + ldsw), 16, 0, 0); \
        __builtin_amdgcn_global_load_lds((const unsigned*)(gb_ + v1_), (LAS unsigned*)(lds + (bufoff) + ldsw + 8192), 16, 0, 0); } while (0)
#define PG8_STAGEA(bufoff, gbase, V, h) PG8_STAGE(bufoff, gbase, V[h][0], V[h][1])
#define PG8_STAGEB(bufoff, gbase) PG8_STAGE(bufoff, gbase, voffB[0], voffB[1])
#define PG8_LDA(dst, b, h) do { if constexpr (FP8) { _Pragma("unroll") for (int m = 0; m < 4; ++m) { const u32x4 l_ = *(const LAS u32x4*)(lds + PG8_SA(b, h) + aoff8 + m * 2048), h_ = *(const LAS u32x4*)(lds + PG8_SA(b, h) + aoff8 + m * 2048 + 16); \
            dst##8[m] = (i32x8){(int)l_.x, (int)l_.y, (int)l_.z, (int)l_.w, (int)h_.x, (int)h_.y, (int)h_.z, (int)h_.w}; } } \
        else { _Pragma("unroll") for (int m = 0; m < 4; ++m) _Pragma("unroll") for (int k = 0; k < 2; ++k) dst[m][k] = *(const LAS bf16x8*)(lds + PG8_SA(b, h) + aoff + m * 2048 + k * 1024); } } while (0)
#define PG8_LDB(dst, b, h) do { if constexpr (FP8) { _Pragma("unroll") for (int n = 0; n < 2; ++n) { const u32x4 l_ = *(const LAS u32x4*)(lds + PG8_SB(b, h) + boff8 + n * 2048), h_ = *(const LAS u32x4*)(lds + PG8_SB(b, h) + boff8 + n * 2048 + 16); \
            dst##8[n] = (i32x8){(int)l_.x, (int)l_.y, (int)l_.z, (int)l_.w, (int)h_.x, (int)h_.y, (int)h_.z, (int)h_.w}; } } \
        else { _Pragma("unroll") for (int n = 0; n < 2; ++n) _Pragma("unroll") for (int k = 0; k < 2; ++k) dst[n][k] = *(const LAS bf16x8*)(lds + PG8_SB(b, h) + boff + n * 2048 + k * 1024); } } while (0)
#define PG8_MMA(ai, bj, At, Bt) do { __builtin_amdgcn_s_setprio(1); \
        if constexpr (FP8) { _Pragma("unroll") for (int m = 0; m < 4; ++m) _Pragma("unroll") for (int n = 0; n < 2; ++n) \
            acc[ai][bj][m][n] = __builtin_amdgcn_mfma_scale_f32_16x16x128_f8f6f4(Bt##8[n], At##8[m], acc[ai][bj][m][n], 0, 0, 0, 0x7f7f7f7f, 0, 0x7f7f7f7f); } \
        else { _Pragma("unroll") for (int m = 0; m < 4; ++m) _Pragma("unroll") for (int n = 0; n < 2; ++n) _Pragma("unroll") for (int k = 0; k < 2; ++k) \
            acc[ai][bj][m][n] = __builtin_amdgcn_mfma_f32_16x16x32_bf16(Bt[n][k], At[m][k], acc[ai][bj][m][n], 0, 0, 0); } \
        __builtin_amdgcn_s_setprio(0); } while (0)
#define PG8_WAIT_V(n) asm volatile("s_waitcnt vmcnt(" #n ")" ::: "memory")
#define PG8_WAIT_L(n) asm volatile("s_waitcnt lgkmcnt(" #n ")" ::: "memory")
#define PG8_BAR __builtin_amdgcn_s_barrier()
#define PG8_SCHED __builtin_amdgcn_sched_barrier(0)
#define PG8_SCHED8 do { if constexpr (FP8) __builtin_amdgcn_sched_barrier(0); } while (0)
    Unit cur, nxt; int ui = 0;
    if (!S.next(0, cur)) return;
    f32x4 acc[2][2][4][2];
#pragma unroll
    for (int a = 0; a < 2; ++a)
#pragma unroll
        for (int b = 0; b < 2; ++b)
#pragma unroll
            for (int m = 0; m < 4; ++m)
#pragma unroll
                for (int n = 0; n < 2; ++n) acc[a][b][m][n] = (f32x4){0.f, 0.f, 0.f, 0.f};
    bf16x8 At[4][2], B0[2][2], B1[2][2]; i32x8 At8[4], B08[2], B18[2];
    const char* const Ab = S.a_base();
    unsigned cvA[2][2];
#pragma unroll
    for (int h = 0; h < 2; ++h)
#pragma unroll
        for (int i = 0; i < 2; ++i) cvA[h][i] = S.a_row_off(cur, h * HALF + RA[i]) + (unsigned)CA[i];
    const char* cB = S.b_base(cur);
    PG8_STAGEB(PG8_SB(0, 0), cB); PG8_STAGEB(PG8_SB(0, 1), cB + hstepB); PG8_STAGEA(PG8_SA(0, 0), Ab, cvA, 0); PG8_STAGEA(PG8_SA(0, 1), Ab, cvA, 1);
    if (wr == 1) PG8_BAR;
    PG8_WAIT_V(2); PG8_BAR;
    PG8_STAGEB(PG8_SB(1, 0), cB + kstepB); PG8_STAGEA(PG8_SA(1, 0), Ab + kstep, cvA, 0); PG8_STAGEB(PG8_SB(1, 1), cB + hstepB + kstepB);
    PG8_WAIT_V(6); PG8_BAR;
    for (;;) {
        const bool has_next = S.next(ui + 1, nxt);
        const char* nB = has_next ? S.b_base(nxt) : cB;
        for (int t = 0; t < nt; t += 2) {
            const bool last = (t == nt - 2);
            const char* a1 = Ab + (size_t)(t + 1) * kstep;
            const char* a2 = last ? Ab : Ab + (size_t)(t + 2) * kstep; const char* b2 = last ? nB : cB + (size_t)(t + 2) * kstepB;
            const char* a3 = a2 + kstep; const char* b3 = b2 + kstepB;
            PG8_LDB(B0, 0, 0); PG8_LDB(B1, 0, 1); PG8_SCHED; PG8_LDA(At, 0, 0); PG8_STAGEA(PG8_SA(1, 1), a1, cvA, 1);
            if (last && has_next) {
#pragma unroll
                for (int h = 0; h < 2; ++h)
#pragma unroll
                    for (int i = 0; i < 2; ++i) cvA[h][i] = S.a_row_off(nxt, h * HALF + RA[i]) + (unsigned)CA[i]; }
            PG8_WAIT_V(8); PG8_WAIT_L(0); PG8_BAR; PG8_SCHED8; PG8_MMA(0, 0, At, B0); PG8_MMA(0, 1, At, B1); PG8_SCHED8; PG8_BAR; PG8_SCHED;
            PG8_LDA(At, 0, 1); PG8_STAGEB(PG8_SB(0, 0), b2); PG8_STAGEB(PG8_SB(0, 1), b2 + hstepB); PG8_STAGEA(PG8_SA(0, 0), a2, cvA, 0);
            PG8_WAIT_V(8); PG8_WAIT_L(0); PG8_BAR; PG8_SCHED8; PG8_MMA(1, 0, At, B0); PG8_MMA(1, 1, At, B1); PG8_SCHED8; PG8_BAR; PG8_SCHED;
            PG8_LDB(B0, 1, 0); PG8_LDB(B1, 1, 1); PG8_SCHED; PG8_LDA(At, 1, 0); PG8_STAGEA(PG8_SA(0, 1), a2, cvA, 1);
            PG8_WAIT_V(8); PG8_WAIT_L(0); PG8_BAR; PG8_SCHED8; PG8_MMA(0, 0, At, B0); PG8_MMA(0, 1, At, B1); PG8_SCHED8; PG8_BAR; PG8_SCHED;
            PG8_LDA(At, 1, 1); PG8_STAGEB(PG8_SB(1, 0), b3); PG8_STAGEB(PG8_SB(1, 1), b3 + hstepB); PG8_STAGEA(PG8_SA(1, 0), a3, cvA, 0);
            PG8_WAIT_V(8); PG8_WAIT_L(0); PG8_BAR; PG8_SCHED8; PG8_MMA(1, 0, At, B0); PG8_MMA(1, 1, At, B1); PG8_SCHED8; PG8_BAR; PG8_SCHED;
        }
        if constexpr (ALIGN_EPI) { if (wr == 0) PG8_BAR; }
        E(acc, cur, wr, wc, fr, fq);
        if (!has_next) break;
#pragma unroll
        for (int a = 0; a < 2; ++a)
#pragma unroll
            for (int b = 0; b < 2; ++b)
#pragma unroll
                for (int m = 0; m < 4; ++m)
#pragma unroll
                    for (int n = 0; n < 2; ++n) acc[a][b][m][n] = (f32x4){0.f, 0.f, 0.f, 0.f};
        cur = nxt; cB = nB; ++ui;
        if constexpr (ALIGN_EPI) { if (wr == 1) PG8_BAR; }
    }
    PG8_WAIT_V(0);
    if constexpr (!ALIGN_EPI) { if (wr == 0) PG8_BAR; }
    PG8_BAR;
#undef PG8_SA
#undef PG8_SB
#undef PG8_STAGE
#undef PG8_STAGEA
#undef PG8_STAGEB
#undef PG8_LDA
#undef PG8_LDB
#undef PG8_MMA
#undef PG8_WAIT_V
#undef PG8_WAIT_L
#undef PG8_BAR
#undef PG8_SCHED
#undef PG8_SCHED8
}
}

struct SchedBase { int x, j, G8, NGp; __device__ __forceinline__ void init_grid() { const int G = gridDim.x, bx = blockIdx.x; if (G % 8 == 0) { NGp = 8; x = bx % 8; j = bx / 8; G8 = G / 8; } else { NGp = 1; x = 0; j = bx; G8 = G; } } };
struct PlainSched : SchedBase {
    const char* A; unsigned lda; const char* Bt; int K, nN, nrt;
    __device__ __forceinline__ bool next(int i, pg8::Unit& u) const { const int U = i * G8 + j, nrtg = (nrt - x + NGp - 1) / NGp; if (U >= nrtg * nN) return false; const int q = U / nN; u.pn = U - q * nN; u.pm = x + NGp * q; return true; }
    __device__ __forceinline__ const char* a_base() const { return A; }
    __device__ __forceinline__ unsigned a_row_off(const pg8::Unit& u, int r) const { return (unsigned)(u.pm * 256 + r) * lda; }
    __device__ __forceinline__ const char* b_base(const pg8::Unit& u) const { return Bt + (size_t)u.pn * 256 * K * 2; }
};
struct GroupSched : SchedBase {
    const char* A; unsigned lda; const int* slot_tok; const char* Bt; size_t strideE; int K; const LAS int* ts;
    __device__ __forceinline__ bool next(int i, pg8::Unit& u) const {
        const int U = i * G8 + j; int q = U >> 2; u.pn = U & 3;
        for (int e = x; e < NEXP; e += NGp) { const int t0 = __builtin_amdgcn_readfirstlane(ts[e]), n = __builtin_amdgcn_readfirstlane(ts[e + 1]) - t0; if (q < n) { u.pm = t0 + q; u.e = e; return true; } q -= n; }
        return false; }
    __device__ __forceinline__ const char* a_base() const { return A; }
    __device__ __forceinline__ unsigned a_row_off(const pg8::Unit& u, int r) const { int row = u.pm * 256 + r; if (slot_tok) row = slot_tok[row]; return (unsigned)row * lda; }
    __device__ __forceinline__ const char* b_base(const pg8::Unit& u) const { return Bt + (size_t)u.e * strideE + (size_t)u.pn * 256 * K * 2; }
};

typedef f32x4 Acc[2][2][4][2];
struct EpiQKV {
    bf16_t* Q; const float* rstd; const LAS float* gl;
    __device__ __forceinline__ void operator()(const Acc& acc, const pg8::Unit& u, int wr, int wc, int fr, int fq) const {
        const int part = u.pn >> 2, colp = (u.pn & 3) * 256 + wc * 64 + 8 * fq;
        bf16_t* base = Q + (size_t)part * NTOK * DM;
        const float qs = part == 0 ? 0.125f * LOG2E : 1.f;
#pragma unroll
        for (int ai = 0; ai < 2; ++ai)
#pragma unroll
            for (int m = 0; m < 4; ++m) {
                const int row = u.pm * 256 + ai * 128 + wr * 64 + m * 16 + fr;
                const float rs = rstd[row];
                float f = rs;
                if (part < 2) { float ss = 0.f;
#pragma unroll
                    for (int bj = 0; bj < 2; ++bj)
#pragma unroll
                        for (int n = 0; n < 2; ++n) { const f32x4 t = acc[ai][bj][m][n] * rs; const f32x4 t2 = t * t; ss += (t2[0] + t2[1]) + (t2[2] + t2[3]); }
                    ss += __shfl_xor(ss, 16); ss += __shfl_xor(ss, 32); f = rs * __builtin_amdgcn_rsqf(ss * (1.f / 64.f) + EPS) * qs; }
                const int hh = (u.pn & 3) * 2 + (wc >> 1), tl = (row & (SEQ - 1)) >> 6, rr = row & 63;
                const size_t tb = ((size_t)((row >> 12) * NHEAD + hh) * 64 + tl) * 8192;
#pragma unroll
                for (int bj = 0; bj < 2; ++bj) {
                    f32x4 g0 = {f, f, f, f}, g1 = g0;
                    if (part < 2) { const LAS f32x4* gp = (const LAS f32x4*)(gl + part * 64 + 32 * bj + 8 * fq); g0 = gp[0] * f; g1 = gp[1] * f; }
                    const f32x4 a = acc[ai][bj][m][0] * g0, b = acc[ai][bj][m][1] * g1;
                    u32x4 w; w.x = cvtpk(a[0], a[1]); w.y = cvtpk(a[2], a[3]); w.z = cvtpk(b[0], b[1]); w.w = cvtpk(b[2], b[3]);
                    if (part == 0) *(u32x4*)(base + (size_t)row * DM + colp + 32 * bj) = w;
                    else if (part == 1) *(u32x4*)(base + tb + ((wc & 1) * 8 + 4 * bj + fq) * 512 + rr * 8) = w;
                    else *(u32x4*)(base + tb + (2 * (wc & 1) + bj) * 2048 + rr * 32 + 8 * fq) = w; }
            }
    }
};
__device__ __forceinline__ int cvt8(float a, float b, int old, bool hi) {
    a = __builtin_amdgcn_fmed3f(a, -448.f, 448.f); b = __builtin_amdgcn_fmed3f(b, -448.f, 448.f);
    return hi ? __builtin_amdgcn_cvt_pk_fp8_f32(a, b, old, true) : __builtin_amdgcn_cvt_pk_fp8_f32(a, b, old, false);
}
struct EpiBf16 {
    bf16_t* O; int ldc; const float* rstd;
    __device__ __forceinline__ void operator()(const Acc& acc, const pg8::Unit& u, int wr, int wc, int fr, int fq) const {
        const int col = u.pn * 256 + wc * 64 + 8 * fq;
        float rsv[2][4];
#pragma unroll
        for (int ai = 0; ai < 2; ++ai)
#pragma unroll
            for (int m = 0; m < 4; ++m) rsv[ai][m] = rstd ? rstd[u.pm * 256 + ai * 128 + wr * 64 + m * 16 + fr] : 1.f;
        asm volatile("" : "+v"(rsv[0][0]), "+v"(rsv[0][1]), "+v"(rsv[0][2]), "+v"(rsv[0][3]), "+v"(rsv[1][0]), "+v"(rsv[1][1]), "+v"(rsv[1][2]), "+v"(rsv[1][3]) :: "memory");
#pragma unroll
        for (int ai = 0; ai < 2; ++ai)
#pragma unroll
            for (int m = 0; m < 4; ++m) {
                const int row = u.pm * 256 + ai * 128 + wr * 64 + m * 16 + fr;
                const float rs = rsv[ai][m];
#pragma unroll
                for (int bj = 0; bj < 2; ++bj) { const f32x4 a = acc[ai][bj][m][0] * rs, b = acc[ai][bj][m][1] * rs; u32x4 w; w.x = cvtpk(a[0], a[1]); w.y = cvtpk(a[2], a[3]); w.z = cvtpk(b[0], b[1]); w.w = cvtpk(b[2], b[3]);
                    *(u32x4*)(O + (size_t)row * ldc + col + 32 * bj) = w; }
            }
    }
};
constexpr float Y8_SCALE = 16.f;
struct EpiY8 {
    static constexpr int NSTORES = 8;
    unsigned char* Y;
    __device__ __forceinline__ void operator()(const Acc& acc, const pg8::Unit& u, int wr, int wc, int fr, int fq) const {
        const int pos = u.pn * 256 + wc * 64 + 16 * fq;
        constexpr float YS = Y8_SCALE / (16.f * 64.f);
#pragma unroll
        for (int ai = 0; ai < 2; ++ai)
#pragma unroll
            for (int m = 0; m < 4; ++m) {
                const int row = u.pm * 256 + ai * 128 + wr * 64 + m * 16 + fr;
                u32x4 w;
#pragma unroll
                for (int bj = 0; bj < 2; ++bj) { const f32x4 a = acc[ai][bj][m][0] * YS, b = acc[ai][bj][m][1] * YS;
                    int lo = cvt8(a[0], a[1], 0, false); lo = cvt8(a[2], a[3], lo, true);
                    int hi = cvt8(b[0], b[1], 0, false); hi = cvt8(b[2], b[3], hi, true);
                    w[2 * bj] = (unsigned)lo; w[2 * bj + 1] = (unsigned)hi; }
                *(u32x4*)(Y + (size_t)row * DM + pos) = w;
            }
    }
};
constexpr float X8_SCALE = 4.f, WG8_SCALE = 64.f;
struct EpiRes {
    bf16_t* xb; const float* scale; unsigned char* x8; float mul;
    __device__ __forceinline__ void operator()(const Acc& acc, const pg8::Unit& u, int wr, int wc, int fr, int fq) const {
        const int col = u.pn * 256 + wc * 64 + 8 * fq;
        f32x4 sc[2][2];
#pragma unroll
        for (int bj = 0; bj < 2; ++bj)
#pragma unroll
            for (int n = 0; n < 2; ++n) sc[bj][n] = (scale ? *(const f32x4*)(scale + col + 32 * bj + 4 * n) : (f32x4){1.f, 1.f, 1.f, 1.f}) * mul;
#pragma unroll
        for (int ai = 0; ai < 2; ++ai) {
            u32x4 r[2][4][2];
#pragma unroll
            for (int m = 0; m < 4; ++m)
#pragma unroll
                for (int bj = 0; bj < 2; ++bj) r[ai][m][bj] = *(const u32x4*)(xb + (size_t)(u.pm * 256 + ai * 128 + wr * 64 + m * 16 + fr) * DM + col + 32 * bj);
            asm volatile("" ::: "memory");
#pragma unroll
            for (int m = 0; m < 4; ++m) {
                const size_t off = (size_t)(u.pm * 256 + ai * 128 + wr * 64 + m * 16 + fr) * DM + col;
                u32x4 w8;
#pragma unroll
                for (int bj = 0; bj < 2; ++bj) {
                    const u32x4 q = r[ai][m][bj];
                    const f32x4 a = acc[ai][bj][m][0] * sc[bj][0], b = acc[ai][bj][m][1] * sc[bj][1];
                    const float x0 = __builtin_bit_cast(float, q.x << 16) + a[0], x1 = __builtin_bit_cast(float, q.x & 0xffff0000u) + a[1], x2 = __builtin_bit_cast(float, q.y << 16) + a[2], x3 = __builtin_bit_cast(float, q.y & 0xffff0000u) + a[3];
                    const float x4 = __builtin_bit_cast(float, q.z << 16) + b[0], x5 = __builtin_bit_cast(float, q.z & 0xffff0000u) + b[1], x6 = __builtin_bit_cast(float, q.w << 16) + b[2], x7 = __builtin_bit_cast(float, q.w & 0xffff0000u) + b[3];
                    u32x4 w; w.x = cvtpk(x0, x1); w.y = cvtpk(x2, x3); w.z = cvtpk(x4, x5); w.w = cvtpk(x6, x7);
                    *(u32x4*)(xb + off + 32 * bj) = w;
                    int lo = cvt8(x0 * X8_SCALE, x1 * X8_SCALE, 0, false); lo = cvt8(x2 * X8_SCALE, x3 * X8_SCALE, lo, true);
                    int hi = cvt8(x4 * X8_SCALE, x5 * X8_SCALE, 0, false); hi = cvt8(x6 * X8_SCALE, x7 * X8_SCALE, hi, true);
                    w8[2 * bj] = (unsigned)lo; w8[2 * bj + 1] = (unsigned)hi; }
                *(u32x4*)(x8 + (size_t)(u.pm * 256 + ai * 128 + wr * 64 + m * 16 + fr) * DM + u.pn * 256 + wc * 64 + 16 * fq) = w8;
            }
        }
    }
};
constexpr float H8_SCALE = 16.f, WD8_SCALE = 64.f;
struct EpiGateUp {
    static constexpr int NSTORES = 8;
    unsigned char* H; const float* slot_rs;
    __device__ __forceinline__ void operator()(const Acc& acc, const pg8::Unit& u, int wr, int wc, int fr, int fq) const {
        const int col = u.pn * 128 + wc * 32 + 8 * fq;
#pragma unroll
        for (int ai = 0; ai < 2; ++ai) {
            float rsv[4];
#pragma unroll
            for (int m = 0; m < 4; ++m) rsv[m] = slot_rs[u.pm * 256 + ai * 128 + wr * 64 + m * 16 + fr];
            asm volatile("" : "+v"(rsv[0]), "+v"(rsv[1]), "+v"(rsv[2]), "+v"(rsv[3]) :: "memory");
#pragma unroll
            for (int m = 0; m < 4; ++m) {
                const int row = u.pm * 256 + ai * 128 + wr * 64 + m * 16 + fr;
                const float rs = rsv[m] * (1.f / (X8_SCALE * WG8_SCALE));
                float h[8];
#pragma unroll
                for (int n = 0; n < 2; ++n)
#pragma unroll
                    for (int i = 0; i < 4; ++i) { const float g = acc[ai][0][m][n][i] * rs, up = acc[ai][1][m][n][i] * rs;
                        h[4 * n + i] = g * up * __builtin_amdgcn_rcpf(1.f + __builtin_amdgcn_exp2f(-g * LOG2E)) * H8_SCALE; }
                int lo = cvt8(h[0], h[1], 0, false); lo = cvt8(h[2], h[3], lo, true);
                int hi = cvt8(h[4], h[5], 0, false); hi = cvt8(h[6], h[7], hi, true);
                u32x2 w; w.x = (unsigned)lo; w.y = (unsigned)hi;
                *(u32x2*)(H + (size_t)row * EFF + col) = w;
            }
        }
    }
};

namespace attn {
constexpr int SLOT = 32768, V_OFF = 16384, NSLOT = 3, X_OFF = NSLOT * SLOT, WSF_OFF = TS_OFF + 256;
static_assert(X_OFF + 4 * 8192 <= RING_BYTES && WSF_OFF + NWAVES * 256 <= LDS_BYTES, "attn LDS");
constexpr int DMAXI = 206;
__device__ __forceinline__ int crow(int r, int hi) { return (r & 3) + 8 * (r >> 2) + 4 * hi; }
__device__ __forceinline__ int rel_bucket(int n) {
    if (n < 16) return n;
    const int l = 16 + (int)(logf((float)n / 16.f) / logf(8.f) * 16.f);
    return l < 31 ? l : 31;
}
struct Params { const bf16_t* Q; const bf16_t* K; const bf16_t* V; bf16_t* O; const float* rel_bias; const float* subln; float lam; float one_minus_li; };

__device__ __forceinline__ void build_lut(LAS unsigned char* lds, const float* rel_bias) {
    LAS float* lut = (LAS float*)(lds + LUT_OFF);
    for (int idx = opaque_tid(); idx < NHEAD * LUT_N; idx += NTHREADS) {
        const int h = idx / LUT_N, i = idx - h * LUT_N, dist = DMAXI - i;
        lut[idx] = dist < 0 ? -INFINITY : (rel_bias[rel_bucket(dist) * NHEAD + h] - rel_bias[31 * NHEAD + h]) * LOG2E;
    }
}
#define ATT_WAIT_BAR(N) asm volatile("s_waitcnt vmcnt(" #N ") lgkmcnt(0)\n\ts_barrier" ::: "memory")
#define ATT_SBAR() __builtin_amdgcn_sched_barrier(0)
#define ATT_PIN(x) asm volatile("" : "+v"(x))
#define ATT_MF(a, b, c) __builtin_amdgcn_mfma_f32_32x32x16_bf16(a, b, c, 0, 0, 0)
#define ATT_VRD8(L, H, ks) do { _Pragma("unroll") for (int d_ = 0; d_ < 4; ++d_) { \
        asm volatile("ds_read_b64_tr_b16 %0, %1 offset:%c2" : "=&v"(L[d_]) : "v"(vaddr), "i"(V_OFF + d_ * 4096 + (ks) * 1024) : "memory"); \
        asm volatile("ds_read_b64_tr_b16 %0, %1 offset:%c2" : "=&v"(H[d_]) : "v"(vaddr), "i"(V_OFF + d_ * 4096 + (ks) * 1024 + 512) : "memory"); } } while (0)
#define ATT_VWAIT(N, L, H) do { asm volatile("s_waitcnt lgkmcnt(" #N ")" : "+v"(L[0]), "+v"(L[1]), "+v"(L[2]), "+v"(L[3]), "+v"(H[0]), "+v"(H[1]), "+v"(H[2]), "+v"(H[3]) :: "memory"); ATT_SBAR(); } while (0)
#define ATT_VF(L, H, d) ((bf16x8){L[d][0], L[d][1], L[d][2], L[d][3], H[d][0], H[d][1], H[d][2], H[d][3]})
#define ATT_PK(P, B) cvtpk(P[B], P[(B) + 1])
#define ATT_GAPA(VR, MFX, A0, A1, A2, A3, W0, W1, PW) do { VR; MFX; sacc += A0; sacc += A1; sacc += A2; sacc += A3; ATT_PIN(sacc); W0; W1; ATT_PIN(PW); ATT_SBAR(); } while (0)
#define ATT_VR1(L, H, d, ks) do { \
        asm volatile("ds_read_b64_tr_b16 %0, %1 offset:%c2" : "=&v"(L[d]) : "v"(vaddr), "i"(V_OFF + (d) * 4096 + (ks) * 1024) : "memory"); \
        asm volatile("ds_read_b64_tr_b16 %0, %1 offset:%c2" : "=&v"(H[d]) : "v"(vaddr), "i"(V_OFF + (d) * 4096 + (ks) * 1024 + 512) : "memory"); } while (0)
#define ATT_GAPB(KR, MFX, X, B) do { KR; MFX; X[B] = __builtin_amdgcn_exp2f(X[B]); X[(B) + 1] = __builtin_amdgcn_exp2f(X[(B) + 1]); ATT_PIN(X); ATT_SBAR(); } while (0)
#define ATT_KR(GL, j) do { if (GL) { kf[2 * (j)] = *(const LAS bf16x8*)(kp0 + sl_next + (j) * 2048); kf[2 * (j) + 1] = *(const LAS bf16x8*)(kp0 + sl_next + (j) * 2048 + 512); } } while (0)
#define ATT_NOP() do { } while (0)
#define ATT_KLOAD(kp_) do { _Pragma("unroll") for (int d0_ = 0; d0_ < 4; ++d0_) { kf[2 * d0_] = *(const LAS bf16x8*)((kp_) + d0_ * 2048); kf[2 * d0_ + 1] = *(const LAS bf16x8*)((kp_) + d0_ * 2048 + 512); } } while (0)
#define ATT_BAND(C0, C1, tt) do { const int dd_ = q0w - 64 * (tt); if (dd_ - 63 < 113) { const LAS float* lb_ = lut + (DMAXI - (dd_ + r32 - 4 * hi)); \
        _Pragma("unroll") for (int r = 0; r < 16; ++r) { C0[r] += lb_[(r & 3) + 8 * (r >> 2)]; C1[r] += lb_[32 + (r & 3) + 8 * (r >> 2)]; } } } while (0)
#define ATT_STEP(C0, C1, P0, P1, tt, ISSUE, GL, WN) do { \
        ATT_WAIT_BAR(WN); \
        ISSUE; \
        const unsigned vaddr = lds_u + (unsigned)sl_prev + (unsigned)vlane; \
        float sacc = 0.f; \
        ATT_GAPA(ATT_VR1(la, ha, 0, 0), C0 = ATT_MF(kf[0], qr[0], zero16), P0[0], P0[1], P0[2], P0[3],     pw0[0] = ATT_PK(P0, 0),  pw0[1] = ATT_PK(P0, 2),  pw0); \
        ATT_GAPA(ATT_VR1(la, ha, 1, 0), C1 = ATT_MF(kf[1], qr[0], zero16), P0[4], P0[5], P0[6], P0[7],     pw0[2] = ATT_PK(P0, 4),  pw0[3] = ATT_PK(P0, 6),  pw0); \
        ATT_GAPA(ATT_VR1(la, ha, 2, 0), C0 = ATT_MF(kf[2], qr[1], C0),     P0[8], P0[9], P0[10], P0[11],   pw1[0] = ATT_PK(P0, 8),  pw1[1] = ATT_PK(P0, 10), pw1); \
        ATT_GAPA(ATT_VR1(la, ha, 3, 0), C1 = ATT_MF(kf[3], qr[1], C1),     P0[12], P0[13], P0[14], P0[15], pw1[2] = ATT_PK(P0, 12), pw1[3] = ATT_PK(P0, 14), pw1); \
        ATT_GAPA(ATT_NOP(), C0 = ATT_MF(kf[4], qr[2], C0),     P1[0], P1[1], P1[2], P1[3],     pw2[0] = ATT_PK(P1, 0),  pw2[1] = ATT_PK(P1, 2),  pw2); \
        ATT_GAPA(ATT_NOP(), C1 = ATT_MF(kf[5], qr[2], C1),     P1[4], P1[5], P1[6], P1[7],     pw2[2] = ATT_PK(P1, 4),  pw2[3] = ATT_PK(P1, 6),  pw2); \
        ATT_GAPA(ATT_NOP(), C0 = ATT_MF(kf[6], qr[3], C0),     P1[8], P1[9], P1[10], P1[11],   pw3[0] = ATT_PK(P1, 8),  pw3[1] = ATT_PK(P1, 10), pw3); \
        ATT_GAPA(ATT_NOP(), C1 = ATT_MF(kf[7], qr[3], C1),     P1[12], P1[13], P1[14], P1[15], pw3[2] = ATT_PK(P1, 12), pw3[3] = ATT_PK(P1, 14), pw3); \
        lsum += sacc; \
        ATT_BAND(C0, C1, tt); \
        ATT_VRD8(lb2, hb2, 1); \
        ATT_VWAIT(8, la, ha); \
        ATT_GAPB(ATT_NOP(), o[0] = ATT_MF(__builtin_bit_cast(bf16x8, pw0), ATT_VF(la, ha, 0), o[0]), C0, 0); \
        ATT_GAPB(ATT_NOP(), o[1] = ATT_MF(__builtin_bit_cast(bf16x8, pw0), ATT_VF(la, ha, 1), o[1]), C0, 2); \
        ATT_GAPB(ATT_KR(GL, 0), o[2] = ATT_MF(__builtin_bit_cast(bf16x8, pw0), ATT_VF(la, ha, 2), o[2]), C0, 4); \
        ATT_GAPB(ATT_KR(GL, 1), o[3] = ATT_MF(__builtin_bit_cast(bf16x8, pw0), ATT_VF(la, ha, 3), o[3]), C0, 6); \
        ATT_VRD8(la, ha, 2); \
        ATT_VWAIT(8, lb2, hb2); \
        ATT_GAPB(ATT_KR(GL, 2), o[0] = ATT_MF(__builtin_bit_cast(bf16x8, pw1), ATT_VF(lb2, hb2, 0), o[0]), C0, 8); \
        ATT_GAPB(ATT_KR(GL, 3), o[1] = ATT_MF(__builtin_bit_cast(bf16x8, pw1), ATT_VF(lb2, hb2, 1), o[1]), C0, 10); \
        ATT_GAPB(ATT_NOP(), o[2] = ATT_MF(__builtin_bit_cast(bf16x8, pw1), ATT_VF(lb2, hb2, 2), o[2]), C0, 12); \
        ATT_GAPB(ATT_NOP(), o[3] = ATT_MF(__builtin_bit_cast(bf16x8, pw1), ATT_VF(lb2, hb2, 3), o[3]), C0, 14); \
        ATT_VRD8(lb2, hb2, 3); \
        ATT_VWAIT(8, la, ha); \
        ATT_GAPB(ATT_NOP(), o[0] = ATT_MF(__builtin_bit_cast(bf16x8, pw2), ATT_VF(la, ha, 0), o[0]), C1, 0); \
        ATT_GAPB(ATT_NOP(), o[1] = ATT_MF(__builtin_bit_cast(bf16x8, pw2), ATT_VF(la, ha, 1), o[1]), C1, 2); \
        ATT_GAPB(ATT_NOP(), o[2] = ATT_MF(__builtin_bit_cast(bf16x8, pw2), ATT_VF(la, ha, 2), o[2]), C1, 4); \
        ATT_GAPB(ATT_NOP(), o[3] = ATT_MF(__builtin_bit_cast(bf16x8, pw2), ATT_VF(la, ha, 3), o[3]), C1, 6); \
        ATT_VWAIT(0, lb2, hb2); \
        ATT_GAPB(ATT_NOP(), o[0] = ATT_MF(__builtin_bit_cast(bf16x8, pw3), ATT_VF(lb2, hb2, 0), o[0]), C1, 8); \
        ATT_GAPB(ATT_NOP(), o[1] = ATT_MF(__builtin_bit_cast(bf16x8, pw3), ATT_VF(lb2, hb2, 1), o[1]), C1, 10); \
        ATT_GAPB(ATT_NOP(), o[2] = ATT_MF(__builtin_bit_cast(bf16x8, pw3), ATT_VF(lb2, hb2, 2), o[2]), C1, 12); \
        ATT_GAPB(ATT_NOP(), o[3] = ATT_MF(__builtin_bit_cast(bf16x8, pw3), ATT_VF(lb2, hb2, 3), o[3]), C1, 14); \
        { const int tmp_ = sl_prev; sl_prev = sl_cur; sl_cur = sl_next; sl_next = tmp_; } \
    } while (0)

__device__ __forceinline__ void attn_unit(const Params& P, int b, int h, int qblk, LAS unsigned char* lds, const bool pre, const bool has_next, int nb, int nh, int nqblk, bf16x8 (&qn)[4]) {
    const int tid = opaque_tid(), lane = tid & 63, r32 = lane & 31, hi = lane >> 5;
    const int wid = __builtin_amdgcn_readfirstlane(tid >> 6), c = wid >> 2, wq = wid & 3;
    const int q0 = qblk * 128, q0w = q0 + 32 * wq, NT = 2 * qblk + 2;
    const size_t rowbase = (size_t)b * SEQ;
    bf16x8 qr[4];
    if (pre) {
#pragma unroll
        for (int d0 = 0; d0 < 4; ++d0) qr[d0] = qn[d0];
    } else { const bf16_t* Qw = P.Q + (rowbase + q0w + r32) * DM + h * 128 + c * 64 + hi * 8;
#pragma unroll
      for (int d0 = 0; d0 < 4; ++d0) qr[d0] = *(const bf16x8*)(Qw + d0 * 16); }
    const bf16_t* ksrc = P.K + (size_t)(b * NHEAD + h) * 64 * 8192 + wid * 512 + lane * 8;
    const bf16_t* vsrc = P.V + (size_t)(b * NHEAD + h) * 64 * 8192 + (wid >> 2) * 2048 + wq * 512 + lane * 8;
#define ATT_DMA_K(t, slot) do { const size_t to_ = (size_t)(t) * 8192; \
        __builtin_amdgcn_global_load_lds((const unsigned*)(ksrc + to_), (LAS unsigned*)(lds + (slot) + wid * 1024), 16, 0, 0); \
        __builtin_amdgcn_global_load_lds((const unsigned*)(ksrc + to_ + 4096), (LAS unsigned*)(lds + (slot) + 8192 + wid * 1024), 16, 0, 0); } while (0)
#define ATT_DMA_V(t, slot) do { const size_t to_ = (size_t)(t) * 8192; \
        __builtin_amdgcn_global_load_lds((const unsigned*)(vsrc + to_), (LAS unsigned*)(lds + (slot) + V_OFF + (wid >> 2) * 4096 + wq * 1024), 16, 0, 0); \
        __builtin_amdgcn_global_load_lds((const unsigned*)(vsrc + to_ + 4096), (LAS unsigned*)(lds + (slot) + V_OFF + (2 + (wid >> 2)) * 4096 + wq * 1024), 16, 0, 0); } while (0)
    if (pre) { ATT_DMA_V(0, 0); }
    else { ATT_DMA_K(0, 0);
        ATT_DMA_K(1, SLOT); ATT_DMA_V(0, 0);
        if (NT > 2) ATT_DMA_K(2, 2 * SLOT); }
    f32x16 o[4];
#pragma unroll
    for (int d = 0; d < 4; ++d)
#pragma unroll
        for (int r = 0; r < 16; ++r) o[d][r] = 0.f;
    f32x16 zero16;
#pragma unroll
    for (int r = 0; r < 16; ++r) zero16[r] = 0.f;
    float lsum = 0.f;
    const LAS float* lut = (const LAS float*)(lds + LUT_OFF) + h * LUT_N;
    const int vlane = ((lane >> 4) & 1) * 32 + (lane & 3) * 8 + (4 * hi + ((lane & 15) >> 2)) * 64;
    const unsigned lds_u = (unsigned)(uintptr_t)lds;
    const LAS unsigned char* kp0 = lds + c * 8192 + hi * 1024 + r32 * 16;
    int sl_prev = 2 * SLOT, sl_cur = 0, sl_next = SLOT;
    bf16x8 kf[8]; s16x4 la[4], ha[4], lb2[4], hb2[4]; u32x4 pw0, pw1, pw2, pw3;
    f32x16 pA0, pA1, pB0, pB1;
    if (pre) { if (c == 0) ATT_WAIT_BAR(8); else ATT_WAIT_BAR(2); }
    else if (NT > 2) ATT_WAIT_BAR(6); else ATT_WAIT_BAR(4);
    ATT_DMA_V(1, SLOT);
    ATT_KLOAD(kp0);
    pA0 = ATT_MF(kf[0], qr[0], zero16); pA1 = ATT_MF(kf[1], qr[0], zero16);
    pA0 = ATT_MF(kf[2], qr[1], pA0); pA1 = ATT_MF(kf[3], qr[1], pA1);
    pA0 = ATT_MF(kf[4], qr[2], pA0); pA1 = ATT_MF(kf[5], qr[2], pA1);
    pA0 = ATT_MF(kf[6], qr[3], pA0); pA1 = ATT_MF(kf[7], qr[3], pA1);
    ATT_BAND(pA0, pA1, 0);
#pragma unroll
    for (int r = 0; r < 16; ++r) { pA0[r] = __builtin_amdgcn_exp2f(pA0[r]); pA1[r] = __builtin_amdgcn_exp2f(pA1[r]); }
    if (pre) ATT_WAIT_BAR(12);
    else if (NT > 2) ATT_WAIT_BAR(6); else ATT_WAIT_BAR(4);
    ATT_KLOAD(kp0 + SLOT);
    { const int tmp_ = sl_prev; sl_prev = sl_cur; sl_cur = sl_next; sl_next = tmp_; }
    ATT_STEP(pB0, pB1, pA0, pA1, 1, { if (3 < NT) ATT_DMA_K(3, sl_prev); if (4 < NT) ATT_DMA_K(4, sl_cur); if (2 < NT) ATT_DMA_V(2, sl_next); }, (2 < NT), 2);
    if (NT > 2) {
        int t = 2;
        for (; t + 4 < NT; t += 2) {
            ATT_STEP(pA0, pA1, pB0, pB1, t,     { ATT_DMA_K(t + 3, sl_cur); ATT_DMA_V(t + 1, sl_next); }, true, 4);
            ATT_STEP(pB0, pB1, pA0, pA1, t + 1, { ATT_DMA_K(t + 4, sl_cur); ATT_DMA_V(t + 2, sl_next); }, true, 4);
        }
        if (NT - t == 4) {
            ATT_STEP(pA0, pA1, pB0, pB1, t,     { ATT_DMA_K(t + 3, sl_cur); ATT_DMA_V(t + 1, sl_next); }, true, 4);
            ATT_STEP(pB0, pB1, pA0, pA1, t + 1, { ATT_DMA_V(t + 2, sl_next); }, true, 4);
            t += 2;
        }
        ATT_STEP(pA0, pA1, pB0, pB1, t,     { ATT_DMA_V(t + 1, sl_next); }, true, 2);
        ATT_STEP(pB0, pB1, pA0, pA1, t + 1, { }, false, 2);
    }
    { float sacc = 0.f;
#pragma unroll
      for (int r = 0; r < 16; ++r) sacc += pB0[r] + pB1[r];
      lsum += sacc;
#pragma unroll
      for (int q = 0; q < 4; ++q) { pw0[q] = ATT_PK(pB0, 2 * q); pw1[q] = ATT_PK(pB0, 8 + 2 * q); pw2[q] = ATT_PK(pB1, 2 * q); pw3[q] = ATT_PK(pB1, 8 + 2 * q); }
      ATT_WAIT_BAR(0);
      if (has_next) {
          const bf16_t* ksn = P.K + (size_t)(nb * NHEAD + nh) * 64 * 8192 + wid * 512 + lane * 8;
#define ATT_DMA_KN(t, slot) do { const size_t to_ = (size_t)(t) * 8192; \
        __builtin_amdgcn_global_load_lds((const unsigned*)(ksn + to_), (LAS unsigned*)(lds + (slot) + wid * 1024), 16, 0, 0); \
        __builtin_amdgcn_global_load_lds((const unsigned*)(ksn + to_ + 4096), (LAS unsigned*)(lds + (slot) + 8192 + wid * 1024), 16, 0, 0); } while (0)
          ATT_DMA_KN(0, 0); ATT_DMA_KN(1, SLOT);
          if (nqblk > 0) ATT_DMA_KN(2, 2 * SLOT);
#undef ATT_DMA_KN
          const bf16_t* Qn = P.Q + ((size_t)nb * SEQ + nqblk * 128 + 32 * wq + r32) * DM + nh * 128 + c * 64 + hi * 8;
#pragma unroll
          for (int d0 = 0; d0 < 4; ++d0) qn[d0] = *(const bf16x8*)(Qn + d0 * 16);
          asm volatile("" ::: "memory");
      }
      const unsigned vaddr = lds_u + (unsigned)sl_prev + (unsigned)vlane;
      ATT_VRD8(la, ha, 0); ATT_VRD8(lb2, hb2, 1);
      ATT_VWAIT(8, la, ha);
#pragma unroll
      for (int d = 0; d < 4; ++d) o[d] = ATT_MF(__builtin_bit_cast(bf16x8, pw0), ATT_VF(la, ha, d), o[d]);
      ATT_VRD8(la, ha, 2);
      ATT_VWAIT(8, lb2, hb2);
#pragma unroll
      for (int d = 0; d < 4; ++d) o[d] = ATT_MF(__builtin_bit_cast(bf16x8, pw1), ATT_VF(lb2, hb2, d), o[d]);
      ATT_VRD8(lb2, hb2, 3);
      ATT_VWAIT(8, la, ha);
#pragma unroll
      for (int d = 0; d < 4; ++d) o[d] = ATT_MF(__builtin_bit_cast(bf16x8, pw2), ATT_VF(la, ha, d), o[d]);
      ATT_VWAIT(0, lb2, hb2);
#pragma unroll
      for (int d = 0; d < 4; ++d) o[d] = ATT_MF(__builtin_bit_cast(bf16x8, pw3), ATT_VF(lb2, hb2, d), o[d]);
    }
#undef ATT_DMA_K
#undef ATT_DMA_V
    LAS float* wsf = (LAS float*)(lds + WSF_OFF) + wid * 64;
    lsum += __shfl_xor(lsum, 32);
    if (hi == 0) wsf[r32] = lsum;
    asm volatile("s_waitcnt lgkmcnt(0)" ::: "memory");
    float rl[16];
#pragma unroll
    for (int r = 0; r < 16; ++r) rl[r] = __builtin_amdgcn_rcpf(wsf[crow(r, hi)]);
    LAS unsigned short* X = (LAS unsigned short*)(lds + X_OFF) + wq * 4096;
    if (c == 1) {
#pragma unroll
        for (int d = 0; d < 4; ++d)
#pragma unroll
            for (int r = 0; r < 16; ++r) X[(d * 16 + r) * 64 + lane] = (unsigned short)(cvtpk(o[d][r] * (rl[r] * P.lam), 0.f) & 0xffffu);
    }
    asm volatile("s_waitcnt lgkmcnt(0)\n\ts_barrier" ::: "memory");
    if (c == 0) {
        float rs[16];
#pragma unroll
        for (int r = 0; r < 16; ++r) {
            float ss = 0.f;
#pragma unroll
            for (int d = 0; d < 4; ++d) { const float v = o[d][r] * rl[r] - bf2f(X[(d * 16 + r) * 64 + lane]); o[d][r] = v; ss += v * v; }
            ss += __shfl_xor(ss, 1); ss += __shfl_xor(ss, 2); ss += __shfl_xor(ss, 4); ss += __shfl_xor(ss, 8); ss += __shfl_xor(ss, 16);
            rs[r] = __builtin_amdgcn_rsqf(ss * (1.f / 128.f) + EPS) * P.one_minus_li;
        }
        asm volatile("s_waitcnt lgkmcnt(0)" ::: "memory");
        LAS unsigned short* stg = X;
#pragma unroll
        for (int d = 0; d < 4; ++d) { const float g = P.subln[32 * d + r32];
#pragma unroll
            for (int r = 0; r < 16; ++r) stg[crow(r, hi) * 128 + 32 * d + r32] = (unsigned short)(cvtpk(o[d][r] * rs[r] * g, 0.f) & 0xffffu); }
        asm volatile("s_waitcnt lgkmcnt(0)" ::: "memory");
        bf16_t* Ow = P.O + (rowbase + q0w) * DM + h * 128;
#pragma unroll
        for (int i = 0; i < 8; ++i) { const int idx = i * 64 + lane, row = idx >> 4, ch = idx & 15;
            const u32x4 v = *(const LAS u32x4*)((const LAS unsigned char*)stg + row * 256 + ch * 16);
            *(u32x4*)(Ow + (size_t)row * DM + ch * 8) = v; }
    }
}

__device__ __forceinline__ void attn_phase(const Params& P, LAS unsigned char* lds) {
    const int G = gridDim.x, bx = blockIdx.x;
    build_lut(lds, P.rel_bias);
    __syncthreads();
    if (G == 256) {
        const int x = bx & 7, j = bx >> 3;
        bf16x8 qn[4];
#pragma unroll
        for (int d0 = 0; d0 < 4; ++d0) qn[d0] = (bf16x8){0, 0, 0, 0, 0, 0, 0, 0};
        for (int r = 0; r < 16; ++r) { const int bh = x * 16 + r, bn = bh + 1;
            attn_unit(P, bh >> 3, bh & 7, (r & 1) ? 31 - j : j, lds, r > 0, r < 15, bn >> 3, bn & 7, (r & 1) ? j : 31 - j, qn); }
    } else {
        for (int i = 0;; ++i) { const int p = bx + G * i; if (p >= 2048) break; const int bh = p >> 4, s2 = p & 15;
            bf16x8 qd[4]; attn_unit(P, bh >> 3, bh & 7, 31 - s2, lds, false, false, 0, 0, 0, qd); attn_unit(P, bh >> 3, bh & 7, s2, lds, false, false, 0, 0, 0, qd); }
    }
    __syncthreads();
}
}

#define BF_LO(u) __builtin_bit_cast(float, (u) << 16)
#define BF_HI(u) __builtin_bit_cast(float, (u) & 0xffff0000u)
template <int MODE>
__device__ __forceinline__ void row_pass(const float* xin, float* xout, bf16_t* xb, float* rstd, const unsigned char* Y, const int* tok_slot, const float* tok_w, LAS unsigned char* lds) {
    const int tid = opaque_tid(), lane = tid & 63, wid = tid >> 6;
    const int ypos = 64 * (lane >> 4) + 16 * (((lane & 15) >> 1) & 3) + 8 * ((lane & 15) >> 3) + 4 * (lane & 1);
    LAS int* sl = (LAS int*)lds; LAS float* wl = (LAS float*)(lds + 2048);
    for (int blk = blockIdx.x; blk < NTOK / 256; blk += gridDim.x) {
        if (MODE != 0) { sl[tid] = tok_slot[blk * 512 + tid]; wl[tid] = tok_w[blk * 512 + tid]; __syncthreads(); }
        for (int it = 0; it < 8; ++it) {
            const int r0 = it * 32 + wid * 4, m0 = blk * 256 + r0;
            f32x4 v[4][4];
            if (MODE == 0) {
#pragma unroll
                for (int rr = 0; rr < 4; ++rr) { const f32x4* xr = (const f32x4*)(xin + (size_t)(m0 + rr) * DM) + lane;
#pragma unroll
                    for (int j = 0; j < 4; ++j) v[rr][j] = xr[64 * j]; }
            } else {
                u32x2 xq[4][4]; unsigned ya[4][4], yb[4][4]; float w0[4], w1[4];
#pragma unroll
                for (int rr = 0; rr < 4; ++rr) { const int s0 = sl[2 * (r0 + rr)], s1 = sl[2 * (r0 + rr) + 1]; w0[rr] = wl[2 * (r0 + rr)] * (1.f / Y8_SCALE); w1[rr] = wl[2 * (r0 + rr) + 1] * (1.f / Y8_SCALE);
                    const u32x2* xr = (const u32x2*)(xb + (size_t)(m0 + rr) * DM) + lane;
                    const unsigned char* y0 = Y + (size_t)s0 * DM + ypos; const unsigned char* y1 = Y + (size_t)s1 * DM + ypos;
#pragma unroll
                    for (int j = 0; j < 4; ++j) { xq[rr][j] = xr[64 * j]; ya[rr][j] = *(const unsigned*)(y0 + 256 * j); yb[rr][j] = *(const unsigned*)(y1 + 256 * j); } }
#pragma unroll
                for (int rr = 0; rr < 4; ++rr)
#pragma unroll
                    for (int j = 0; j < 4; ++j) { const u32x2 x = xq[rr][j];
                        const f32x2 a0 = __builtin_amdgcn_cvt_pk_f32_fp8((int)ya[rr][j], false), a1 = __builtin_amdgcn_cvt_pk_f32_fp8((int)ya[rr][j], true);
                        const f32x2 b0 = __builtin_amdgcn_cvt_pk_f32_fp8((int)yb[rr][j], false), b1 = __builtin_amdgcn_cvt_pk_f32_fp8((int)yb[rr][j], true);
                        v[rr][j][0] = BF_LO(x.x) + w0[rr] * a0.x + w1[rr] * b0.x;
                        v[rr][j][1] = BF_HI(x.x) + w0[rr] * a0.y + w1[rr] * b0.y;
                        v[rr][j][2] = BF_LO(x.y) + w0[rr] * a1.x + w1[rr] * b1.x;
                        v[rr][j][3] = BF_HI(x.y) + w0[rr] * a1.y + w1[rr] * b1.y; }
            }
            if (MODE == 2) {
#pragma unroll
                for (int rr = 0; rr < 4; ++rr) { f32x4* xo = (f32x4*)(xout + (size_t)(m0 + rr) * DM) + lane;
#pragma unroll
                    for (int j = 0; j < 4; ++j) xo[64 * j] = v[rr][j]; }
            } else {
#pragma unroll
                for (int rr = 0; rr < 4; ++rr) {
                    float ss = 0.f;
                    u32x2* o8 = (u32x2*)(xb + (size_t)(m0 + rr) * DM) + lane;
#pragma unroll
                    for (int j = 0; j < 4; ++j) { ss += (v[rr][j][0] * v[rr][j][0] + v[rr][j][1] * v[rr][j][1]) + (v[rr][j][2] * v[rr][j][2] + v[rr][j][3] * v[rr][j][3]);
                        u32x2 w; w.x = cvtpk(v[rr][j][0], v[rr][j][1]); w.y = cvtpk(v[rr][j][2], v[rr][j][3]); o8[64 * j] = w; }
                    ss = wave_sum(ss);
                    if (lane == 0) rstd[m0 + rr] = __builtin_amdgcn_rsqf(ss * (1.f / DM) + EPS);
                }
            }
        }
        if (MODE != 0) __syncthreads();
    }
}

__device__ __forceinline__ void router_pass(const bf16_t* x, const bf16_t* wt, const float* wg  , const float* bg, const float* be,
                                            float* rstd_out, int* tok_e, float* tok_w, int* cnt, LAS unsigned char* lds) {
    const int tid = opaque_tid(), lane = tid & 63, wid = tid >> 6, r32 = lane & 31, hi = lane >> 5;
    LAS f32x4* wgl = (LAS f32x4*)lds;
    LAS int* cntl = (LAS int*)(lds + 16384);
    for (int i = tid; i < 1024; i += NTHREADS) wgl[i] = *(const f32x4*)(wg + 4 * i);
    for (int blk = blockIdx.x; blk < NTOK / 256; blk += gridDim.x) {
        if (tid < NEXP) cntl[tid] = 0;
        __syncthreads();
        const int tok = blk * 256 + wid * 32 + r32;
        const u32x4* xp = (const u32x4*)(x + (size_t)tok * DM + 8 * hi);
        const u32x4* wph = (const u32x4*)wt + lane; const u32x4* wpl = wph + 64 * 64;
        const LAS f32x4* gp_ = wgl + 8 * hi;
        f32x16 D;
#pragma unroll
        for (int r = 0; r < 16; ++r) D[r] = 0.f;
        float ss = 0.f; f32x4 gl = {0.f, 0.f, 0.f, 0.f};
#pragma unroll 4
        for (int s = 0; s < 64; ++s) {
            const u32x4 xq_ = xp[2 * s], wh = wph[64 * s], wl = wpl[64 * s];
            D = __builtin_amdgcn_mfma_f32_32x32x16_bf16(__builtin_bit_cast(bf16x8, wh), __builtin_bit_cast(bf16x8, xq_), D, 0, 0, 0);
            D = __builtin_amdgcn_mfma_f32_32x32x16_bf16(__builtin_bit_cast(bf16x8, wl), __builtin_bit_cast(bf16x8, xq_), D, 0, 0, 0);
            const float xa[8] = {BF_LO(xq_.x), BF_HI(xq_.x), BF_LO(xq_.y), BF_HI(xq_.y), BF_LO(xq_.z), BF_HI(xq_.z), BF_LO(xq_.w), BF_HI(xq_.w)};
#pragma unroll
            for (int j = 0; j < 8; ++j) { gl += gp_[16 * s + j] * xa[j]; ss += xa[j] * xa[j]; }
        }
        ss += __shfl_xor(ss, 32);
#pragma unroll
        for (int g = 0; g < 4; ++g) gl[g] += __shfl_xor(gl[g], 32);
        const float rs = __builtin_amdgcn_rsqf(ss * (1.f / DM) + EPS);
        float glg[4]; float gmax = -INFINITY; int gidx = 0;
#pragma unroll
        for (int g = 0; g < 4; ++g) { glg[g] = gl[g] * rs + bg[g]; if (glg[g] > gmax) { gmax = glg[g]; gidx = g; } }
        float gsum = 0.f;
#pragma unroll
        for (int g = 0; g < 4; ++g) gsum += __expf(glg[g] - gmax);
        const float gprob = 1.f / gsum;
        float own[4], oth[4], v[8];
#pragma unroll
        for (int i = 0; i < 4; ++i) { const float d = gidx == 0 ? D[i] : gidx == 1 ? D[4 + i] : gidx == 2 ? D[8 + i] : D[12 + i];
            own[i] = d * rs + be[8 * gidx + 4 * hi + i]; oth[i] = __shfl_xor(own[i], 32); }
#pragma unroll
        for (int i = 0; i < 4; ++i) { v[i] = hi ? oth[i] : own[i]; v[4 + i] = hi ? own[i] : oth[i]; }
        int i1 = 0; float v1 = v[0];
#pragma unroll
        for (int i = 1; i < 8; ++i) if (v[i] > v1) { v1 = v[i]; i1 = i; }
        int i2 = -1; float v2 = -INFINITY;
#pragma unroll
        for (int i = 0; i < 8; ++i) if (i != i1 && v[i] > v2) { v2 = v[i]; i2 = i; }
        const float w1 = gprob / (1.f + __expf(v2 - v1)), w2 = gprob - w1;
        if (hi == 0) {
            const int e1 = 8 * gidx + i1, e2 = 8 * gidx + i2;
            tok_e[2 * tok] = e1; tok_e[2 * tok + 1] = e2; tok_w[2 * tok] = w1; tok_w[2 * tok + 1] = w2; rstd_out[tok] = rs;
            atomicAdd((int*)&cntl[e1], 1); atomicAdd((int*)&cntl[e2], 1);
        }
        __syncthreads();
        if (tid < NEXP) cnt[blk * NEXP + tid] = cntl[tid];
        __syncthreads();
    }
}

__device__ __forceinline__ void assign_pass(const int* cnt, const int* tok_e, const float* rstd_ffn, int* tok_slot, int* slot_tok, float* slot_rs, LAS unsigned char* lds) {
    const int tid = opaque_tid(), lane = tid & 63, wid = tid >> 6;
    LAS int* pall = (LAS int*)lds;
    LAS int* plt = pall + 512;
    LAS int* total = plt + 512;
    LAS int* mybase = total + 32;
    LAS int* wcnt = mybase + 32;
    LAS int* ts = (LAS int*)(lds + TS_OFF);
    { const int e = tid & 31, p = tid >> 5; int a = 0;
      for (int b = 16 * p; b < 16 * p + 16; ++b) a += cnt[b * NEXP + e];
      pall[p * 32 + e] = a; }
    __syncthreads();
    if (tid < NEXP) { int a = 0; for (int p = 0; p < 16; ++p) a += pall[p * 32 + tid]; total[tid] = a; }
    __syncthreads();
    if (tid == 0) { int acc = 0; for (int e = 0; e < NEXP; ++e) { ts[e] = acc; acc += (total[e] + 255) >> 8; } ts[NEXP] = acc; }
    __syncthreads();
    for (int blk = blockIdx.x; blk < NTOK / 256; blk += gridDim.x) {
        { const int e = tid & 31, p = tid >> 5; int l = 0;
          for (int b = 16 * p; b < 16 * p + 16; ++b) { const int c = cnt[b * NEXP + e]; if (b < blk) l += c; }
          plt[p * 32 + e] = l; }
        int e0 = -1, e1 = -1, r0 = 0, r1 = 0; float rs = 0.f;
        if (tid < 256) { const int tok = blk * 256 + tid; e0 = tok_e[2 * tok]; e1 = tok_e[2 * tok + 1]; rs = rstd_ffn[tok]; }
        if (wid < 4) {
            const unsigned long long lt = (1ull << lane) - 1ull;
#pragma unroll 4
            for (int e = 0; e < NEXP; ++e) {
                const unsigned long long m = __ballot(e0 == e || e1 == e);
                const int r = __popcll(m & lt);
                if (e0 == e) r0 = r;
                if (e1 == e) r1 = r;
                if (lane == 0) wcnt[e * 4 + wid] = __popcll(m);
            }
        }
        __syncthreads();
        if (tid < NEXP) { int l = 0; for (int p = 0; p < 16; ++p) l += plt[p * 32 + tid]; mybase[tid] = l; }
        __syncthreads();
        if (tid < 256) {
            const int tok = blk * 256 + tid;
            int p0 = ts[e0] * 256 + mybase[e0] + r0, p1 = ts[e1] * 256 + mybase[e1] + r1;
            for (int w = 0; w < wid; ++w) { p0 += wcnt[e0 * 4 + w]; p1 += wcnt[e1 * 4 + w]; }
            tok_slot[2 * tok] = p0; tok_slot[2 * tok + 1] = p1;
            slot_tok[p0] = tok; slot_tok[p1] = tok; slot_rs[p0] = rs; slot_rs[p1] = rs;
        }
        if (blk == 0) {
            for (int e = 0; e < NEXP; ++e) for (int p = ts[e] * 256 + total[e] + tid; p < ts[e + 1] * 256; p += NTHREADS) { slot_tok[p] = 0; slot_rs[p] = 0.f; }
        }
        __syncthreads();
    }
}

__device__ __forceinline__ void pool_pass(const bf16_t* U, unsigned char* Pq) {
    const int tid = opaque_tid(), lane = tid & 63, wid = tid >> 6;
    for (int task = blockIdx.x * NWAVES + wid; task < (NTOK / 64) * 2; task += gridDim.x * NWAVES) {
        const int rb = task >> 1, half = task & 1, T0 = rb * 64, col = half * 512 + lane * 8, w = 2 << (half * 2 + (lane >> 5)), tp0 = T0 & (SEQ - 1);
        float S[8];
#pragma unroll
        for (int k = 0; k < 8; ++k) S[k] = 0.f;
#define PL_LD(dst, row) do { const u32x4 q_ = *(const u32x4*)(U + (size_t)(row) * DM + col); \
        dst[0] = __builtin_bit_cast(float, q_.x << 16); dst[1] = __builtin_bit_cast(float, q_.x & 0xffff0000u); dst[2] = __builtin_bit_cast(float, q_.y << 16); dst[3] = __builtin_bit_cast(float, q_.y & 0xffff0000u); \
        dst[4] = __builtin_bit_cast(float, q_.z << 16); dst[5] = __builtin_bit_cast(float, q_.z & 0xffff0000u); dst[6] = __builtin_bit_cast(float, q_.w << 16); dst[7] = __builtin_bit_cast(float, q_.w & 0xffff0000u); } while (0)
        for (int jj = 1; jj < 16; ++jj) if (jj < w && tp0 - jj >= 0) { float a[8]; PL_LD(a, T0 - jj);
#pragma unroll
            for (int k = 0; k < 8; ++k) S[k] += a[k]; }
#define PL_UNP(dst, q_) do { dst[0] = __builtin_bit_cast(float, q_.x << 16); dst[1] = __builtin_bit_cast(float, q_.x & 0xffff0000u); dst[2] = __builtin_bit_cast(float, q_.y << 16); dst[3] = __builtin_bit_cast(float, q_.y & 0xffff0000u); \
        dst[4] = __builtin_bit_cast(float, q_.z << 16); dst[5] = __builtin_bit_cast(float, q_.z & 0xffff0000u); dst[6] = __builtin_bit_cast(float, q_.w << 16); dst[7] = __builtin_bit_cast(float, q_.w & 0xffff0000u); } while (0)
        for (int i0 = 0; i0 < 64; i0 += 8) {
            u32x4 cq[8], aq[8];
#pragma unroll
            for (int i = 0; i < 8; ++i) { const int t = T0 + i0 + i, tp = tp0 + i0 + i;
                cq[i] = *(const u32x4*)(U + (size_t)t * DM + col);
                aq[i] = (tp - (w - 1) >= 0) ? *(const u32x4*)(U + (size_t)(t - (w - 1)) * DM + col) : (u32x4){0u, 0u, 0u, 0u}; }
#pragma unroll
            for (int i = 0; i < 8; ++i) { const int t = T0 + i0 + i, tp = tp0 + i0 + i; float c[8], a[8]; PL_UNP(c, cq[i]); PL_UNP(a, aq[i]);
                const int n = tp + 1 < w ? tp + 1 : w; const float inv = 1.f / (float)n;
                float o[8];
#pragma unroll
                for (int k = 0; k < 8; ++k) { S[k] += c[k]; o[k] = S[k] * inv - c[k]; S[k] -= a[k]; }
                int lo = cvt8(o[0] * A8_SCALE, o[1] * A8_SCALE, 0, false); lo = cvt8(o[2] * A8_SCALE, o[3] * A8_SCALE, lo, true);
                int hi = cvt8(o[4] * A8_SCALE, o[5] * A8_SCALE, 0, false); hi = cvt8(o[6] * A8_SCALE, o[7] * A8_SCALE, hi, true);
                *(u32x2*)(Pq + (size_t)t * DM + col) = (u32x2){(unsigned)lo, (unsigned)hi}; }
        }
#undef PL_UNP
#undef PL_LD
    }
}

constexpr int ARG_OFF = attn::WSF_OFF + NWAVES * 256;
static_assert(ARG_OFF + 27 * 8 <= LDS_BYTES, "LDS map (args)");
__device__ __forceinline__ const void* arg_ptr(LAS unsigned char* lds, int i) {
    const unsigned long long v = ((const LAS unsigned long long*)(lds + ARG_OFF))[i];
    const unsigned lo = __builtin_amdgcn_readfirstlane((unsigned)v), hi = __builtin_amdgcn_readfirstlane((unsigned)(v >> 32));
    return (const void*)(const __attribute__((address_space(1))) char*)(((unsigned long long)hi << 32) | lo);
}
#define INP(i) ((const float*)arg_ptr(lds, (i)))
#define OUTP() ((float*)arg_ptr(lds, 25))
#define WSP() ((unsigned char*)arg_ptr(lds, 26))


__device__ __forceinline__ size_t wt_image_off(int n, int k, int Kd) {
    const int pn = n >> 8, nr = n & 255, wc = nr >> 6, bj = (nr >> 5) & 1, x = nr & 31, rho = 16 * ((x >> 2) & 1) + 4 * (x >> 3) + (x & 3);
    const int kt = k >> 6, kk = k & 63;
    return ((size_t)((pn * (Kd >> 6) + kt) * 2 + bj) * 16384 + pg8::lds_byte(wc * 32 + rho, kk)) >> 1;
}
__device__ __forceinline__ size_t wt_image_off8(int n, int k, int Kd) {
    const int pn = n >> 8, nr = n & 255, wc = nr >> 6, bj = (nr >> 5) & 1, x = nr & 31, rho = 16 * ((x >> 2) & 1) + 4 * (x >> 3) + (x & 3);
    const int kt = k >> 7, kb = k & 127;
    return (size_t)((pn * (Kd >> 7) + kt) * 2 + bj) * 16384 + pg8::lds_byte(wc * 32 + rho, kb >> 1);
}
struct TrDesc { const float* W; const float* gain; bf16_t* WT; int N, k0, n0, Kd, drow0; int f8; float f8s; };
__device__ __forceinline__ void tr_load(const TrDesc& d, f32x4 (&v)[8], float (&g)[8], int lane) {
    const int kr = lane >> 3, n4 = (lane & 7) * 4;
#pragma unroll
    for (int i = 0; i < 8; ++i) { v[i] = *(const f32x4*)(d.W + (size_t)(d.k0 + 8 * i + kr) * d.N + d.n0 + n4); g[i] = d.gain ? d.gain[d.k0 + 8 * i + kr] : 1.f; }
}
__device__ __forceinline__ void tr_finish(const TrDesc& d, const f32x4 (&v)[8], const float (&g)[8], LAS float* scr, int lane) {
    const int kr = lane >> 3, n4 = (lane & 7) * 4;
#pragma unroll
    for (int i = 0; i < 8; ++i) { LAS float* q = scr + (8 * i + kr) * 33 + n4; q[0] = v[i][0] * g[i]; q[1] = v[i][1] * g[i]; q[2] = v[i][2] * g[i]; q[3] = v[i][3] * g[i]; }
    asm volatile("s_waitcnt lgkmcnt(0)" ::: "memory");
    if (d.f8) {
#pragma unroll
        for (int j = 0; j < 2; ++j) { const int pc = lane * 2 + j, n = pc >> 2, kg = pc & 3; const float fs = d.f8s;
            u32x4 o;
#pragma unroll
            for (int q = 0; q < 4; ++q) { const int kb = d.f8 == 2 ? (q >> 1) * 32 + 8 * kg + 4 * (q & 1) : 16 * kg + 4 * q; const LAS float* t = scr + kb * 33 + n;
                int r = cvt8(t[0] * fs, t[33] * fs, 0, false);
                r = cvt8(t[66] * fs, t[99] * fs, r, true); o[q] = (unsigned)r; }
            *(u32x4*)((unsigned char*)d.WT + wt_image_off8(d.drow0 + n, d.k0 + 16 * kg, d.Kd)) = o; }
        asm volatile("s_waitcnt lgkmcnt(0)" ::: "memory");
        return;
    }
    const int c = lane & 7;
#pragma unroll
    for (int j = 0; j < 4; ++j) { const int n = (lane >> 3) + 8 * j; const LAS float* t = scr + (8 * c) * 33 + n;
        u32x4 o; o.x = cvtpk(t[0 * 33], t[1 * 33]); o.y = cvtpk(t[2 * 33], t[3 * 33]); o.z = cvtpk(t[4 * 33], t[5 * 33]); o.w = cvtpk(t[6 * 33], t[7 * 33]);
        *(u32x4*)(d.WT + wt_image_off(d.drow0 + n, d.k0 + 8 * c, d.Kd)) = o; }
    asm volatile("s_waitcnt lgkmcnt(0)" ::: "memory");
}
struct Args { const float* in[25]; float* out; unsigned char* ws; };
enum { I_X = 0, I_RELB, I_ANORM, I_WQKV, I_QG, I_KG, I_LQ1, I_LK1, I_LQ2, I_LK2, I_SUBLN, I_WO, I_PNORM, I_PWIN, I_PWG, I_PWOUT, I_PSCALE, I_FNORM, I_RGW, I_RGB, I_REW, I_REB, I_WGATE, I_WUP, I_WDOWN };

__device__ __forceinline__ TrDesc tr_decode(LAS unsigned char* lds, unsigned char* ws, int it) {
    constexpr int N_QKV = 2 * 16 * 96, N_WO = 2 * 16 * 32, N_GU = 128 * 512, N_DN = 128 * 256;
    TrDesc d; d.f8 = 0; d.f8s = 1.f;
    if (it < N_GU) { const int le = it >> 9, r = it & 511, isup = r >> 8, r2 = r & 255, kb = r2 >> 4, nb = r2 & 15;
        d.W = (isup ? INP(I_WUP) : INP(I_WGATE)) + (size_t)le * 1024 * 512; d.N = 512; d.k0 = 64 * kb; d.n0 = 32 * nb; d.WT = (bf16_t*)(ws + WS_WGU + (size_t)le * 1024 * 1024); d.Kd = 1024;
        d.drow0 = 256 * (nb >> 2) + 64 * (nb & 3) + 32 * isup; d.gain = INP(I_FNORM) + (le >> 5) * 1024; d.f8 = 2; d.f8s = WG8_SCALE; return d; }
    it -= N_GU;
    if (it < N_DN) { const int le = it >> 8, r = it & 255, kb = r >> 5, nb = r & 31;
        d.W = INP(I_WDOWN) + (size_t)le * 512 * 1024; d.N = 1024; d.k0 = 64 * kb; d.n0 = 32 * nb; d.WT = (bf16_t*)(ws + WS_WDN + (size_t)le * 1024 * 512); d.Kd = 512; d.drow0 = 32 * nb; d.gain = nullptr; d.f8 = 1; d.f8s = WD8_SCALE; return d; }
    it -= N_DN;
    if (it < N_QKV) { const int l = it / 1536, r = it - l * 1536, kb = r / 96, nb = r - kb * 96;
        d.W = INP(I_WQKV) + (size_t)l * 1024 * 3072; d.N = 3072; d.k0 = 64 * kb; d.n0 = 32 * nb; d.WT = (bf16_t*)(ws + WS_WQKV) + (size_t)l * 3072 * 1024; d.Kd = 1024; d.drow0 = 32 * nb; d.gain = INP(I_ANORM) + l * 1024; return d; }
    it -= N_QKV;
    const bool po = it >= N_WO; if (po) it -= N_WO;
    { const int l = it >> 9, r = it & 511, kb = r >> 5, nb = r & 31;
      d.W = (po ? INP(I_PWOUT) : INP(I_WO)) + (size_t)l * 1024 * 1024; d.N = 1024; d.k0 = 64 * kb; d.n0 = 32 * nb; d.WT = (bf16_t*)(ws + (po ? WS_WPO : WS_WO) + (size_t)l * 1024 * 1024 * (po ? 1 : 2)); d.Kd = 1024; d.drow0 = 32 * nb; d.gain = nullptr; d.f8 = po ? 1 : 0; d.f8s = po ? WN8_SCALE : 1.f; }
    return d;
}
__device__ __forceinline__ void prologue(LAS unsigned char* lds) {
    const int tid = opaque_tid(), lane = tid & 63, wid = tid >> 6;
    LAS float* scr = (LAS float*)(lds + wid * 16384);
    const int gw = blockIdx.x * NWAVES + wid, NGW = gridDim.x * NWAVES;
    unsigned char* ws = WSP();
    constexpr int N_QKV = 2 * 16 * 96, N_WO = 2 * 16 * 32, N_GU = 128 * 512, N_DN = 128 * 256, N_PC = 2 * 64 * 16;
    constexpr int NTR = N_QKV + 2 * N_WO + N_GU + N_DN;
    if (gw < NTR) {
        TrDesc dA = tr_decode(lds, ws, gw), dB; f32x4 va[8], vb[8]; float ga[8], gb[8];
        tr_load(dA, va, ga, lane);
        for (int itA = gw;;) {
            const int itB = itA + NGW; const bool hasB = itB < NTR;
            if (hasB) { dB = tr_decode(lds, ws, itB); tr_load(dB, vb, gb, lane); }
            tr_finish(dA, va, ga, scr, lane);
            if (!hasB) break;
            itA = itB + NGW; const bool hasA = itA < NTR;
            if (hasA) { dA = tr_decode(lds, ws, itA); tr_load(dA, va, ga, lane); }
            tr_finish(dB, vb, gb, scr, lane);
            if (!hasA) break;
        }
    }
    for (int it = gw; it < N_PC; it += NGW) {
        {
            const int l = it >> 10, r = it & 1023, k0 = (r >> 4) * 16, n0 = (r & 15) * 64, g = n0 >> 8, e = (n0 & 255) + lane;
            const float* win = INP(I_PWIN) + (size_t)l * 1024 * 1024 + (size_t)k0 * 1024 + g * 256;
            const float* wgp = INP(I_PWG) + (size_t)l * 4 * 256 * 256 + (size_t)g * 256 * 256 + e;
            float acc[16];
#pragma unroll
            for (int kk = 0; kk < 16; ++kk) acc[kk] = 0.f;
            {
                f32x4 wv[16];
#pragma unroll
                for (int kk = 0; kk < 16; ++kk) wv[kk] = *(const f32x4*)(win + (size_t)kk * 1024 + 4 * lane);
#pragma unroll
                for (int kk = 0; kk < 16; ++kk) *(LAS f32x4*)(scr + kk * 256 + 4 * lane) = wv[kk];
                asm volatile("s_waitcnt lgkmcnt(0)" ::: "memory"); }
#pragma unroll 8
            for (int c4 = 0; c4 < 64; ++c4) {
                float b[4];
#pragma unroll
                for (int cc = 0; cc < 4; ++cc) b[cc] = wgp[(size_t)(4 * c4 + cc) * 256];
#pragma unroll
                for (int kk = 0; kk < 16; ++kk) { const f32x4 av = *(const LAS f32x4*)(scr + kk * 256 + 4 * c4); acc[kk] += (av[0] * b[0] + av[1] * b[1]) + (av[2] * b[2] + av[3] * b[3]); }
            }
            const float* pn = INP(I_PNORM) + l * 1024 + k0;
#pragma unroll
            for (int h8 = 0; h8 < 2; ++h8) {
                u32x4 o; o.x = cvtpk(acc[8 * h8 + 0] * pn[8 * h8 + 0], acc[8 * h8 + 1] * pn[8 * h8 + 1]); o.y = cvtpk(acc[8 * h8 + 2] * pn[8 * h8 + 2], acc[8 * h8 + 3] * pn[8 * h8 + 3]);
                o.z = cvtpk(acc[8 * h8 + 4] * pn[8 * h8 + 4], acc[8 * h8 + 5] * pn[8 * h8 + 5]); o.w = cvtpk(acc[8 * h8 + 6] * pn[8 * h8 + 6], acc[8 * h8 + 7] * pn[8 * h8 + 7]);
                *(u32x4*)((bf16_t*)(ws + WS_WPC) + (size_t)l * 1024 * 1024 + wt_image_off(n0 + lane, k0 + 8 * h8, 1024)) = o; }
            asm volatile("s_waitcnt lgkmcnt(0)" ::: "memory");
        }
    }
    float* rwt = (float*)(ws + WS_RWT); float* rwg = (float*)(ws + WS_RWG);
    { bf16_t* rwb = (bf16_t*)rwt;
      for (int i = blockIdx.x * NTHREADS + tid; i < DEPTH * NEXP * DM; i += gridDim.x * NTHREADS) { const int l = i >> 15, r = i & 32767, sx = r >> 9, ln = (r >> 3) & 63, jj = r & 7, k = 16 * sx + 8 * (ln >> 5) + jj, e = ln & 31;
        const float v = INP(I_FNORM)[l * 1024 + k] * INP(I_REW)[(size_t)l * 1024 * 32 + k * 32 + e];
        const unsigned hb = cvtpk(v, 0.f) & 0xffffu; const float vh = __builtin_bit_cast(float, hb << 16);
        rwb[(size_t)l * 65536 + r] = (bf16_t)hb; rwb[(size_t)l * 65536 + 32768 + r] = (bf16_t)(cvtpk(v - vh, 0.f) & 0xffffu); } }
    for (int i = blockIdx.x * NTHREADS + tid; i < DEPTH * DM * NGRP; i += gridDim.x * NTHREADS) { const int l = i >> 12, k = (i >> 2) & 1023;
        rwg[i] = INP(I_FNORM)[l * 1024 + k] * INP(I_RGW)[i]; }
}

__device__ __forceinline__ void moe_layer(LAS unsigned char* lds, const XcdBarrier& bar, const int L, const bool fin) {
    const LAS int* ts = (const LAS int*)(lds + TS_OFF);
    {   unsigned char* ws = WSP();
        router_pass((const bf16_t*)(ws + WS_XB), (const bf16_t*)(ws + WS_RWT) + (size_t)L * 65536, (const float*)(ws + WS_RWG) + (size_t)L * DM * NGRP, INP(I_RGB) + L * NGRP, INP(I_REB) + L * NEXP,
                    (float*)(ws + WS_RSFFN), (int*)(ws + WS_TOKE), (float*)(ws + WS_TOKW), (int*)(ws + WS_CNT), lds); }
    xcd_barrier(bar);
    {   unsigned char* ws = WSP();
        assign_pass((const int*)(ws + WS_CNT), (const int*)(ws + WS_TOKE), (const float*)(ws + WS_RSFFN), (int*)(ws + WS_TOKS), (int*)(ws + WS_SLOTTOK), (float*)(ws + WS_SLOTRS), lds); }
    xcd_barrier(bar);
    {   unsigned char* ws = WSP();
        GroupSched S; S.init_grid(); S.A = (const char*)(ws + WS_ACT + ACT_X8); S.lda = DM; S.slot_tok = (const int*)(ws + WS_SLOTTOK); S.Bt = (const char*)(ws + WS_WGU) + (size_t)L * NEXP * 1024 * 1024; S.strideE = (size_t)1024 * 1024; S.K = DM / 2; S.ts = ts;
        EpiGateUp E{ws + WS_ACT + ACT_H, (const float*)(ws + WS_SLOTRS)};
        int kx = DM; asm volatile("" : "+s"(kx));
        pg8::gemm_phase<EpiGateUp, GroupSched, true, true>(lds, kx, S, E); }
    xcd_barrier(bar);
    {   unsigned char* ws = WSP();
        GroupSched S; S.init_grid(); S.A = (const char*)(ws + WS_ACT + ACT_H); S.lda = EFF; S.slot_tok = nullptr; S.Bt = (const char*)(ws + WS_WDN) + (size_t)L * NEXP * 1024 * 512; S.strideE = (size_t)1024 * 512; S.K = EFF / 2; S.ts = ts;
        EpiY8 E{ws + WS_ACT + ACT_Y};
        int kx = EFF; asm volatile("" : "+s"(kx));
        pg8::gemm_phase<EpiY8, GroupSched, true, true>(lds, kx, S, E); }
    xcd_barrier(bar);
    {   unsigned char* ws = WSP(); float* xo = OUTP();
        if (fin) row_pass<2>(nullptr, xo, (bf16_t*)(ws + WS_XB), nullptr, (const unsigned char*)(ws + WS_ACT + ACT_Y), (const int*)(ws + WS_TOKS), (const float*)(ws + WS_TOKW), lds);
        else { row_pass<1>(nullptr, nullptr, (bf16_t*)(ws + WS_XB), (float*)(ws + WS_RSMIX), (const unsigned char*)(ws + WS_ACT + ACT_Y), (const int*)(ws + WS_TOKS), (const float*)(ws + WS_TOKW), lds); } }
    if (!fin) xcd_barrier(bar);
}

__global__ void __launch_bounds__(NTHREADS, 2) hybrid_fwd(Args a) {
    extern __shared__ __attribute__((aligned(16))) unsigned char lds_raw[];
    LAS unsigned char* lds = (LAS unsigned char*)lds_raw;
    volatile LAS unsigned* MISC = (volatile LAS unsigned*)(lds + MISC_OFF);
    const int tid = threadIdx.x;
    if (tid < 64) MISC[tid] = 0u;
    if (tid < 27) ((LAS unsigned long long*)(lds + ARG_OFF))[tid] = ((const __attribute__((address_space(4))) unsigned long long*)__builtin_amdgcn_kernarg_segment_ptr())[tid];
    __syncthreads();
    XcdBarrier bar = xcd_barrier_post((unsigned*)(a.ws + WS_CTL) + CW_BAR, MISC + 8);

    prologue(lds);
    {   unsigned char* ws = WSP();
        row_pass<0>(INP(I_X), nullptr, (bf16_t*)(ws + WS_XB), (float*)(ws + WS_RSMIX), nullptr, nullptr, nullptr, lds); }
    xcd_barrier(bar);

    for (int lp = 0; lp < 2; ++lp) {
        {   unsigned char* ws = WSP();
            PlainSched S; S.init_grid(); S.A = (const char*)(ws + WS_XB); S.lda = DM * 2; S.Bt = (const char*)(ws + WS_WQKV) + (size_t)lp * 3072 * 1024 * 2; S.K = DM; S.nN = 12; S.nrt = NTOK / 256;
            LAS float* gl = (LAS float*)(lds + attn::WSF_OFF);
            { const int t_ = opaque_tid(); if (t_ < 128) gl[t_] = t_ < 64 ? INP(I_QG)[lp * HD + t_] : INP(I_KG)[lp * HD + t_ - 64]; }
            __syncthreads();
            EpiQKV E{(bf16_t*)(ws + WS_ACT + ACT_Q), (const float*)(ws + WS_RSMIX), gl};
            pg8::gemm_phase<EpiQKV, PlainSched, true>(lds, DM, S, E); }
        xcd_barrier(bar);
        {   unsigned char* ws = WSP();
            const float* lq1 = INP(I_LQ1) + lp * HD; const float* lk1 = INP(I_LK1) + lp * HD; const float* lq2 = INP(I_LQ2) + lp * HD; const float* lk2 = INP(I_LK2) + lp * HD;
            float d1 = 0.f, d2 = 0.f;
            for (int i = 0; i < HD; ++i) { d1 += lq1[i] * lk1[i]; d2 += lq2[i] * lk2[i]; }
            const float li = 0.8f - 0.6f * expf(-0.3f * (float)(2 * lp));
            bf16_t* Qb = (bf16_t*)(ws + WS_ACT + ACT_Q);
            attn::Params P{Qb, Qb + (size_t)NTOK * DM, Qb + (size_t)2 * NTOK * DM, Qb, INP(I_RELB), INP(I_SUBLN) + lp * 128, expf(d1) - expf(d2) + li, 1.f - li};
            attn::attn_phase(P, lds); }
        xcd_barrier(bar);
        {   unsigned char* ws = WSP(); float* xo = OUTP();
            PlainSched S; S.init_grid(); S.A = (const char*)(ws + WS_ACT + ACT_Q); S.lda = DM * 2; S.Bt = (const char*)(ws + WS_WO) + (size_t)lp * 1024 * 1024 * 2; S.K = DM; S.nN = 4; S.nrt = NTOK / 256;
            EpiRes E{(bf16_t*)(ws + WS_XB), nullptr, ws + WS_ACT + ACT_X8, 1.f};
            pg8::gemm_phase<EpiRes, PlainSched, true>(lds, DM, S, E); }
        xcd_barrier(bar);
        moe_layer(lds, bar, 2 * lp, false);
        {   unsigned char* ws = WSP();
            PlainSched S; S.init_grid(); S.A = (const char*)(ws + WS_XB); S.lda = DM * 2; S.Bt = (const char*)(ws + WS_WPC) + (size_t)lp * 1024 * 1024 * 2; S.K = DM; S.nN = 4; S.nrt = NTOK / 256;
            EpiBf16 E{(bf16_t*)(ws + WS_ACT + ACT_U), DM, (const float*)(ws + WS_RSMIX)};
            pg8::gemm_phase<EpiBf16, PlainSched, true>(lds, DM, S, E); }
        xcd_barrier(bar);
        {   unsigned char* ws = WSP(); pool_pass((const bf16_t*)(ws + WS_ACT + ACT_U), ws + WS_ACT + ACT_P); }
        xcd_barrier(bar);
        {   unsigned char* ws = WSP(); float* xo = OUTP();
            PlainSched S; S.init_grid(); S.A = (const char*)(ws + WS_ACT + ACT_P); S.lda = DM; S.Bt = (const char*)(ws + WS_WPO) + (size_t)lp * 1024 * 1024; S.K = DM / 2; S.nN = 4; S.nrt = NTOK / 256;
            EpiRes E{(bf16_t*)(ws + WS_XB), INP(I_PSCALE) + lp * DM, ws + WS_ACT + ACT_X8, 1.f / (A8_SCALE * WN8_SCALE)};
            int kx = DM; asm volatile("" : "+s"(kx));
            pg8::gemm_phase<EpiRes, PlainSched, true, true>(lds, kx, S, E); }
        xcd_barrier(bar);
        moe_layer(lds, bar, 2 * lp + 1, lp == 1);
    }
}

extern "C" void kernel_launch(void* const* d_in, const int* in_sizes, int n_in, void* d_out, int out_size, void* d_ws, size_t ws_size, hipStream_t stream) {
    static int grid = 0;
    if (grid == 0) {
        if (n_in != 25 || out_size != NTOK * DM || ws_size < WS_END) { fprintf(stderr, "kernel_launch: unexpected problem (n_in %d, out %d, ws %zu)\n", n_in, out_size, ws_size); grid = -1; return; }
        int dev = 0, cus = 0;
        if (hipGetDevice(&dev) != hipSuccess || hipDeviceGetAttribute(&cus, hipDeviceAttributeMultiprocessorCount, dev) != hipSuccess) { grid = -1; return; }
        if (hipFuncSetAttribute((const void*)hybrid_fwd, hipFuncAttributeMaxDynamicSharedMemorySize, LDS_BYTES) != hipSuccess) { fprintf(stderr, "kernel_launch: hipFuncSetAttribute failed\n"); grid = -1; return; }
        int per_cu = 0;
        if (hipOccupancyMaxActiveBlocksPerMultiprocessor(&per_cu, (const void*)hybrid_fwd, NTHREADS, LDS_BYTES) != hipSuccess || per_cu < 1) fprintf(stderr, "kernel_launch: occupancy query says %d\n", per_cu);
        (void)hipGetLastError();
        grid = cus > 256 ? 256 : cus;
    }
    if (grid < 0) return;
    (void)hipMemsetAsync((char*)d_ws + WS_CTL, 0, CTL_ZERO_BYTES, stream);
    Args a{};
    for (int i = 0; i < 25; ++i) a.in[i] = (const float*)d_in[i];
    a.out = (float*)d_out; a.ws = (unsigned char*)d_ws;
    hipLaunchKernelGGL(hybrid_fwd, dim3(grid), dim3(NTHREADS), LDS_BYTES, stream, a);
}
```

```cpp
#include <hip/hip_runtime.h>
#include <cstdio>
#include <cstdint>

#define GAS __attribute__((address_space(1)))
#define LAS __attribute__((address_space(3)))
typedef unsigned short bf16_t;
typedef short bf16x8 __attribute__((ext_vector_type(8)));
typedef short s16x4 __attribute__((ext_vector_type(4)));
typedef float f32x2 __attribute__((ext_vector_type(2)));
typedef float f32x4 __attribute__((ext_vector_type(4)));
typedef float f32x16 __attribute__((ext_vector_type(16)));
typedef unsigned u32x2 __attribute__((ext_vector_type(2)));
typedef unsigned u32x4 __attribute__((ext_vector_type(4)));
typedef int i32x8 __attribute__((ext_vector_type(8)));
typedef __bf16 bf16x2_t __attribute__((ext_vector_type(2)));

constexpr int NB = 16, SEQ = 4096, DM = 1024, NTOK = NB * SEQ, DEPTH = 4;
constexpr int NHEAD = 8, HD = 64;
constexpr int NEXP = 32, EPG = 8, NGRP = 4, EFF = 512;
constexpr int MAXSLOT = 139264;
constexpr float EPS = 1e-6f;
constexpr float LOG2E = 1.4426950408889634f;
constexpr int NWAVES = 8, NTHREADS = 512;

constexpr size_t MiB = 1u << 20;
constexpr size_t WS_CTL = 0, CTL_ZERO_BYTES = 1 * MiB;
constexpr size_t WS_RSMIX = 4 * MiB;
constexpr size_t WS_RSFFN = WS_RSMIX + 256 * 1024;
constexpr size_t WS_TOKE = WS_RSFFN + 256 * 1024;
constexpr size_t WS_TOKW = WS_TOKE + 512 * 1024;
constexpr size_t WS_TOKS = WS_TOKW + 512 * 1024;
constexpr size_t WS_SLOTTOK = WS_TOKS + 512 * 1024;
constexpr size_t WS_SLOTRS = WS_SLOTTOK + 576 * 1024;
constexpr size_t WS_CNT = WS_SLOTRS + 576 * 1024;
constexpr size_t WS_RWT = WS_CNT + 64 * 1024;
constexpr size_t WS_RWG = WS_RWT + 512 * 1024;
constexpr size_t WS_SMALL_END = WS_RWG + 64 * 1024;
static_assert(WS_SMALL_END <= 16 * MiB, "small arrays");
constexpr size_t WS_WQKV = 16 * MiB;
constexpr size_t WS_WO = WS_WQKV + 12 * MiB;
constexpr size_t WS_WPC = WS_WO + 4 * MiB;
constexpr size_t WS_WPO = WS_WPC + 4 * MiB;
constexpr size_t WS_WGU = WS_WPO + 4 * MiB;
constexpr size_t WS_WDN = WS_WGU + 256 * MiB;
constexpr size_t WS_XB = WS_WDN + 128 * MiB;
constexpr size_t WS_ACT = WS_XB + 128 * MiB;
constexpr size_t WS_END = WS_ACT + 408 * MiB;
static_assert(WS_END <= 1126807104ull, "d_ws map exceeds the guaranteed workspace");
constexpr float A8_SCALE = 8.f, WN8_SCALE = 64.f;
constexpr size_t ACT_Q = 0, ACT_K = 128 * MiB, ACT_V = 256 * MiB;
constexpr size_t ACT_U = 0, ACT_P = 128 * MiB;
constexpr size_t ACT_H = 0, ACT_Y = 136 * MiB, ACT_X8 = 288 * MiB;
constexpr int CW_BAR = 4096;
constexpr int CW_TILES = 16384;

constexpr int RING_BYTES = 131072;
constexpr int LUT_OFF = RING_BYTES;
constexpr int LUT_N = 336;
constexpr int MISC_OFF = LUT_OFF + NHEAD * LUT_N * 4;
constexpr int TS_OFF = MISC_OFF + 256;
constexpr int LDS_BYTES = 147456;
static_assert(TS_OFF + 256 <= LDS_BYTES, "LDS map");

#define RLX_AGENT __ATOMIC_RELAXED, __HIP_MEMORY_SCOPE_AGENT
__device__ __forceinline__ unsigned cvtpk(float lo, float hi) { f32x2 v = {lo, hi}; bf16x2_t b = __builtin_convertvector(v, bf16x2_t); return __builtin_bit_cast(unsigned, b); }
__device__ __forceinline__ float bf2f(unsigned short h) { return __builtin_bit_cast(float, (unsigned)h << 16); }
__device__ __forceinline__ float wave_sum(float v) {
#pragma unroll
    for (int o = 1; o < 64; o <<= 1) v += __shfl_xor(v, o);
    return v;
}

__device__ __forceinline__ int opaque_tid() { int t = threadIdx.x; asm volatile("" : "+v"(t)); return t; }

#define XB_TMO      128
#define XB_XCNT(j)  (256  + 64 * (j))
#define XB_XSUB(j)  (1280 + 64 * (j))
#define XB_XGEN(j)  (2304 + 64 * (j))
#define XB_TOP      3328
#define XB_TOPGEN   3392
#define XCD_BAR_WORDS 3456
#define XB_SPIN_CAP (1u << 18)
__device__ __forceinline__ unsigned xb_ld(unsigned* p)              { return __hip_atomic_load(p, __ATOMIC_RELAXED, __HIP_MEMORY_SCOPE_AGENT); }
__device__ __forceinline__ unsigned xb_add(unsigned* p, unsigned v) { return __hip_atomic_fetch_add(p, v, __ATOMIC_RELAXED, __HIP_MEMORY_SCOPE_AGENT); }
__device__ __forceinline__ unsigned xb_xcc_id() { return (unsigned)__builtin_amdgcn_s_getreg((3 << 11) | 20) & 0xFu; }
#define XB_SPIN(cond, bar) do { unsigned _sp = 0; while (cond) { __builtin_amdgcn_s_sleep(1); \
    if ((++_sp & 255u) == 0u) { if (xb_ld(&(bar)[XB_TMO])) break; if (_sp > XB_SPIN_CAP) { atomicAdd(&(bar)[XB_TMO], 1u); break; } } } } while (0)
struct XcdBarrier { unsigned* bar; unsigned x; volatile LAS unsigned* st; };
__device__ __forceinline__ XcdBarrier xcd_barrier_post(unsigned* bar, volatile LAS unsigned* st) {
    XcdBarrier b; b.bar = bar; b.x = xb_xcc_id(); b.st = st;
    if (threadIdx.x == 0) (void)xb_add(&bar[XB_XCNT(b.x)], 1u);
    return b;
}
__device__ __forceinline__ void xcd_barrier_complete(unsigned* bar, unsigned x, unsigned& nloc, unsigned& nx) {
    const unsigned G = gridDim.x * gridDim.y * gridDim.z;
    unsigned sum, cnt, mine, sp = 0u;
    for (;;) {
        sum = 0u; cnt = 0u; mine = 0u;
#pragma unroll
        for (unsigned j = 0; j < 16; ++j) { const unsigned c = xb_ld(&bar[XB_XCNT(j)]); sum += c; cnt += (c > 0u) ? 1u : 0u; mine = (j == x) ? c : mine; }
        if (sum == G) break;
        __builtin_amdgcn_s_sleep(1);
        if ((++sp & 255u) == 0u) { if (xb_ld(&bar[XB_TMO])) break; if (sp > XB_SPIN_CAP) { atomicAdd(&bar[XB_TMO], 1u); break; } }
    }
    nloc = mine > 0u ? mine : 1u; nx = cnt > 0u ? cnt : 1u;
}
__device__ __forceinline__ void xcd_barrier(const XcdBarrier& b) {
    asm volatile("s_waitcnt vmcnt(0)" ::: "memory");
    __syncthreads();
    if (threadIdx.x == 0) {
        unsigned* bar = b.bar;
        __builtin_amdgcn_s_waitcnt(0);
        unsigned nloc = b.st[0], nx = b.st[1];
        if (nloc == 0u) { xcd_barrier_complete(bar, b.x, nloc, nx); b.st[0] = nloc; b.st[1] = nx; }
        const unsigned old = xb_add(&bar[XB_XSUB(b.x)], 1u);
        const unsigned gen = old / nloc;
        if (old + 1u == (gen + 1u) * nloc) {
            __builtin_amdgcn_fence(__ATOMIC_RELEASE, "agent");
            asm volatile("s_waitcnt vmcnt(0)" ::: "memory");
            const unsigned og = xb_add(&bar[XB_TOP], 1u);
            const unsigned tg = og / nx;
            if (og + 1u == (tg + 1u) * nx) xb_add(&bar[XB_TOPGEN], 1u);
            else XB_SPIN(xb_ld(&bar[XB_TOPGEN]) == tg, bar);
            __builtin_amdgcn_fence(__ATOMIC_ACQUIRE, "agent");
            xb_add(&bar[XB_XGEN(b.x)], 1u);
            asm volatile("s_waitcnt vmcnt(0)" ::: "memory");
        } else {
            XB_SPIN(xb_ld(&bar[XB_XGEN(b.x)]) == gen, bar);
            __builtin_amdgcn_fence(__ATOMIC_ACQUIRE, "agent");
            asm volatile("s_waitcnt vmcnt(0)" ::: "memory");
        }
    }
    __syncthreads();
}

namespace pg8 {
constexpr int BM = 256, BK = 64, HALF = 128, HTB = HALF * BK * 2, STAGE_BYTES = 8 * HTB;
__host__ __device__ __forceinline__ int lds_byte(int r, int c) { const int st = (r >> 4) * 2 + (c >> 5), rr = r & 15, cc = c & 31, ob = rr * 64 + cc * 2; return st * 1024 + (ob ^ (((ob >> 9) & 1) << 5)); }
__host__ __device__ __forceinline__ void stage_rc(int b, int& R, int& C) { const int st = b / 1024, sb = b % 1024, swz = sb ^ (((sb >> 9) & 1) << 5); R = (st >> 1) * 16 + swz / 64; C = (st & 1) * 32 + (swz % 64) / 2; }
__host__ __device__ __forceinline__ int perm32(int rho) { const int n = rho >> 4, i = rho & 15; return 8 * (i >> 2) + 4 * n + (i & 3); }
struct Unit { int pm, pn, e; };

template <class Epi, class Sched, bool ALIGN_EPI, bool FP8 = false>
__device__ __forceinline__ void gemm_phase(LAS unsigned char* lds, const int K, const Sched& S, const Epi& E) {
    const int tid = opaque_tid(), wid = __builtin_amdgcn_readfirstlane(tid >> 6), lane = tid & 63, wr = wid >> 2, wc = wid & 3, fr = lane & 15, fq = lane >> 4;
    const int nt = FP8 ? K / 128 : K / BK;
    int RA[2], CA[2]; unsigned voffB[2];
#pragma unroll
    for (int i = 0; i < 2; ++i) { int R, C; stage_rc(tid * 16 + i * 8192, R, C); RA[i] = R; CA[i] = C * 2;
        voffB[i] = (unsigned)(tid * 16 + i * 8192); }
    const size_t kstep = (size_t)(BK * 2);
    const size_t hstepB = 16384, kstepB = 32768;
    const unsigned ldsw = (unsigned)wid * 1024u;
    const int aoff = lds_byte(wr * 64 + fr, fq * 8), boff = lds_byte(wc * 32 + fr, fq * 8);
    const int aoff8 = lds_byte(wr * 64 + fr, fq * 16), boff8 = lds_byte(wc * 32 + fr, fq * 16);
#define PG8_SA(b, h) (((b) * 2 + (h)) * HTB)
#define PG8_SB(b, h) ((4 + (b) * 2 + (h)) * HTB)
#define PG8_STAGE(bufoff, gbase, v0, v1) do { const char* gb_ = (const char*)(gbase); unsigned v0_ = (v0), v1_ = (v1); asm volatile("" : "+s"(gb_), "+v"(v0_), "+v"(v1_)); \
        __builtin_amdgcn_global_load_lds((const unsigned*)(gb_ + v0_), (LAS unsigned*)(lds + (bufoff) + ldsw), 16, 0, 0); \
        __builtin_amdgcn_global_load_lds((const unsigned*)(gb_ + v1_), (LAS unsigned*)(lds + (bufoff) + ldsw + 8192), 16, 0, 0); } while (0)
#define PG8_STAGEA(bufoff, gbase, V, h) PG8_STAGE(bufoff, gbase, V[h][0], V[h][1])
#define PG8_STAGEB(bufoff, gbase) PG8_STAGE(bufoff, gbase, voffB[0], voffB[1])
#define PG8_LDA(dst, b, h) do { if constexpr (FP8) { _Pragma("unroll") for (int m = 0; m < 4; ++m) { const u32x4 l_ = *(const LAS u32x4*)(lds + PG8_SA(b, h) + aoff8 + m * 2048), h_ = *(const LAS u32x4*)(lds + PG8_SA(b, h) + aoff8 + m * 2048 + 16); \
            dst##8[m] = (i32x8){(int)l_.x, (int)l_.y, (int)l_.z, (int)l_.w, (int)h_.x, (int)h_.y, (int)h_.z, (int)h_.w}; } } \
        else { _Pragma("unroll") for (int m = 0; m < 4; ++m) _Pragma("unroll") for (int k = 0; k < 2; ++k) dst[m][k] = *(const LAS bf16x8*)(lds + PG8_SA(b, h) + aoff + m * 2048 + k * 1024); } } while (0)
#define PG8_LDB(dst, b, h) do { if constexpr (FP8) { _Pragma("unroll") for (int n = 0; n < 2; ++n) { const u32x4 l_ = *(const LAS u32x4*)(lds + PG8_SB(b, h) + boff8 + n * 2048), h_ = *(const LAS u32x4*)(lds + PG8_SB(b, h) + boff8 + n * 2048 + 16); \
            dst##8[n] = (i32x8){(int)l_.x, (int)l_.y, (int)l_.z, (int)l_.w, (int)h_.x, (int)h_.y, (int)h_.z, (int)h_.w}; } } \
        else { _Pragma("unroll") for (int n = 0; n < 2; ++n) _Pragma("unroll") for (int k = 0; k < 2; ++k) dst[n][k] = *(const LAS bf16x8*)(lds + PG8_SB(b, h) + boff + n * 2048 + k * 1024); } } while (0)
#define PG8_MMA(ai, bj, At, Bt) do { __builtin_amdgcn_s_setprio(1); \
        if constexpr (FP8) { _Pragma("unroll") for (int m = 0; m < 4; ++m) _Pragma("unroll") for (int n = 0; n < 2; ++n) \
            acc[ai][bj][m][n] = __builtin_amdgcn_mfma_scale_f32_16x16x128_f8f6f4(Bt##8[n], At##8[m], acc[ai][bj][m][n], 0, 0, 0, 0x7f7f7f7f, 0, 0x7f7f7f7f); } \
        else { _Pragma("unroll") for (int m = 0; m < 4; ++m) _Pragma("unroll") for (int n = 0; n < 2; ++n) _Pragma("unroll") for (int k = 0; k < 2; ++k) \
            acc[ai][bj][m][n] = __builtin_amdgcn_mfma_f32_16x16x32_bf16(Bt[n][k], At[m][k], acc[ai][bj][m][n], 0, 0, 0); } \
        __builtin_amdgcn_s_setprio(0); } while (0)
#define PG8_WAIT_V(n) asm volatile("s_waitcnt vmcnt(" #n ")" ::: "memory")
#define PG8_WAIT_L(n) asm volatile("s_waitcnt lgkmcnt(" #n ")" ::: "memory")
#define PG8_BAR __builtin_amdgcn_s_barrier()
#define PG8_SCHED __builtin_amdgcn_sched_barrier(0)
#define PG8_SCHED8 do { if constexpr (FP8) __builtin_amdgcn_sched_barrier(0); } while (0)
    Unit cur, nxt; int ui = 0;
    if (!S.next(0, cur)) return;
    f32x4 acc[2][2][4][2];
#pragma unroll
    for (int a = 0; a < 2; ++a)
#pragma unroll
        for (int b = 0; b < 2; ++b)
#pragma unroll
            for (int m = 0; m < 4; ++m)
#pragma unroll
                for (int n = 0; n < 2; ++n) acc[a][b][m][n] = (f32x4){0.f, 0.f, 0.f, 0.f};
    bf16x8 At[4][2], B0[2][2], B1[2][2]; i32x8 At8[4], B08[2], B18[2];
    const char* const Ab = S.a_base();
    unsigned cvA[2][2];
#pragma unroll
    for (int h = 0; h < 2; ++h)
#pragma unroll
        for (int i = 0; i < 2; ++i) cvA[h][i] = S.a_row_off(cur, h * HALF + RA[i]) + (unsigned)CA[i];
    const char* cB = S.b_base(cur);
    PG8_STAGEB(PG8_SB(0, 0), cB); PG8_STAGEB(PG8_SB(0, 1), cB + hstepB); PG8_STAGEA(PG8_SA(0, 0), Ab, cvA, 0); PG8_STAGEA(PG8_SA(0, 1), Ab, cvA, 1);
    if (wr == 1) PG8_BAR;
    PG8_WAIT_V(2); PG8_BAR;
    PG8_STAGEB(PG8_SB(1, 0), cB + kstepB); PG8_STAGEA(PG8_SA(1, 0), Ab + kstep, cvA, 0); PG8_STAGEB(PG8_SB(1, 1), cB + hstepB + kstepB);
    PG8_WAIT_V(6); PG8_BAR;
    for (;;) {
        const bool has_next = S.next(ui + 1, nxt);
        const char* nB = has_next ? S.b_base(nxt) : cB;
        for (int t = 0; t < nt; t += 2) {
            const bool last = (t == nt - 2);
            const char* a1 = Ab + (size_t)(t + 1) * kstep;
            const char* a2 = last ? Ab : Ab + (size_t)(t + 2) * kstep; const char* b2 = last ? nB : cB + (size_t)(t + 2) * kstepB;
            const char* a3 = a2 + kstep; const char* b3 = b2 + kstepB;
            PG8_LDB(B0, 0, 0); PG8_LDB(B1, 0, 1); PG8_SCHED; PG8_LDA(At, 0, 0); PG8_STAGEA(PG8_SA(1, 1), a1, cvA, 1);
            if (last && has_next) {
#pragma unroll
                for (int h = 0; h < 2; ++h)
#pragma unroll
                    for (int i = 0; i < 2; ++i) cvA[h][i] = S.a_row_off(nxt, h * HALF + RA[i]) + (unsigned)CA[i]; }
            PG8_WAIT_V(8); PG8_WAIT_L(0); PG8_BAR; PG8_SCHED8; PG8_MMA(0, 0, At, B0); PG8_MMA(0, 1, At, B1); PG8_SCHED8; PG8_BAR; PG8_SCHED;
            PG8_LDA(At, 0, 1); PG8_STAGEB(PG8_SB(0, 0), b2); PG8_STAGEB(PG8_SB(0, 1), b2 + hstepB); PG8_STAGEA(PG8_SA(0, 0), a2, cvA, 0);
            PG8_WAIT_V(8); PG8_WAIT_L(0); PG8_BAR; PG8_SCHED8; PG8_MMA(1, 0, At, B0); PG8_MMA(1, 1, At, B1); PG8_SCHED8; PG8_BAR; PG8_SCHED;
            PG8_LDB(B0, 1, 0); PG8_LDB(B1, 1, 1); PG8_SCHED; PG8_LDA(At, 1, 0); PG8_STAGEA(PG8_SA(0, 1), a2, cvA, 1);
            PG8_WAIT_V(8); PG8_WAIT_L(0); PG8_BAR; PG8_SCHED8; PG8_MMA(0, 0, At, B0); PG8_MMA(0, 1, At, B1); PG8_SCHED8; PG8_BAR; PG8_SCHED;
            PG8_LDA(At, 1, 1); PG8_STAGEB(PG8_SB(1, 0), b3); PG8_STAGEB(PG8_SB(1, 1), b3 + hstepB); PG8_STAGEA(PG8_SA(1, 0), a3, cvA, 0);
            PG8_WAIT_V(8); PG8_WAIT_L(0); PG8_BAR; PG8_SCHED8; PG8_MMA(1, 0, At, B0); PG8_MMA(1, 1, At, B1); PG8_SCHED8; PG8_BAR; PG8_SCHED;
        }
        if constexpr (ALIGN_EPI) { if (wr == 0) PG8_BAR; }
        E(acc, cur, wr, wc, fr, fq);
        if (!has_next) break;
#pragma unroll
        for (int a = 0; a < 2; ++a)
#pragma unroll
            for (int b = 0; b < 2; ++b)
#pragma unroll
                for (int m = 0; m < 4; ++m)
#pragma unroll
                    for (int n = 0; n < 2; ++n) acc[a][b][m][n] = (f32x4){0.f, 0.f, 0.f, 0.f};
        cur = nxt; cB = nB; ++ui;
        if constexpr (ALIGN_EPI) { if (wr == 1) PG8_BAR; }
    }
    PG8_WAIT_V(0);
    if constexpr (!ALIGN_EPI) { if (wr == 0) PG8_BAR; }
    PG8_BAR;
#undef PG8_SA
#undef PG8_SB
#undef PG8_STAGE
#undef PG8_STAGEA
#undef PG8_STAGEB
#undef PG8_LDA
#undef PG8_LDB
#undef PG8_MMA
#undef PG8_WAIT_V
#undef PG8_WAIT_L
#undef PG8_BAR
#undef PG8_SCHED
#undef PG8_SCHED8
}
}

struct SchedBase { int x, j, G8, NGp; __device__ __forceinline__ void init_grid() { const int G = gridDim.x, bx = blockIdx.x; if (G % 8 == 0) { NGp = 8; x = bx % 8; j = bx / 8; G8 = G / 8; } else { NGp = 1; x = 0; j = bx; G8 = G; } } };
struct PlainSched : SchedBase {
    const char* A; unsigned lda; const char* Bt; int K, nN, nrt;
    __device__ __forceinline__ bool next(int i, pg8::Unit& u) const { const int U = i * G8 + j, nrtg = (nrt - x + NGp - 1) / NGp; if (U >= nrtg * nN) return false; const int q = U / nN; u.pn = U - q * nN; u.pm = x + NGp * q; return true; }
    __device__ __forceinline__ const char* a_base() const { return A; }
    __device__ __forceinline__ unsigned a_row_off(const pg8::Unit& u, int r) const { return (unsigned)(u.pm * 256 + r) * lda; }
    __device__ __forceinline__ const char* b_base(const pg8::Unit& u) const { return Bt + (size_t)u.pn * 256 * K * 2; }
};
struct GroupSched : SchedBase {
    const char* A; unsigned lda; const int* slot_tok; const char* Bt; size_t strideE; int K; const LAS int* ts;
    __device__ __forceinline__ bool next(int i, pg8::Unit& u) const {
        const int U = i * G8 + j; int q = U >> 2; u.pn = U & 3;
        for (int e = x; e < NEXP; e += NGp) { const int t0 = __builtin_amdgcn_readfirstlane(ts[e]), n = __builtin_amdgcn_readfirstlane(ts[e + 1]) - t0; if (q < n) { u.pm = t0 + q; u.e = e; return true; } q -= n; }
        return false; }
    __device__ __forceinline__ const char* a_base() const { return A; }
    __device__ __forceinline__ unsigned a_row_off(const pg8::Unit& u, int r) const { int row = u.pm * 256 + r; if (slot_tok) row = slot_tok[row]; return (unsigned)row * lda; }
    __device__ __forceinline__ const char* b_base(const pg8::Unit& u) const { return Bt + (size_t)u.e * strideE + (size_t)u.pn * 256 * K * 2; }
};

typedef f32x4 Acc[2][2][4][2];
struct EpiQKV {
    bf16_t* Q; const float* rstd; const LAS float* gl;
    __device__ __forceinline__ void operator()(const Acc& acc, const pg8::Unit& u, int wr, int wc, int fr, int fq) const {
        const int part = u.pn >> 2, colp = (u.pn & 3) * 256 + wc * 64 + 8 * fq;
        bf16_t* base = Q + (size_t)part * NTOK * DM;
        const float qs = part == 0 ? 0.125f * LOG2E : 1.f;
#pragma unroll
        for (int ai = 0; ai < 2; ++ai)
#pragma unroll
            for (int m = 0; m < 4; ++m) {
                const int row = u.pm * 256 + ai * 128 + wr * 64 + m * 16 + fr;
                const float rs = rstd[row];
                float f = rs;
                if (part < 2) { float ss = 0.f;
#pragma unroll
                    for (int bj = 0; bj < 2; ++bj)
#pragma unroll
                        for (int n = 0; n < 2; ++n) { const f32x4 t = acc[ai][bj][m][n] * rs; const f32x4 t2 = t * t; ss += (t2[0] + t2[1]) + (t2[2] + t2[3]); }
                    ss += __shfl_xor(ss, 16); ss += __shfl_xor(ss, 32); f = rs * __builtin_amdgcn_rsqf(ss * (1.f / 64.f) + EPS) * qs; }
                const int hh = (u.pn & 3) * 2 + (wc >> 1), tl = (row & (SEQ - 1)) >> 6, rr = row & 63;
                const size_t tb = ((size_t)((row >> 12) * NHEAD + hh) * 64 + tl) * 8192;
#pragma unroll
                for (int bj = 0; bj < 2; ++bj) {
                    f32x4 g0 = {f, f, f, f}, g1 = g0;
                    if (part < 2) { const LAS f32x4* gp = (const LAS f32x4*)(gl + part * 64 + 32 * bj + 8 * fq); g0 = gp[0] * f; g1 = gp[1] * f; }
                    const f32x4 a = acc[ai][bj][m][0] * g0, b = acc[ai][bj][m][1] * g1;
                    u32x4 w; w.x = cvtpk(a[0], a[1]); w.y = cvtpk(a[2], a[3]); w.z = cvtpk(b[0], b[1]); w.w = cvtpk(b[2], b[3]);
                    if (part == 0) *(u32x4*)(base + (size_t)row * DM + colp + 32 * bj) = w;
                    else if (part == 1) *(u32x4*)(base + tb + ((wc & 1) * 8 + 4 * bj + fq) * 512 + rr * 8) = w;
                    else *(u32x4*)(base + tb + (2 * (wc & 1) + bj) * 2048 + rr * 32 + 8 * fq) = w; }
            }
    }
};
__device__ __forceinline__ int cvt8(float a, float b, int old, bool hi) {
    a = __builtin_amdgcn_fmed3f(a, -448.f, 448.f); b = __builtin_amdgcn_fmed3f(b, -448.f, 448.f);
    return hi ? __builtin_amdgcn_cvt_pk_fp8_f32(a, b, old, true) : __builtin_amdgcn_cvt_pk_fp8_f32(a, b, old, false);
}
struct EpiBf16 {
    bf16_t* O; int ldc; const float* rstd;
    __device__ __forceinline__ void operator()(const Acc& acc, const pg8::Unit& u, int wr, int wc, int fr, int fq) const {
        const int col = u.pn * 256 + wc * 64 + 8 * fq;
        float rsv[2][4];
#pragma unroll
        for (int ai = 0; ai < 2; ++ai)
#pragma unroll
            for (int m = 0; m < 4; ++m) rsv[ai][m] = rstd ? rstd[u.pm * 256 + ai * 128 + wr * 64 + m * 16 + fr] : 1.f;
        asm volatile("" : "+v"(rsv[0][0]), "+v"(rsv[0][1]), "+v"(rsv[0][2]), "+v"(rsv[0][3]), "+v"(rsv[1][0]), "+v"(rsv[1][1]), "+v"(rsv[1][2]), "+v"(rsv[1][3]) :: "memory");
#pragma unroll
        for (int ai = 0; ai < 2; ++ai)
#pragma unroll
            for (int m = 0; m < 4; ++m) {
                const int row = u.pm * 256 + ai * 128 + wr * 64 + m * 16 + fr;
                const float rs = rsv[ai][m];
#pragma unroll
                for (int bj = 0; bj < 2; ++bj) { const f32x4 a = acc[ai][bj][m][0] * rs, b = acc[ai][bj][m][1] * rs; u32x4 w; w.x = cvtpk(a[0], a[1]); w.y = cvtpk(a[2], a[3]); w.z = cvtpk(b[0], b[1]); w.w = cvtpk(b[2], b[3]);
                    *(u32x4*)(O + (size_t)row * ldc + col + 32 * bj) = w; }
            }
    }
};
constexpr float Y8_SCALE = 16.f;
struct EpiY8 {
    static constexpr int NSTORES = 8;
    unsigned char* Y;
    __device__ __forceinline__ void operator()(const Acc& acc, const pg8::Unit& u, int wr, int wc, int fr, int fq) const {
        const int pos = u.pn * 256 + wc * 64 + 16 * fq;
        constexpr float YS = Y8_SCALE / (16.f * 64.f);
#pragma unroll
        for (int ai = 0; ai < 2; ++ai)
#pragma unroll
            for (int m = 0; m < 4; ++m) {
                const int row = u.pm * 256 + ai * 128 + wr * 64 + m * 16 + fr;
                u32x4 w;
#pragma unroll
                for (int bj = 0; bj < 2; ++bj) { const f32x4 a = acc[ai][bj][m][0] * YS, b = acc[ai][bj][m][1] * YS;
                    int lo = cvt8(a[0], a[1], 0, false); lo = cvt8(a[2], a[3], lo, true);
                    int hi = cvt8(b[0], b[1], 0, false); hi = cvt8(b[2], b[3], hi, true);
                    w[2 * bj] = (unsigned)lo; w[2 * bj + 1] = (unsigned)hi; }
                *(u32x4*)(Y + (size_t)row * DM + pos) = w;
            }
    }
};
constexpr float X8_SCALE = 4.f, WG8_SCALE = 64.f;
struct EpiRes {
    bf16_t* xb; const float* scale; unsigned char* x8; float mul;
    __device__ __forceinline__ void operator()(const Acc& acc, const pg8::Unit& u, int wr, int wc, int fr, int fq) const {
        const int col = u.pn * 256 + wc * 64 + 8 * fq;
        f32x4 sc[2][2];
#pragma unroll
        for (int bj = 0; bj < 2; ++bj)
#pragma unroll
            for (int n = 0; n < 2; ++n) sc[bj][n] = (scale ? *(const f32x4*)(scale + col + 32 * bj + 4 * n) : (f32x4){1.f, 1.f, 1.f, 1.f}) * mul;
#pragma unroll
        for (int ai = 0; ai < 2; ++ai) {
            u32x4 r[2][4][2];
#pragma unroll
            for (int m = 0; m < 4; ++m)
#pragma unroll
                for (int bj = 0; bj < 2; ++bj) r[ai][m][bj] = *(const u32x4*)(xb + (size_t)(u.pm * 256 + ai * 128 + wr * 64 + m * 16 + fr) * DM + col + 32 * bj);
            asm volatile("" ::: "memory");
#pragma unroll
            for (int m = 0; m < 4; ++m) {
                const size_t off = (size_t)(u.pm * 256 + ai * 128 + wr * 64 + m * 16 + fr) * DM + col;
                u32x4 w8;
#pragma unroll
                for (int bj = 0; bj < 2; ++bj) {
                    const u32x4 q = r[ai][m][bj];
                    const f32x4 a = acc[ai][bj][m][0] * sc[bj][0], b = acc[ai][bj][m][1] * sc[bj][1];
                    const float x0 = __builtin_bit_cast(float, q.x << 16) + a[0], x1 = __builtin_bit_cast(float, q.x & 0xffff0000u) + a[1], x2 = __builtin_bit_cast(float, q.y << 16) + a[2], x3 = __builtin_bit_cast(float, q.y & 0xffff0000u) + a[3];
                    const float x4 = __builtin_bit_cast(float, q.z << 16) + b[0], x5 = __builtin_bit_cast(float, q.z & 0xffff0000u) + b[1], x6 = __builtin_bit_cast(float, q.w << 16) + b[2], x7 = __builtin_bit_cast(float, q.w & 0xffff0000u) + b[3];
                    u32x4 w; w.x = cvtpk(x0, x1); w.y = cvtpk(x2, x3); w.z = cvtpk(x4, x5); w.w = cvtpk(x6, x7);
                    *(u32x4*)(xb + off + 32 * bj) = w;
                    int lo = cvt8(x0 * X8_SCALE, x1 * X8_SCALE, 0, false); lo = cvt8(x2 * X8_SCALE, x3 * X8_SCALE, lo, true);
                    int hi = cvt8(x4 * X8_SCALE, x5 * X8_SCALE, 0, false); hi = cvt8(x6 * X8_SCALE, x7 * X8_SCALE, hi, true);
                    w8[2 * bj] = (unsigned)lo; w8[2 * bj + 1] = (unsigned)hi; }
                *(u32x4*)(x8 + (size_t)(u.pm * 256 + ai * 128 + wr * 64 + m * 16 + fr) * DM + u.pn * 256 + wc * 64 + 16 * fq) = w8;
            }
        }
    }
};
constexpr float H8_SCALE = 16.f, WD8_SCALE = 64.f;
struct EpiGateUp {
    static constexpr int NSTORES = 8;
    unsigned char* H; const float* slot_rs;
    __device__ __forceinline__ void operator()(const Acc& acc, const pg8::Unit& u, int wr, int wc, int fr, int fq) const {
#pragma unroll
        for (int ai = 0; ai < 2; ++ai) {
            float rsv[4];
#pragma unroll
            for (int m = 0; m < 4; ++m) rsv[m] = slot_rs[u.pm * 256 + ai * 128 + wr * 64 + m * 16 + fr];
            asm volatile("" : "+v"(rsv[0]), "+v"(rsv[1]), "+v"(rsv[2]), "+v"(rsv[3]) :: "memory");
            u32x2 w[4];
#pragma unroll
            for (int m = 0; m < 4; ++m) {
                const float rs = rsv[m] * (1.f / (X8_SCALE * WG8_SCALE));
                float h[8];
#pragma unroll
                for (int n = 0; n < 2; ++n)
#pragma unroll
                    for (int i = 0; i < 4; ++i) { const float g = acc[ai][0][m][n][i] * rs, up = acc[ai][1][m][n][i] * rs;
                        h[4 * n + i] = g * up * __builtin_amdgcn_rcpf(1.f + __builtin_amdgcn_exp2f(-g * LOG2E)) * H8_SCALE; }
                int lo = cvt8(h[0], h[1], 0, false); lo = cvt8(h[2], h[3], lo, true);
                int hi = cvt8(h[4], h[5], 0, false); hi = cvt8(h[6], h[7], hi, true);
                w[m].x = (unsigned)lo; w[m].y = (unsigned)hi;
            }
            const int odd = fq & 1;
#pragma unroll
            for (int mp = 0; mp < 4; mp += 2) {
                const u32x2 snd = odd ? w[mp] : w[mp + 1], own = odd ? w[mp + 1] : w[mp];
                u32x2 rcv; rcv.x = (unsigned)__shfl_xor((int)snd.x, 16); rcv.y = (unsigned)__shfl_xor((int)snd.y, 16);
                u32x4 o; o.x = odd ? rcv.x : own.x; o.y = odd ? rcv.y : own.y; o.z = odd ? own.x : rcv.x; o.w = odd ? own.y : rcv.y;
                const int row = u.pm * 256 + ai * 128 + wr * 64 + (mp + odd) * 16 + fr;
                *(u32x4*)(H + (size_t)row * EFF + u.pn * 128 + wc * 32 + 8 * (fq & 2)) = o;
            }
        }
    }
};

namespace attn {
constexpr int SLOT = 32768, V_OFF = 16384, NSLOT = 3, X_OFF = NSLOT * SLOT, WSF_OFF = TS_OFF + 256;
static_assert(X_OFF + 4 * 8192 <= RING_BYTES && WSF_OFF + NWAVES * 256 <= LDS_BYTES, "attn LDS");
constexpr int DMAXI = 206;
__device__ __forceinline__ int crow(int r, int hi) { return (r & 3) + 8 * (r >> 2) + 4 * hi; }
__device__ __forceinline__ int rel_bucket(int n) {
    if (n < 16) return n;
    const int l = 16 + (int)(logf((float)n / 16.f) / logf(8.f) * 16.f);
    return l < 31 ? l : 31;
}
struct Params { const bf16_t* Q; const bf16_t* K; const bf16_t* V; bf16_t* O; const float* rel_bias; const float* subln; float lam; float one_minus_li; };

__device__ __forceinline__ void build_lut(LAS unsigned char* lds, const float* rel_bias) {
    LAS float* lut = (LAS float*)(lds + LUT_OFF);
    for (int idx = opaque_tid(); idx < NHEAD * LUT_N; idx += NTHREADS) {
        const int h = idx / LUT_N, i = idx - h * LUT_N, dist = DMAXI - i;
        lut[idx] = dist < 0 ? -INFINITY : (rel_bias[rel_bucket(dist) * NHEAD + h] - rel_bias[31 * NHEAD + h]) * LOG2E;
    }
}
#define ATT_WAIT_BAR(N) asm volatile("s_waitcnt vmcnt(" #N ") lgkmcnt(0)\n\ts_barrier" ::: "memory")
#define ATT_SBAR() __builtin_amdgcn_sched_barrier(0)
#define ATT_PIN(x) asm volatile("" : "+v"(x))
#define ATT_MF(a, b, c) __builtin_amdgcn_mfma_f32_32x32x16_bf16(a, b, c, 0, 0, 0)
#define ATT_VRD8(L, H, ks) do { _Pragma("unroll") for (int d_ = 0; d_ < 4; ++d_) { \
        asm volatile("ds_read_b64_tr_b16 %0, %1 offset:%c2" : "=&v"(L[d_]) : "v"(vaddr), "i"(V_OFF + d_ * 4096 + (ks) * 1024) : "memory"); \
        asm volatile("ds_read_b64_tr_b16 %0, %1 offset:%c2" : "=&v"(H[d_]) : "v"(vaddr), "i"(V_OFF + d_ * 4096 + (ks) * 1024 + 512) : "memory"); } } while (0)
#define ATT_VWAIT(N, L, H) do { asm volatile("s_waitcnt lgkmcnt(" #N ")" : "+v"(L[0]), "+v"(L[1]), "+v"(L[2]), "+v"(L[3]), "+v"(H[0]), "+v"(H[1]), "+v"(H[2]), "+v"(H[3]) :: "memory"); ATT_SBAR(); } while (0)
#define ATT_VF(L, H, d) ((bf16x8){L[d][0], L[d][1], L[d][2], L[d][3], H[d][0], H[d][1], H[d][2], H[d][3]})
#define ATT_PK(P, B) cvtpk(P[B], P[(B) + 1])
#define ATT_GAPA(VR, MFX, A0, A1, A2, A3, W0, W1, PW) do { VR; MFX; sacc += A0; sacc += A1; sacc += A2; sacc += A3; ATT_PIN(sacc); W0; W1; ATT_PIN(PW); ATT_SBAR(); } while (0)
#define ATT_VR1(L, H, d, ks) do { \
        asm volatile("ds_read_b64_tr_b16 %0, %1 offset:%c2" : "=&v"(L[d]) : "v"(vaddr), "i"(V_OFF + (d) * 4096 + (ks) * 1024) : "memory"); \
        asm volatile("ds_read_b64_tr_b16 %0, %1 offset:%c2" : "=&v"(H[d]) : "v"(vaddr), "i"(V_OFF + (d) * 4096 + (ks) * 1024 + 512) : "memory"); } while (0)
#define ATT_GAPB(KR, MFX, X, B) do { KR; MFX; X[B] = __builtin_amdgcn_exp2f(X[B]); X[(B) + 1] = __builtin_amdgcn_exp2f(X[(B) + 1]); ATT_PIN(X); ATT_SBAR(); } while (0)
#define ATT_KR(GL, j) do { if (GL) { kf[2 * (j)] = *(const LAS bf16x8*)(kp0 + sl_next + (j) * 2048); kf[2 * (j) + 1] = *(const LAS bf16x8*)(kp0 + sl_next + (j) * 2048 + 512); } } while (0)
#define ATT_NOP() do { } while (0)
#define ATT_KLOAD(kp_) do { _Pragma("unroll") for (int d0_ = 0; d0_ < 4; ++d0_) { kf[2 * d0_] = *(const LAS bf16x8*)((kp_) + d0_ * 2048); kf[2 * d0_ + 1] = *(const LAS bf16x8*)((kp_) + d0_ * 2048 + 512); } } while (0)
#define ATT_BAND(C0, C1, tt) do { const int dd_ = q0w - 64 * (tt); if (dd_ - 63 < 113) { const LAS float* lb_ = lut + (DMAXI - (dd_ + r32 - 4 * hi)); \
        _Pragma("unroll") for (int r = 0; r < 16; ++r) { C0[r] += lb_[(r & 3) + 8 * (r >> 2)]; C1[r] += lb_[32 + (r & 3) + 8 * (r >> 2)]; } } } while (0)
#define ATT_STEP(C0, C1, P0, P1, tt, ISSUE, GL, WN) do { \
        ATT_WAIT_BAR(WN); \
        ISSUE; \
        const unsigned vaddr = lds_u + (unsigned)sl_prev + (unsigned)vlane; \
        float sacc = 0.f; \
        ATT_GAPA(ATT_VR1(la, ha, 0, 0), C0 = ATT_MF(kf[0], qr[0], zero16), P0[0], P0[1], P0[2], P0[3],     pw0[0] = ATT_PK(P0, 0),  pw0[1] = ATT_PK(P0, 2),  pw0); \
        ATT_GAPA(ATT_VR1(la, ha, 1, 0), C1 = ATT_MF(kf[1], qr[0], zero16), P0[4], P0[5], P0[6], P0[7],     pw0[2] = ATT_PK(P0, 4),  pw0[3] = ATT_PK(P0, 6),  pw0); \
        ATT_GAPA(ATT_VR1(la, ha, 2, 0), C0 = ATT_MF(kf[2], qr[1], C0),     P0[8], P0[9], P0[10], P0[11],   pw1[0] = ATT_PK(P0, 8),  pw1[1] = ATT_PK(P0, 10), pw1); \
        ATT_GAPA(ATT_VR1(la, ha, 3, 0), C1 = ATT_MF(kf[3], qr[1], C1),     P0[12], P0[13], P0[14], P0[15], pw1[2] = ATT_PK(P0, 12), pw1[3] = ATT_PK(P0, 14), pw1); \
        ATT_GAPA(ATT_NOP(), C0 = ATT_MF(kf[4], qr[2], C0),     P1[0], P1[1], P1[2], P1[3],     pw2[0] = ATT_PK(P1, 0),  pw2[1] = ATT_PK(P1, 2),  pw2); \
        ATT_GAPA(ATT_NOP(), C1 = ATT_MF(kf[5], qr[2], C1),     P1[4], P1[5], P1[6], P1[7],     pw2[2] = ATT_PK(P1, 4),  pw2[3] = ATT_PK(P1, 6),  pw2); \
        ATT_GAPA(ATT_NOP(), C0 = ATT_MF(kf[6], qr[3], C0),     P1[8], P1[9], P1[10], P1[11],   pw3[0] = ATT_PK(P1, 8),  pw3[1] = ATT_PK(P1, 10), pw3); \
        ATT_GAPA(ATT_NOP(), C1 = ATT_MF(kf[7], qr[3], C1),     P1[12], P1[13], P1[14], P1[15], pw3[2] = ATT_PK(P1, 12), pw3[3] = ATT_PK(P1, 14), pw3); \
        lsum += sacc; \
        ATT_BAND(C0, C1, tt); \
        ATT_VRD8(lb2, hb2, 1); \
        ATT_VWAIT(8, la, ha); \
        ATT_GAPB(ATT_NOP(), o[0] = ATT_MF(__builtin_bit_cast(bf16x8, pw0), ATT_VF(la, ha, 0), o[0]), C0, 0); \
        ATT_GAPB(ATT_NOP(), o[1] = ATT_MF(__builtin_bit_cast(bf16x8, pw0), ATT_VF(la, ha, 1), o[1]), C0, 2); \
        ATT_GAPB(ATT_KR(GL, 0), o[2] = ATT_MF(__builtin_bit_cast(bf16x8, pw0), ATT_VF(la, ha, 2), o[2]), C0, 4); \
        ATT_GAPB(ATT_KR(GL, 1), o[3] = ATT_MF(__builtin_bit_cast(bf16x8, pw0), ATT_VF(la, ha, 3), o[3]), C0, 6); \
        ATT_VRD8(la, ha, 2); \
        ATT_VWAIT(8, lb2, hb2); \
        ATT_GAPB(ATT_KR(GL, 2), o[0] = ATT_MF(__builtin_bit_cast(bf16x8, pw1), ATT_VF(lb2, hb2, 0), o[0]), C0, 8); \
        ATT_GAPB(ATT_KR(GL, 3), o[1] = ATT_MF(__builtin_bit_cast(bf16x8, pw1), ATT_VF(lb2, hb2, 1), o[1]), C0, 10); \
        ATT_GAPB(ATT_NOP(), o[2] = ATT_MF(__builtin_bit_cast(bf16x8, pw1), ATT_VF(lb2, hb2, 2), o[2]), C0, 12); \
        ATT_GAPB(ATT_NOP(), o[3] = ATT_MF(__builtin_bit_cast(bf16x8, pw1), ATT_VF(lb2, hb2, 3), o[3]), C0, 14); \
        ATT_VRD8(lb2, hb2, 3); \
        ATT_VWAIT(8, la, ha); \
        ATT_GAPB(ATT_NOP(), o[0] = ATT_MF(__builtin_bit_cast(bf16x8, pw2), ATT_VF(la, ha, 0), o[0]), C1, 0); \
        ATT_GAPB(ATT_NOP(), o[1] = ATT_MF(__builtin_bit_cast(bf16x8, pw2), ATT_VF(la, ha, 1), o[1]), C1, 2); \
        ATT_GAPB(ATT_NOP(), o[2] = ATT_MF(__builtin_bit_cast(bf16x8, pw2), ATT_VF(la, ha, 2), o[2]), C1, 4); \
        ATT_GAPB(ATT_NOP(), o[3] = ATT_MF(__builtin_bit_cast(bf16x8, pw2), ATT_VF(la, ha, 3), o[3]), C1, 6); \
        ATT_VWAIT(0, lb2, hb2); \
        ATT_GAPB(ATT_NOP(), o[0] = ATT_MF(__builtin_bit_cast(bf16x8, pw3), ATT_VF(lb2, hb2, 0), o[0]), C1, 8); \
        ATT_GAPB(ATT_NOP(), o[1] = ATT_MF(__builtin_bit_cast(bf16x8, pw3), ATT_VF(lb2, hb2, 1), o[1]), C1, 10); \
        ATT_GAPB(ATT_NOP(), o[2] = ATT_MF(__builtin_bit_cast(bf16x8, pw3), ATT_VF(lb2, hb2, 2), o[2]), C1, 12); \
        ATT_GAPB(ATT_NOP(), o[3] = ATT_MF(__builtin_bit_cast(bf16x8, pw3), ATT_VF(lb2, hb2, 3), o[3]), C1, 14); \
        { const int tmp_ = sl_prev; sl_prev = sl_cur; sl_cur = sl_next; sl_next = tmp_; } \
    } while (0)

__device__ __forceinline__ void attn_unit(const Params& P, int b, int h, int qblk, LAS unsigned char* lds) {
    const int tid = opaque_tid(), lane = tid & 63, r32 = lane & 31, hi = lane >> 5;
    const int wid = __builtin_amdgcn_readfirstlane(tid >> 6), c = wid >> 2, wq = wid & 3;
    const int q0 = qblk * 128, q0w = q0 + 32 * wq, NT = 2 * qblk + 2;
    const size_t rowbase = (size_t)b * SEQ;
    bf16x8 qr[4];
    { const bf16_t* Qw = P.Q + (rowbase + q0w + r32) * DM + h * 128 + c * 64 + hi * 8;
#pragma unroll
      for (int d0 = 0; d0 < 4; ++d0) qr[d0] = *(const bf16x8*)(Qw + d0 * 16); }
    const bf16_t* ksrc = P.K + (size_t)(b * NHEAD + h) * 64 * 8192 + wid * 512 + lane * 8;
    const bf16_t* vsrc = P.V + (size_t)(b * NHEAD + h) * 64 * 8192 + (wid >> 2) * 2048 + wq * 512 + lane * 8;
#define ATT_DMA_K(t, slot) do { const size_t to_ = (size_t)(t) * 8192; \
        __builtin_amdgcn_global_load_lds((const unsigned*)(ksrc + to_), (LAS unsigned*)(lds + (slot) + wid * 1024), 16, 0, 0); \
        __builtin_amdgcn_global_load_lds((const unsigned*)(ksrc + to_ + 4096), (LAS unsigned*)(lds + (slot) + 8192 + wid * 1024), 16, 0, 0); } while (0)
#define ATT_DMA_V(t, slot) do { const size_t to_ = (size_t)(t) * 8192; \
        __builtin_amdgcn_global_load_lds((const unsigned*)(vsrc + to_), (LAS unsigned*)(lds + (slot) + V_OFF + (wid >> 2) * 4096 + wq * 1024), 16, 0, 0); \
        __builtin_amdgcn_global_load_lds((const unsigned*)(vsrc + to_ + 4096), (LAS unsigned*)(lds + (slot) + V_OFF + (2 + (wid >> 2)) * 4096 + wq * 1024), 16, 0, 0); } while (0)
    ATT_DMA_K(0, 0);
    ATT_DMA_K(1, SLOT); ATT_DMA_V(0, 0);
    if (NT > 2) ATT_DMA_K(2, 2 * SLOT);
    f32x16 o[4];
#pragma unroll
    for (int d = 0; d < 4; ++d)
#pragma unroll
        for (int r = 0; r < 16; ++r) o[d][r] = 0.f;
    f32x16 zero16;
#pragma unroll
    for (int r = 0; r < 16; ++r) zero16[r] = 0.f;
    float lsum = 0.f;
    const LAS float* lut = (const LAS float*)(lds + LUT_OFF) + h * LUT_N;
    const int vlane = ((lane >> 4) & 1) * 32 + (lane & 3) * 8 + (4 * hi + ((lane & 15) >> 2)) * 64;
    const unsigned lds_u = (unsigned)(uintptr_t)lds;
    const LAS unsigned char* kp0 = lds + c * 8192 + hi * 1024 + r32 * 16;
    int sl_prev = 2 * SLOT, sl_cur = 0, sl_next = SLOT;
    bf16x8 kf[8]; s16x4 la[4], ha[4], lb2[4], hb2[4]; u32x4 pw0, pw1, pw2, pw3;
    f32x16 pA0, pA1, pB0, pB1;
    if (NT > 2) ATT_WAIT_BAR(6); else ATT_WAIT_BAR(4);
    ATT_DMA_V(1, SLOT);
    ATT_KLOAD(kp0);
    pA0 = ATT_MF(kf[0], qr[0], zero16); pA1 = ATT_MF(kf[1], qr[0], zero16);
    pA0 = ATT_MF(kf[2], qr[1], pA0); pA1 = ATT_MF(kf[3], qr[1], pA1);
    pA0 = ATT_MF(kf[4], qr[2], pA0); pA1 = ATT_MF(kf[5], qr[2], pA1);
    pA0 = ATT_MF(kf[6], qr[3], pA0); pA1 = ATT_MF(kf[7], qr[3], pA1);
    ATT_BAND(pA0, pA1, 0);
#pragma unroll
    for (int r = 0; r < 16; ++r) { pA0[r] = __builtin_amdgcn_exp2f(pA0[r]); pA1[r] = __builtin_amdgcn_exp2f(pA1[r]); }
    if (NT > 2) ATT_WAIT_BAR(6); else ATT_WAIT_BAR(4);
    ATT_KLOAD(kp0 + SLOT);
    { const int tmp_ = sl_prev; sl_prev = sl_cur; sl_cur = sl_next; sl_next = tmp_; }
    ATT_STEP(pB0, pB1, pA0, pA1, 1, { if (3 < NT) ATT_DMA_K(3, sl_prev); if (4 < NT) ATT_DMA_K(4, sl_cur); if (2 < NT) ATT_DMA_V(2, sl_next); }, (2 < NT), 2);
    if (NT > 2) {
        int t = 2;
        for (; t + 4 < NT; t += 2) {
            ATT_STEP(pA0, pA1, pB0, pB1, t,     { ATT_DMA_K(t + 3, sl_cur); ATT_DMA_V(t + 1, sl_next); }, true, 4);
            ATT_STEP(pB0, pB1, pA0, pA1, t + 1, { ATT_DMA_K(t + 4, sl_cur); ATT_DMA_V(t + 2, sl_next); }, true, 4);
        }
        if (NT - t == 4) {
            ATT_STEP(pA0, pA1, pB0, pB1, t,     { ATT_DMA_K(t + 3, sl_cur); ATT_DMA_V(t + 1, sl_next); }, true, 4);
            ATT_STEP(pB0, pB1, pA0, pA1, t + 1, { ATT_DMA_V(t + 2, sl_next); }, true, 4);
            t += 2;
        }
        ATT_STEP(pA0, pA1, pB0, pB1, t,     { ATT_DMA_V(t + 1, sl_next); }, true, 2);
        ATT_STEP(pB0, pB1, pA0, pA1, t + 1, { }, false, 2);
    }
    { float sacc = 0.f;
#pragma unroll
      for (int r = 0; r < 16; ++r) sacc += pB0[r] + pB1[r];
      lsum += sacc;
#pragma unroll
      for (int q = 0; q < 4; ++q) { pw0[q] = ATT_PK(pB0, 2 * q); pw1[q] = ATT_PK(pB0, 8 + 2 * q); pw2[q] = ATT_PK(pB1, 2 * q); pw3[q] = ATT_PK(pB1, 8 + 2 * q); }
      ATT_WAIT_BAR(0);
      const unsigned vaddr = lds_u + (unsigned)sl_prev + (unsigned)vlane;
      ATT_VRD8(la, ha, 0); ATT_VRD8(lb2, hb2, 1);
      ATT_VWAIT(8, la, ha);
#pragma unroll
      for (int d = 0; d < 4; ++d) o[d] = ATT_MF(__builtin_bit_cast(bf16x8, pw0), ATT_VF(la, ha, d), o[d]);
      ATT_VRD8(la, ha, 2);
      ATT_VWAIT(8, lb2, hb2);
#pragma unroll
      for (int d = 0; d < 4; ++d) o[d] = ATT_MF(__builtin_bit_cast(bf16x8, pw1), ATT_VF(lb2, hb2, d), o[d]);
      ATT_VRD8(lb2, hb2, 3);
      ATT_VWAIT(8, la, ha);
#pragma unroll
      for (int d = 0; d < 4; ++d) o[d] = ATT_MF(__builtin_bit_cast(bf16x8, pw2), ATT_VF(la, ha, d), o[d]);
      ATT_VWAIT(0, lb2, hb2);
#pragma unroll
      for (int d = 0; d < 4; ++d) o[d] = ATT_MF(__builtin_bit_cast(bf16x8, pw3), ATT_VF(lb2, hb2, d), o[d]);
    }
#undef ATT_DMA_K
#undef ATT_DMA_V
    LAS float* wsf = (LAS float*)(lds + WSF_OFF) + wid * 64;
    lsum += __shfl_xor(lsum, 32);
    if (hi == 0) wsf[r32] = lsum;
    asm volatile("s_waitcnt lgkmcnt(0)" ::: "memory");
    float rl[16];
#pragma unroll
    for (int r = 0; r < 16; ++r) rl[r] = __builtin_amdgcn_rcpf(wsf[crow(r, hi)]);
    LAS unsigned short* X = (LAS unsigned short*)(lds + X_OFF) + wq * 4096;
    if (c == 1) {
#pragma unroll
        for (int d = 0; d < 4; ++d)
#pragma unroll
            for (int r = 0; r < 16; ++r) X[(d * 16 + r) * 64 + lane] = (unsigned short)(cvtpk(o[d][r] * (rl[r] * P.lam), 0.f) & 0xffffu);
    }
    asm volatile("s_waitcnt lgkmcnt(0)\n\ts_barrier" ::: "memory");
    if (c == 0) {
        float rs[16];
#pragma unroll
        for (int r = 0; r < 16; ++r) {
            float ss = 0.f;
#pragma unroll
            for (int d = 0; d < 4; ++d) { const float v = o[d][r] * rl[r] - bf2f(X[(d * 16 + r) * 64 + lane]); o[d][r] = v; ss += v * v; }
            ss += __shfl_xor(ss, 1); ss += __shfl_xor(ss, 2); ss += __shfl_xor(ss, 4); ss += __shfl_xor(ss, 8); ss += __shfl_xor(ss, 16);
            rs[r] = __builtin_amdgcn_rsqf(ss * (1.f / 128.f) + EPS) * P.one_minus_li;
        }
        asm volatile("s_waitcnt lgkmcnt(0)" ::: "memory");
        LAS unsigned short* stg = X;
#pragma unroll
        for (int d = 0; d < 4; ++d) { const float g = P.subln[32 * d + r32];
#pragma unroll
            for (int r = 0; r < 16; ++r) stg[crow(r, hi) * 128 + 32 * d + r32] = (unsigned short)(cvtpk(o[d][r] * rs[r] * g, 0.f) & 0xffffu); }
        asm volatile("s_waitcnt lgkmcnt(0)" ::: "memory");
        bf16_t* Ow = P.O + (rowbase + q0w) * DM + h * 128;
#pragma unroll
        for (int i = 0; i < 8; ++i) { const int idx = i * 64 + lane, row = idx >> 4, ch = idx & 15;
            const u32x4 v = *(const LAS u32x4*)((const LAS unsigned char*)stg + row * 256 + ch * 16);
            *(u32x4*)(Ow + (size_t)row * DM + ch * 8) = v; }
    }
}

__device__ __forceinline__ void attn_phase(const Params& P, LAS unsigned char* lds) {
    const int G = gridDim.x, bx = blockIdx.x;
    build_lut(lds, P.rel_bias);
    __syncthreads();
    if (G == 256) {
        const int x = bx & 7, j = bx >> 3;
        for (int r = 0; r < 16; ++r) { const int bh = x * 16 + r; attn_unit(P, bh >> 3, bh & 7, (r & 1) ? 31 - j : j, lds); }
    } else {
        for (int i = 0;; ++i) { const int p = bx + G * i; if (p >= 2048) break; const int bh = p >> 4, s2 = p & 15;
            attn_unit(P, bh >> 3, bh & 7, 31 - s2, lds); attn_unit(P, bh >> 3, bh & 7, s2, lds); }
    }
    __syncthreads();
}
}

#define BF_LO(u) __builtin_bit_cast(float, (u) << 16)
#define BF_HI(u) __builtin_bit_cast(float, (u) & 0xffff0000u)
template <int MODE>
__device__ __forceinline__ void row_pass(const float* xin, float* xout, bf16_t* xb, float* rstd, const unsigned char* Y, const int* tok_slot, const float* tok_w, LAS unsigned char* lds) {
    const int tid = opaque_tid(), lane = tid & 63, wid = tid >> 6;
    const int ypos = 256 * (lane >> 5) + 64 * ((lane & 31) >> 3) + 16 * (lane & 3) + 8 * (((lane & 31) >> 2) & 1);
    LAS int* sl = (LAS int*)lds; LAS float* wl = (LAS float*)(lds + 2048);
    for (int blk = blockIdx.x; blk < NTOK / 256; blk += gridDim.x) {
        if (MODE != 0) { sl[tid] = tok_slot[blk * 512 + tid]; wl[tid] = tok_w[blk * 512 + tid]; __syncthreads(); }
        for (int it = 0; it < 8; ++it) {
            const int r0 = it * 32 + wid * 4, m0 = blk * 256 + r0;
            float v[4][2][8];
            if (MODE == 0) {
#pragma unroll
                for (int rr = 0; rr < 4; ++rr) { const f32x4* xr = (const f32x4*)(xin + (size_t)(m0 + rr) * DM + 8 * lane);
#pragma unroll
                    for (int j = 0; j < 2; ++j) { const f32x4 a = xr[128 * j], b = xr[128 * j + 1];
#pragma unroll
                        for (int i = 0; i < 4; ++i) { v[rr][j][i] = a[i]; v[rr][j][4 + i] = b[i]; } } }
            } else {
                u32x4 xq[4][2]; u32x2 ya[4][2], yb[4][2]; float w0[4], w1[4];
#pragma unroll
                for (int rr = 0; rr < 4; ++rr) { const int s0 = sl[2 * (r0 + rr)], s1 = sl[2 * (r0 + rr) + 1]; w0[rr] = wl[2 * (r0 + rr)] * (1.f / Y8_SCALE); w1[rr] = wl[2 * (r0 + rr) + 1] * (1.f / Y8_SCALE);
                    const bf16_t* xr = xb + (size_t)(m0 + rr) * DM + 8 * lane;
                    const unsigned char* y0 = Y + (size_t)s0 * DM + ypos; const unsigned char* y1 = Y + (size_t)s1 * DM + ypos;
#pragma unroll
                    for (int j = 0; j < 2; ++j) { xq[rr][j] = *(const u32x4*)(xr + 512 * j); ya[rr][j] = *(const u32x2*)(y0 + 512 * j); yb[rr][j] = *(const u32x2*)(y1 + 512 * j); } }
#pragma unroll
                for (int rr = 0; rr < 4; ++rr)
#pragma unroll
                    for (int j = 0; j < 2; ++j) { const u32x4 x = xq[rr][j];
#pragma unroll
                        for (int q = 0; q < 2; ++q) { const unsigned xa = q ? x.z : x.x, xc = q ? x.w : x.y; const int yaq = (int)(q ? ya[rr][j].y : ya[rr][j].x), ybq = (int)(q ? yb[rr][j].y : yb[rr][j].x);
                            const f32x2 a0 = __builtin_amdgcn_cvt_pk_f32_fp8(yaq, false), a1 = __builtin_amdgcn_cvt_pk_f32_fp8(yaq, true);
                            const f32x2 b0 = __builtin_amdgcn_cvt_pk_f32_fp8(ybq, false), b1 = __builtin_amdgcn_cvt_pk_f32_fp8(ybq, true);
                            v[rr][j][4 * q + 0] = BF_LO(xa) + w0[rr] * a0.x + w1[rr] * b0.x;
                            v[rr][j][4 * q + 1] = BF_HI(xa) + w0[rr] * a0.y + w1[rr] * b0.y;
                            v[rr][j][4 * q + 2] = BF_LO(xc) + w0[rr] * a1.x + w1[rr] * b1.x;
                            v[rr][j][4 * q + 3] = BF_HI(xc) + w0[rr] * a1.y + w1[rr] * b1.y; } }
            }
            if (MODE == 2) {
#pragma unroll
                for (int rr = 0; rr < 4; ++rr) { f32x4* xo = (f32x4*)(xout + (size_t)(m0 + rr) * DM + 8 * lane);
#pragma unroll
                    for (int j = 0; j < 2; ++j) { xo[128 * j] = (f32x4){v[rr][j][0], v[rr][j][1], v[rr][j][2], v[rr][j][3]}; xo[128 * j + 1] = (f32x4){v[rr][j][4], v[rr][j][5], v[rr][j][6], v[rr][j][7]}; } }
            } else {
#pragma unroll
                for (int rr = 0; rr < 4; ++rr) {
                    float ss = 0.f;
                    bf16_t* o8 = xb + (size_t)(m0 + rr) * DM + 8 * lane;
#pragma unroll
                    for (int j = 0; j < 2; ++j) {
#pragma unroll
                        for (int i = 0; i < 8; i += 2) ss += v[rr][j][i] * v[rr][j][i] + v[rr][j][i + 1] * v[rr][j][i + 1];
                        u32x4 w; w.x = cvtpk(v[rr][j][0], v[rr][j][1]); w.y = cvtpk(v[rr][j][2], v[rr][j][3]); w.z = cvtpk(v[rr][j][4], v[rr][j][5]); w.w = cvtpk(v[rr][j][6], v[rr][j][7]);
                        *(u32x4*)(o8 + 512 * j) = w; }
                    ss = wave_sum(ss);
                    if (lane == 0) rstd[m0 + rr] = __builtin_amdgcn_rsqf(ss * (1.f / DM) + EPS);
                }
            }
        }
        if (MODE != 0) __syncthreads();
    }
}

__device__ __forceinline__ void router_pass(const bf16_t* x, const bf16_t* wt, const float* wg  , const float* bg, const float* be,
                                            float* rstd_out, int* tok_e, float* tok_w, int* cnt, LAS unsigned char* lds) {
    const int tid = opaque_tid(), lane = tid & 63, wid = tid >> 6, r32 = lane & 31, hi = lane >> 5;
    LAS f32x4* wgl = (LAS f32x4*)lds;
    LAS int* cntl = (LAS int*)(lds + 16384);
    for (int i = tid; i < 1024; i += NTHREADS) wgl[i] = *(const f32x4*)(wg + 4 * i);
    for (int blk = blockIdx.x; blk < NTOK / 256; blk += gridDim.x) {
        if (tid < NEXP) cntl[tid] = 0;
        __syncthreads();
        const int tok = blk * 256 + wid * 32 + r32;
        const u32x4* xp = (const u32x4*)(x + (size_t)tok * DM + 8 * hi);
        const u32x4* wph = (const u32x4*)wt + lane; const u32x4* wpl = wph + 64 * 64;
        const LAS f32x4* gp_ = wgl + 8 * hi;
        f32x16 D;
#pragma unroll
        for (int r = 0; r < 16; ++r) D[r] = 0.f;
        float ss = 0.f; f32x4 gl = {0.f, 0.f, 0.f, 0.f};
#pragma unroll 4
        for (int s = 0; s < 64; ++s) {
            const u32x4 xq_ = xp[2 * s], wh = wph[64 * s], wl = wpl[64 * s];
            D = __builtin_amdgcn_mfma_f32_32x32x16_bf16(__builtin_bit_cast(bf16x8, wh), __builtin_bit_cast(bf16x8, xq_), D, 0, 0, 0);
            D = __builtin_amdgcn_mfma_f32_32x32x16_bf16(__builtin_bit_cast(bf16x8, wl), __builtin_bit_cast(bf16x8, xq_), D, 0, 0, 0);
            const float xa[8] = {BF_LO(xq_.x), BF_HI(xq_.x), BF_LO(xq_.y), BF_HI(xq_.y), BF_LO(xq_.z), BF_HI(xq_.z), BF_LO(xq_.w), BF_HI(xq_.w)};
#pragma unroll
            for (int j = 0; j < 8; ++j) { gl += gp_[16 * s + j] * xa[j]; ss += xa[j] * xa[j]; }
        }
        ss += __shfl_xor(ss, 32);
#pragma unroll
        for (int g = 0; g < 4; ++g) gl[g] += __shfl_xor(gl[g], 32);
        const float rs = __builtin_amdgcn_rsqf(ss * (1.f / DM) + EPS);
        float glg[4]; float gmax = -INFINITY; int gidx = 0;
#pragma unroll
        for (int g = 0; g < 4; ++g) { glg[g] = gl[g] * rs + bg[g]; if (glg[g] > gmax) { gmax = glg[g]; gidx = g; } }
        float gsum = 0.f;
#pragma unroll
        for (int g = 0; g < 4; ++g) gsum += __expf(glg[g] - gmax);
        const float gprob = 1.f / gsum;
        float own[4], oth[4], v[8];
#pragma unroll
        for (int i = 0; i < 4; ++i) { const float d = gidx == 0 ? D[i] : gidx == 1 ? D[4 + i] : gidx == 2 ? D[8 + i] : D[12 + i];
            own[i] = d * rs + be[8 * gidx + 4 * hi + i]; oth[i] = __shfl_xor(own[i], 32); }
#pragma unroll
        for (int i = 0; i < 4; ++i) { v[i] = hi ? oth[i] : own[i]; v[4 + i] = hi ? own[i] : oth[i]; }
        int i1 = 0; float v1 = v[0];
#pragma unroll
        for (int i = 1; i < 8; ++i) if (v[i] > v1) { v1 = v[i]; i1 = i; }
        int i2 = -1; float v2 = -INFINITY;
#pragma unroll
        for (int i = 0; i < 8; ++i) if (i != i1 && v[i] > v2) { v2 = v[i]; i2 = i; }
        const float w1 = gprob / (1.f + __expf(v2 - v1)), w2 = gprob - w1;
        if (hi == 0) {
            const int e1 = 8 * gidx + i1, e2 = 8 * gidx + i2;
            tok_e[2 * tok] = e1; tok_e[2 * tok + 1] = e2; tok_w[2 * tok] = w1; tok_w[2 * tok + 1] = w2; rstd_out[tok] = rs;
            atomicAdd((int*)&cntl[e1], 1); atomicAdd((int*)&cntl[e2], 1);
        }
        __syncthreads();
        if (tid < NEXP) cnt[blk * NEXP + tid] = cntl[tid];
        __syncthreads();
    }
}

__device__ __forceinline__ void assign_pass(const int* cnt, const int* tok_e, const float* rstd_ffn, int* tok_slot, int* slot_tok, float* slot_rs, LAS unsigned char* lds) {
    const int tid = opaque_tid(), lane = tid & 63, wid = tid >> 6;
    LAS int* pall = (LAS int*)lds;
    LAS int* plt = pall + 512;
    LAS int* total = plt + 512;
    LAS int* mybase = total + 32;
    LAS int* wcnt = mybase + 32;
    LAS int* ts = (LAS int*)(lds + TS_OFF);
    { const int e = tid & 31, p = tid >> 5; int a = 0;
      for (int b = 16 * p; b < 16 * p + 16; ++b) a += cnt[b * NEXP + e];
      pall[p * 32 + e] = a; }
    __syncthreads();
    if (tid < NEXP) { int a = 0; for (int p = 0; p < 16; ++p) a += pall[p * 32 + tid]; total[tid] = a; }
    __syncthreads();
    if (tid == 0) { int acc = 0; for (int e = 0; e < NEXP; ++e) { ts[e] = acc; acc += (total[e] + 255) >> 8; } ts[NEXP] = acc; }
    __syncthreads();
    for (int blk = blockIdx.x; blk < NTOK / 256; blk += gridDim.x) {
        { const int e = tid & 31, p = tid >> 5; int l = 0;
          for (int b = 16 * p; b < 16 * p + 16; ++b) { const int c = cnt[b * NEXP + e]; if (b < blk) l += c; }
          plt[p * 32 + e] = l; }
        int e0 = -1, e1 = -1, r0 = 0, r1 = 0; float rs = 0.f;
        if (tid < 256) { const int tok = blk * 256 + tid; e0 = tok_e[2 * tok]; e1 = tok_e[2 * tok + 1]; rs = rstd_ffn[tok]; }
        if (wid < 4) {
            const unsigned long long lt = (1ull << lane) - 1ull;
#pragma unroll 4
            for (int e = 0; e < NEXP; ++e) {
                const unsigned long long m = __ballot(e0 == e || e1 == e);
                const int r = __popcll(m & lt);
                if (e0 == e) r0 = r;
                if (e1 == e) r1 = r;
                if (lane == 0) wcnt[e * 4 + wid] = __popcll(m);
            }
        }
        __syncthreads();
        if (tid < NEXP) { int l = 0; for (int p = 0; p < 16; ++p) l += plt[p * 32 + tid]; mybase[tid] = l; }
        __syncthreads();
        if (tid < 256) {
            const int tok = blk * 256 + tid;
            int p0 = ts[e0] * 256 + mybase[e0] + r0, p1 = ts[e1] * 256 + mybase[e1] + r1;
            for (int w = 0; w < wid; ++w) { p0 += wcnt[e0 * 4 + w]; p1 += wcnt[e1 * 4 + w]; }
            tok_slot[2 * tok] = p0; tok_slot[2 * tok + 1] = p1;
            slot_tok[p0] = tok; slot_tok[p1] = tok; slot_rs[p0] = rs; slot_rs[p1] = rs;
        }
        if (blk == 0) {
            for (int e = 0; e < NEXP; ++e) for (int p = ts[e] * 256 + total[e] + tid; p < ts[e + 1] * 256; p += NTHREADS) { slot_tok[p] = 0; slot_rs[p] = 0.f; }
        }
        __syncthreads();
    }
}

__device__ __forceinline__ void pool_pass(const bf16_t* U, unsigned char* Pq) {
    const int tid = opaque_tid(), lane = tid & 63, wid = tid >> 6;
    for (int task = blockIdx.x * NWAVES + wid; task < (NTOK / 64) * 2; task += gridDim.x * NWAVES) {
        const int rb = task >> 1, half = task & 1, T0 = rb * 64, col = half * 512 + lane * 8, w = 2 << (half * 2 + (lane >> 5)), tp0 = T0 & (SEQ - 1);
        float S[8];
#pragma unroll
        for (int k = 0; k < 8; ++k) S[k] = 0.f;
#define PL_LD(dst, row) do { const u32x4 q_ = *(const u32x4*)(U + (size_t)(row) * DM + col); \
        dst[0] = __builtin_bit_cast(float, q_.x << 16); dst[1] = __builtin_bit_cast(float, q_.x & 0xffff0000u); dst[2] = __builtin_bit_cast(float, q_.y << 16); dst[3] = __builtin_bit_cast(float, q_.y & 0xffff0000u); \
        dst[4] = __builtin_bit_cast(float, q_.z << 16); dst[5] = __builtin_bit_cast(float, q_.z & 0xffff0000u); dst[6] = __builtin_bit_cast(float, q_.w << 16); dst[7] = __builtin_bit_cast(float, q_.w & 0xffff0000u); } while (0)
        for (int jj = 1; jj < 16; ++jj) if (jj < w && tp0 - jj >= 0) { float a[8]; PL_LD(a, T0 - jj);
#pragma unroll
            for (int k = 0; k < 8; ++k) S[k] += a[k]; }
#define PL_UNP(dst, q_) do { dst[0] = __builtin_bit_cast(float, q_.x << 16); dst[1] = __builtin_bit_cast(float, q_.x & 0xffff0000u); dst[2] = __builtin_bit_cast(float, q_.y << 16); dst[3] = __builtin_bit_cast(float, q_.y & 0xffff0000u); \
        dst[4] = __builtin_bit_cast(float, q_.z << 16); dst[5] = __builtin_bit_cast(float, q_.z & 0xffff0000u); dst[6] = __builtin_bit_cast(float, q_.w << 16); dst[7] = __builtin_bit_cast(float, q_.w & 0xffff0000u); } while (0)
        for (int i0 = 0; i0 < 64; i0 += 8) {
            u32x4 cq[8], aq[8];
#pragma unroll
            for (int i = 0; i < 8; ++i) { const int t = T0 + i0 + i, tp = tp0 + i0 + i;
                cq[i] = *(const u32x4*)(U + (size_t)t * DM + col);
                aq[i] = (tp - (w - 1) >= 0) ? *(const u32x4*)(U + (size_t)(t - (w - 1)) * DM + col) : (u32x4){0u, 0u, 0u, 0u}; }
#pragma unroll
            for (int i = 0; i < 8; ++i) { const int t = T0 + i0 + i, tp = tp0 + i0 + i; float c[8], a[8]; PL_UNP(c, cq[i]); PL_UNP(a, aq[i]);
                const int n = tp + 1 < w ? tp + 1 : w; const float inv = 1.f / (float)n;
                float o[8];
#pragma unroll
                for (int k = 0; k < 8; ++k) { S[k] += c[k]; o[k] = S[k] * inv - c[k]; S[k] -= a[k]; }
                int lo = cvt8(o[0] * A8_SCALE, o[1] * A8_SCALE, 0, false); lo = cvt8(o[2] * A8_SCALE, o[3] * A8_SCALE, lo, true);
                int hi = cvt8(o[4] * A8_SCALE, o[5] * A8_SCALE, 0, false); hi = cvt8(o[6] * A8_SCALE, o[7] * A8_SCALE, hi, true);
                *(u32x2*)(Pq + (size_t)t * DM + col) = (u32x2){(unsigned)lo, (unsigned)hi}; }
        }
#undef PL_UNP
#undef PL_LD
    }
}

constexpr int ARG_OFF = attn::WSF_OFF + NWAVES * 256;
static_assert(ARG_OFF + 27 * 8 <= LDS_BYTES, "LDS map (args)");
__device__ __forceinline__ const void* arg_ptr(LAS unsigned char* lds, int i) {
    const unsigned long long v = ((const LAS unsigned long long*)(lds + ARG_OFF))[i];
    const unsigned lo = __builtin_amdgcn_readfirstlane((unsigned)v), hi = __builtin_amdgcn_readfirstlane((unsigned)(v >> 32));
    return (const void*)(const __attribute__((address_space(1))) char*)(((unsigned long long)hi << 32) | lo);
}
#define INP(i) ((const float*)arg_ptr(lds, (i)))
#define OUTP() ((float*)arg_ptr(lds, 25))
#define WSP() ((unsigned char*)arg_ptr(lds, 26))


__device__ __forceinline__ size_t wt_image_off(int n, int k, int Kd) {
    const int pn = n >> 8, nr = n & 255, wc = nr >> 6, bj = (nr >> 5) & 1, x = nr & 31, rho = 16 * ((x >> 2) & 1) + 4 * (x >> 3) + (x & 3);
    const int kt = k >> 6, kk = k & 63;
    return ((size_t)((pn * (Kd >> 6) + kt) * 2 + bj) * 16384 + pg8::lds_byte(wc * 32 + rho, kk)) >> 1;
}
__device__ __forceinline__ size_t wt_image_off8(int n, int k, int Kd) {
    const int pn = n >> 8, nr = n & 255, wc = nr >> 6, bj = (nr >> 5) & 1, x = nr & 31, rho = 16 * ((x >> 2) & 1) + 4 * (x >> 3) + (x & 3);
    const int kt = k >> 7, kb = k & 127;
    return (size_t)((pn * (Kd >> 7) + kt) * 2 + bj) * 16384 + pg8::lds_byte(wc * 32 + rho, kb >> 1);
}
struct TrDesc { const float* W; const float* gain; bf16_t* WT; int N, k0, n0, Kd, drow0; int f8; float f8s; };
__device__ __forceinline__ void tr_load(const TrDesc& d, f32x4 (&v)[8], float (&g)[8], int lane) {
    const int kr = lane >> 3, n4 = (lane & 7) * 4;
#pragma unroll
    for (int i = 0; i < 8; ++i) { v[i] = *(const f32x4*)(d.W + (size_t)(d.k0 + 8 * i + kr) * d.N + d.n0 + n4); g[i] = d.gain ? d.gain[d.k0 + 8 * i + kr] : 1.f; }
}
__device__ __forceinline__ void tr_finish(const TrDesc& d, const f32x4 (&v)[8], const float (&g)[8], LAS float* scr, int lane) {
    const int kr = lane >> 3, n4 = (lane & 7) * 4;
#pragma unroll
    for (int i = 0; i < 8; ++i) { LAS float* q = scr + (8 * i + kr) * 33 + n4; q[0] = v[i][0] * g[i]; q[1] = v[i][1] * g[i]; q[2] = v[i][2] * g[i]; q[3] = v[i][3] * g[i]; }
    asm volatile("s_waitcnt lgkmcnt(0)" ::: "memory");
    if (d.f8) {
#pragma unroll
        for (int j = 0; j < 2; ++j) { const int pc = lane * 2 + j, n = pc >> 2, kg = pc & 3; const float fs = d.f8s;
            u32x4 o;
#pragma unroll
            for (int q = 0; q < 4; ++q) { const int kb = d.f8 == 2 ? (q >> 1) * 32 + 8 * kg + 4 * (q & 1) : 16 * kg + 4 * q; const LAS float* t = scr + kb * 33 + n;
                int r = cvt8(t[0] * fs, t[33] * fs, 0, false);
                r = cvt8(t[66] * fs, t[99] * fs, r, true); o[q] = (unsigned)r; }
            *(u32x4*)((unsigned char*)d.WT + wt_image_off8(d.drow0 + n, d.k0 + 16 * kg, d.Kd)) = o; }
        asm volatile("s_waitcnt lgkmcnt(0)" ::: "memory");
        return;
    }
    const int c = lane & 7;
#pragma unroll
    for (int j = 0; j < 4; ++j) { const int n = (lane >> 3) + 8 * j; const LAS float* t = scr + (8 * c) * 33 + n;
        u32x4 o; o.x = cvtpk(t[0 * 33], t[1 * 33]); o.y = cvtpk(t[2 * 33], t[3 * 33]); o.z = cvtpk(t[4 * 33], t[5 * 33]); o.w = cvtpk(t[6 * 33], t[7 * 33]);
        *(u32x4*)(d.WT + wt_image_off(d.drow0 + n, d.k0 + 8 * c, d.Kd)) = o; }
    asm volatile("s_waitcnt lgkmcnt(0)" ::: "memory");
}
struct Args { const float* in[25]; float* out; unsigned char* ws; };
enum { I_X = 0, I_RELB, I_ANORM, I_WQKV, I_QG, I_KG, I_LQ1, I_LK1, I_LQ2, I_LK2, I_SUBLN, I_WO, I_PNORM, I_PWIN, I_PWG, I_PWOUT, I_PSCALE, I_FNORM, I_RGW, I_RGB, I_REW, I_REB, I_WGATE, I_WUP, I_WDOWN };

__device__ __forceinline__ TrDesc tr_decode(LAS unsigned char* lds, unsigned char* ws, int it) {
    constexpr int N_QKV = 2 * 16 * 96, N_WO = 2 * 16 * 32, N_GU = 128 * 512, N_DN = 128 * 256;
    TrDesc d; d.f8 = 0; d.f8s = 1.f;
    if (it < N_GU) { const int le = it >> 9, r = it & 511, isup = r >> 8, r2 = r & 255, kb = r2 >> 4, nb = r2 & 15;
        d.W = (isup ? INP(I_WUP) : INP(I_WGATE)) + (size_t)le * 1024 * 512; d.N = 512; d.k0 = 64 * kb; d.n0 = 32 * nb; d.WT = (bf16_t*)(ws + WS_WGU + (size_t)le * 1024 * 1024); d.Kd = 1024;
        d.drow0 = 256 * (nb >> 2) + 64 * (nb & 3) + 32 * isup; d.gain = INP(I_FNORM) + (le >> 5) * 1024; d.f8 = 2; d.f8s = WG8_SCALE; return d; }
    it -= N_GU;
    if (it < N_DN) { const int le = it >> 8, r = it & 255, kb = r >> 5, nb = r & 31;
        d.W = INP(I_WDOWN) + (size_t)le * 512 * 1024; d.N = 1024; d.k0 = 64 * kb; d.n0 = 32 * nb; d.WT = (bf16_t*)(ws + WS_WDN + (size_t)le * 1024 * 512); d.Kd = 512; d.drow0 = 32 * nb; d.gain = nullptr; d.f8 = 1; d.f8s = WD8_SCALE; return d; }
    it -= N_DN;
    if (it < N_QKV) { const int l = it / 1536, r = it - l * 1536, kb = r / 96, nb = r - kb * 96;
        d.W = INP(I_WQKV) + (size_t)l * 1024 * 3072; d.N = 3072; d.k0 = 64 * kb; d.n0 = 32 * nb; d.WT = (bf16_t*)(ws + WS_WQKV) + (size_t)l * 3072 * 1024; d.Kd = 1024; d.drow0 = 32 * nb; d.gain = INP(I_ANORM) + l * 1024; return d; }
    it -= N_QKV;
    const bool po = it >= N_WO; if (po) it -= N_WO;
    { const int l = it >> 9, r = it & 511, kb = r >> 5, nb = r & 31;
      d.W = (po ? INP(I_PWOUT) : INP(I_WO)) + (size_t)l * 1024 * 1024; d.N = 1024; d.k0 = 64 * kb; d.n0 = 32 * nb; d.WT = (bf16_t*)(ws + (po ? WS_WPO : WS_WO) + (size_t)l * 1024 * 1024 * (po ? 1 : 2)); d.Kd = 1024; d.drow0 = 32 * nb; d.gain = nullptr; d.f8 = po ? 1 : 0; d.f8s = po ? WN8_SCALE : 1.f; }
    return d;
}
__device__ __forceinline__ void prologue(LAS unsigned char* lds) {
    const int tid = opaque_tid(), lane = tid & 63, wid = tid >> 6;
    LAS float* scr = (LAS float*)(lds + wid * 16384);
    const int gw = blockIdx.x * NWAVES + wid, NGW = gridDim.x * NWAVES;
    unsigned char* ws = WSP();
    constexpr int N_QKV = 2 * 16 * 96, N_WO = 2 * 16 * 32, N_GU = 128 * 512, N_DN = 128 * 256, N_PC = 2 * 64 * 16;
    constexpr int NTR = N_QKV + 2 * N_WO + N_GU + N_DN;
    if (gw < NTR) {
        TrDesc dA = tr_decode(lds, ws, gw), dB; f32x4 va[8], vb[8]; float ga[8], gb[8];
        tr_load(dA, va, ga, lane);
        for (int itA = gw;;) {
            const int itB = itA + NGW; const bool hasB = itB < NTR;
            if (hasB) { dB = tr_decode(lds, ws, itB); tr_load(dB, vb, gb, lane); }
            tr_finish(dA, va, ga, scr, lane);
            if (!hasB) break;
            itA = itB + NGW; const bool hasA = itA < NTR;
            if (hasA) { dA = tr_decode(lds, ws, itA); tr_load(dA, va, ga, lane); }
            tr_finish(dB, vb, gb, scr, lane);
            if (!hasA) break;
        }
    }
    for (int it = gw; it < N_PC; it += NGW) {
        {
            const int l = it >> 10, r = it & 1023, k0 = (r >> 4) * 16, n0 = (r & 15) * 64, g = n0 >> 8, e = (n0 & 255) + lane;
            const float* win = INP(I_PWIN) + (size_t)l * 1024 * 1024 + (size_t)k0 * 1024 + g * 256;
            const float* wgp = INP(I_PWG) + (size_t)l * 4 * 256 * 256 + (size_t)g * 256 * 256 + e;
            float acc[16];
#pragma unroll
            for (int kk = 0; kk < 16; ++kk) acc[kk] = 0.f;
            {
                f32x4 wv[16];
#pragma unroll
                for (int kk = 0; kk < 16; ++kk) wv[kk] = *(const f32x4*)(win + (size_t)kk * 1024 + 4 * lane);
#pragma unroll
                for (int kk = 0; kk < 16; ++kk) *(LAS f32x4*)(scr + kk * 256 + 4 * lane) = wv[kk];
                asm volatile("s_waitcnt lgkmcnt(0)" ::: "memory"); }
#pragma unroll 8
            for (int c4 = 0; c4 < 64; ++c4) {
                float b[4];
#pragma unroll
                for (int cc = 0; cc < 4; ++cc) b[cc] = wgp[(size_t)(4 * c4 + cc) * 256];
#pragma unroll
                for (int kk = 0; kk < 16; ++kk) { const f32x4 av = *(const LAS f32x4*)(scr + kk * 256 + 4 * c4); acc[kk] += (av[0] * b[0] + av[1] * b[1]) + (av[2] * b[2] + av[3] * b[3]); }
            }
            const float* pn = INP(I_PNORM) + l * 1024 + k0;
#pragma unroll
            for (int h8 = 0; h8 < 2; ++h8) {
                u32x4 o; o.x = cvtpk(acc[8 * h8 + 0] * pn[8 * h8 + 0], acc[8 * h8 + 1] * pn[8 * h8 + 1]); o.y = cvtpk(acc[8 * h8 + 2] * pn[8 * h8 + 2], acc[8 * h8 + 3] * pn[8 * h8 + 3]);
                o.z = cvtpk(acc[8 * h8 + 4] * pn[8 * h8 + 4], acc[8 * h8 + 5] * pn[8 * h8 + 5]); o.w = cvtpk(acc[8 * h8 + 6] * pn[8 * h8 + 6], acc[8 * h8 + 7] * pn[8 * h8 + 7]);
                *(u32x4*)((bf16_t*)(ws + WS_WPC) + (size_t)l * 1024 * 1024 + wt_image_off(n0 + lane, k0 + 8 * h8, 1024)) = o; }
            asm volatile("s_waitcnt lgkmcnt(0)" ::: "memory");
        }
    }
    float* rwt = (float*)(ws + WS_RWT); float* rwg = (float*)(ws + WS_RWG);
    { bf16_t* rwb = (bf16_t*)rwt;
      for (int i = blockIdx.x * NTHREADS + tid; i < DEPTH * NEXP * DM; i += gridDim.x * NTHREADS) { const int l = i >> 15, r = i & 32767, sx = r >> 9, ln = (r >> 3) & 63, jj = r & 7, k = 16 * sx + 8 * (ln >> 5) + jj, e = ln & 31;
        const float v = INP(I_FNORM)[l * 1024 + k] * INP(I_REW)[(size_t)l * 1024 * 32 + k * 32 + e];
        const unsigned hb = cvtpk(v, 0.f) & 0xffffu; const float vh = __builtin_bit_cast(float, hb << 16);
        rwb[(size_t)l * 65536 + r] = (bf16_t)hb; rwb[(size_t)l * 65536 + 32768 + r] = (bf16_t)(cvtpk(v - vh, 0.f) & 0xffffu); } }
    for (int i = blockIdx.x * NTHREADS + tid; i < DEPTH * DM * NGRP; i += gridDim.x * NTHREADS) { const int l = i >> 12, k = (i >> 2) & 1023;
        rwg[i] = INP(I_FNORM)[l * 1024 + k] * INP(I_RGW)[i]; }
}

__device__ __forceinline__ void moe_layer(LAS unsigned char* lds, const XcdBarrier& bar, const int L, const bool fin) {
    const LAS int* ts = (const LAS int*)(lds + TS_OFF);
    {   unsigned char* ws = WSP();
        router_pass((const bf16_t*)(ws + WS_XB), (const bf16_t*)(ws + WS_RWT) + (size_t)L * 65536, (const float*)(ws + WS_RWG) + (size_t)L * DM * NGRP, INP(I_RGB) + L * NGRP, INP(I_REB) + L * NEXP,
                    (float*)(ws + WS_RSFFN), (int*)(ws + WS_TOKE), (float*)(ws + WS_TOKW), (int*)(ws + WS_CNT), lds); }
    xcd_barrier(bar);
    {   unsigned char* ws = WSP();
        assign_pass((const int*)(ws + WS_CNT), (const int*)(ws + WS_TOKE), (const float*)(ws + WS_RSFFN), (int*)(ws + WS_TOKS), (int*)(ws + WS_SLOTTOK), (float*)(ws + WS_SLOTRS), lds); }
    xcd_barrier(bar);
    {   unsigned char* ws = WSP();
        GroupSched S; S.init_grid(); S.A = (const char*)(ws + WS_ACT + ACT_X8); S.lda = DM; S.slot_tok = (const int*)(ws + WS_SLOTTOK); S.Bt = (const char*)(ws + WS_WGU) + (size_t)L * NEXP * 1024 * 1024; S.strideE = (size_t)1024 * 1024; S.K = DM / 2; S.ts = ts;
        EpiGateUp E{ws + WS_ACT + ACT_H, (const float*)(ws + WS_SLOTRS)};
        int kx = DM; asm volatile("" : "+s"(kx));
        pg8::gemm_phase<EpiGateUp, GroupSched, true, true>(lds, kx, S, E); }
    xcd_barrier(bar);
    {   unsigned char* ws = WSP();
        GroupSched S; S.init_grid(); S.A = (const char*)(ws + WS_ACT + ACT_H); S.lda = EFF; S.slot_tok = nullptr; S.Bt = (const char*)(ws + WS_WDN) + (size_t)L * NEXP * 1024 * 512; S.strideE = (size_t)1024 * 512; S.K = EFF / 2; S.ts = ts;
        EpiY8 E{ws + WS_ACT + ACT_Y};
        int kx = EFF; asm volatile("" : "+s"(kx));
        pg8::gemm_phase<EpiY8, GroupSched, true, true>(lds, kx, S, E); }
    xcd_barrier(bar);
    {   unsigned char* ws = WSP(); float* xo = OUTP();
        if (fin) row_pass<2>(nullptr, xo, (bf16_t*)(ws + WS_XB), nullptr, (const unsigned char*)(ws + WS_ACT + ACT_Y), (const int*)(ws + WS_TOKS), (const float*)(ws + WS_TOKW), lds);
        else { row_pass<1>(nullptr, nullptr, (bf16_t*)(ws + WS_XB), (float*)(ws + WS_RSMIX), (const unsigned char*)(ws + WS_ACT + ACT_Y), (const int*)(ws + WS_TOKS), (const float*)(ws + WS_TOKW), lds); } }
    if (!fin) xcd_barrier(bar);
}

__global__ void __launch_bounds__(NTHREADS, 2) hybrid_fwd(Args a) {
    extern __shared__ __attribute__((aligned(16))) unsigned char lds_raw[];
    LAS unsigned char* lds = (LAS unsigned char*)lds_raw;
    volatile LAS unsigned* MISC = (volatile LAS unsigned*)(lds + MISC_OFF);
    const int tid = threadIdx.x;
    if (tid < 64) MISC[tid] = 0u;
    if (tid < 27) ((LAS unsigned long long*)(lds + ARG_OFF))[tid] = ((const __attribute__((address_space(4))) unsigned long long*)__builtin_amdgcn_kernarg_segment_ptr())[tid];
    __syncthreads();
    XcdBarrier bar = xcd_barrier_post((unsigned*)(a.ws + WS_CTL) + CW_BAR, MISC + 8);

    prologue(lds);
    {   unsigned char* ws = WSP();
        row_pass<0>(INP(I_X), nullptr, (bf16_t*)(ws + WS_XB), (float*)(ws + WS_RSMIX), nullptr, nullptr, nullptr, lds); }
    xcd_barrier(bar);

    for (int lp = 0; lp < 2; ++lp) {
        {   unsigned char* ws = WSP();
            PlainSched S; S.init_grid(); S.A = (const char*)(ws + WS_XB); S.lda = DM * 2; S.Bt = (const char*)(ws + WS_WQKV) + (size_t)lp * 3072 * 1024 * 2; S.K = DM; S.nN = 12; S.nrt = NTOK / 256;
            LAS float* gl = (LAS float*)(lds + attn::WSF_OFF);
            { const int t_ = opaque_tid(); if (t_ < 128) gl[t_] = t_ < 64 ? INP(I_QG)[lp * HD + t_] : INP(I_KG)[lp * HD + t_ - 64]; }
            __syncthreads();
            EpiQKV E{(bf16_t*)(ws + WS_ACT + ACT_Q), (const float*)(ws + WS_RSMIX), gl};
            pg8::gemm_phase<EpiQKV, PlainSched, true>(lds, DM, S, E); }
        xcd_barrier(bar);
        {   unsigned char* ws = WSP();
            const float* lq1 = INP(I_LQ1) + lp * HD; const float* lk1 = INP(I_LK1) + lp * HD; const float* lq2 = INP(I_LQ2) + lp * HD; const float* lk2 = INP(I_LK2) + lp * HD;
            float d1 = 0.f, d2 = 0.f;
            for (int i = 0; i < HD; ++i) { d1 += lq1[i] * lk1[i]; d2 += lq2[i] * lk2[i]; }
            const float li = 0.8f - 0.6f * expf(-0.3f * (float)(2 * lp));
            bf16_t* Qb = (bf16_t*)(ws + WS_ACT + ACT_Q);
            attn::Params P{Qb, Qb + (size_t)NTOK * DM, Qb + (size_t)2 * NTOK * DM, Qb, INP(I_RELB), INP(I_SUBLN) + lp * 128, expf(d1) - expf(d2) + li, 1.f - li};
            attn::attn_phase(P, lds); }
        xcd_barrier(bar);
        {   unsigned char* ws = WSP(); float* xo = OUTP();
            PlainSched S; S.init_grid(); S.A = (const char*)(ws + WS_ACT + ACT_Q); S.lda = DM * 2; S.Bt = (const char*)(ws + WS_WO) + (size_t)lp * 1024 * 1024 * 2; S.K = DM; S.nN = 4; S.nrt = NTOK / 256;
            EpiRes E{(bf16_t*)(ws + WS_XB), nullptr, ws + WS_ACT + ACT_X8, 1.f};
            pg8::gemm_phase<EpiRes, PlainSched, true>(lds, DM, S, E); }
        xcd_barrier(bar);
        moe_layer(lds, bar, 2 * lp, false);
        {   unsigned char* ws = WSP();
            PlainSched S; S.init_grid(); S.A = (const char*)(ws + WS_XB); S.lda = DM * 2; S.Bt = (const char*)(ws + WS_WPC) + (size_t)lp * 1024 * 1024 * 2; S.K = DM; S.nN = 4; S.nrt = NTOK / 256;
            EpiBf16 E{(bf16_t*)(ws + WS_ACT + ACT_U), DM, (const float*)(ws + WS_RSMIX)};
            pg8::gemm_phase<EpiBf16, PlainSched, true>(lds, DM, S, E); }
        xcd_barrier(bar);
        {   unsigned char* ws = WSP(); pool_pass((const bf16_t*)(ws + WS_ACT + ACT_U), ws + WS_ACT + ACT_P); }
        xcd_barrier(bar);
        {   unsigned char* ws = WSP(); float* xo = OUTP();
            PlainSched S; S.init_grid(); S.A = (const char*)(ws + WS_ACT + ACT_P); S.lda = DM; S.Bt = (const char*)(ws + WS_WPO) + (size_t)lp * 1024 * 1024; S.K = DM / 2; S.nN = 4; S.nrt = NTOK / 256;
            EpiRes E{(bf16_t*)(ws + WS_XB), INP(I_PSCALE) + lp * DM, ws + WS_ACT + ACT_X8, 1.f / (A8_SCALE * WN8_SCALE)};
            int kx = DM; asm volatile("" : "+s"(kx));
            pg8::gemm_phase<EpiRes, PlainSched, true, true>(lds, kx, S, E); }
        xcd_barrier(bar);
        moe_layer(lds, bar, 2 * lp + 1, lp == 1);
    }
}

extern "C" void kernel_launch(void* const* d_in, const int* in_sizes, int n_in, void* d_out, int out_size, void* d_ws, size_t ws_size, hipStream_t stream) {
    static int grid = 0;
    if (grid == 0) {
        if (n_in != 25 || out_size != NTOK * DM || ws_size < WS_END) { fprintf(stderr, "kernel_launch: unexpected problem (n_in %d, out %d, ws %zu)\n", n_in, out_size, ws_size); grid = -1; return; }
        int dev = 0, cus = 0;
        if (hipGetDevice(&dev) != hipSuccess || hipDeviceGetAttribute(&cus, hipDeviceAttributeMultiprocessorCount, dev) != hipSuccess) { grid = -1; return; }
        if (hipFuncSetAttribute((const void*)hybrid_fwd, hipFuncAttributeMaxDynamicSharedMemorySize, LDS_BYTES) != hipSuccess) { fprintf(stderr, "kernel_launch: hipFuncSetAttribute failed\n"); grid = -1; return; }
        int per_cu = 0;
        if (hipOccupancyMaxActiveBlocksPerMultiprocessor(&per_cu, (const void*)hybrid_fwd, NTHREADS, LDS_BYTES) != hipSuccess || per_cu < 1) fprintf(stderr, "kernel_launch: occupancy query says %d\n", per_cu);
        (void)hipGetLastError();
        grid = cus > 256 ? 256 : cus;
    }
    if (grid < 0) return;
    (void)hipMemsetAsync((char*)d_ws + WS_CTL, 0, CTL_ZERO_BYTES, stream);
    Args a{};
    for (int i = 0; i < 25; ++i) a.in[i] = (const float*)d_in[i];
    a.out = (float*)d_out; a.ws = (unsigned char*)d_ws;
    hipLaunchKernelGGL(hybrid_fwd, dim3(grid), dim3(NTHREADS), LDS_BYTES, stream, a);
}
```

```cpp
#include <hip/hip_runtime.h>
#include <cstdio>
#include <cstdint>

#define GAS __attribute__((address_space(1)))
#define LAS __attribute__((address_space(3)))
typedef unsigned short bf16_t;
typedef short bf16x8 __attribute__((ext_vector_type(8)));
typedef short s16x4 __attribute__((ext_vector_type(4)));
typedef float f32x2 __attribute__((ext_vector_type(2)));
typedef float f32x4 __attribute__((ext_vector_type(4)));
typedef float f32x16 __attribute__((ext_vector_type(16)));
typedef unsigned u32x2 __attribute__((ext_vector_type(2)));
typedef unsigned u32x4 __attribute__((ext_vector_type(4)));
typedef int i32x8 __attribute__((ext_vector_type(8)));
typedef __bf16 bf16x2_t __attribute__((ext_vector_type(2)));

constexpr int NB = 16, SEQ = 4096, DM = 1024, NTOK = NB * SEQ, DEPTH = 4;
constexpr int NHEAD = 8, HD = 64;
constexpr int NEXP = 32, EPG = 8, NGRP = 4, EFF = 512;
constexpr int MAXSLOT = 139264;
constexpr float EPS = 1e-6f;
constexpr float LOG2E = 1.4426950408889634f;
constexpr int NWAVES = 8, NTHREADS = 512;

constexpr size_t MiB = 1u << 20;
constexpr size_t WS_CTL = 0, CTL_ZERO_BYTES = 1 * MiB;
constexpr size_t WS_RSMIX = 4 * MiB;
constexpr size_t WS_RSFFN = WS_RSMIX + 256 * 1024;
constexpr size_t WS_TOKE = WS_RSFFN + 256 * 1024;
constexpr size_t WS_TOKW = WS_TOKE + 512 * 1024;
constexpr size_t WS_TOKS = WS_TOKW + 512 * 1024;
constexpr size_t WS_SLOTTOK = WS_TOKS + 512 * 1024;
constexpr size_t WS_SLOTRS = WS_SLOTTOK + 576 * 1024;
constexpr size_t WS_CNT = WS_SLOTRS + 576 * 1024;
constexpr size_t WS_RWT = WS_CNT + 64 * 1024;
constexpr size_t WS_RWG = WS_RWT + 512 * 1024;
constexpr size_t WS_SMALL_END = WS_RWG + 64 * 1024;
static_assert(WS_SMALL_END <= 16 * MiB, "small arrays");
constexpr size_t WS_WQKV = 16 * MiB;
constexpr size_t WS_WO = WS_WQKV + 12 * MiB;
constexpr size_t WS_WPC = WS_WO + 4 * MiB;
constexpr size_t WS_WPO = WS_WPC + 4 * MiB;
constexpr size_t WS_WGU = WS_WPO + 4 * MiB;
constexpr size_t WS_WDN = WS_WGU + 256 * MiB;
constexpr size_t WS_XB = WS_WDN + 128 * MiB;
constexpr size_t WS_ACT = WS_XB + 128 * MiB;
constexpr size_t WS_END = WS_ACT + 408 * MiB;
static_assert(WS_END <= 1126807104ull, "d_ws map exceeds the guaranteed workspace");
constexpr float A8_SCALE = 8.f, WN8_SCALE = 64.f;
constexpr size_t ACT_Q = 0, ACT_K = 128 * MiB, ACT_V = 256 * MiB;
constexpr size_t ACT_U = 0, ACT_P = 128 * MiB;
constexpr size_t ACT_H = 0, ACT_Y = 136 * MiB, ACT_X8 = 288 * MiB;
constexpr int CW_BAR = 4096;
constexpr int CW_TILES = 16384;

constexpr int RING_BYTES = 131072;
constexpr int LUT_OFF = RING_BYTES;
constexpr int LUT_N = 336;
constexpr int MISC_OFF = LUT_OFF + NHEAD * LUT_N * 4;
constexpr int TS_OFF = MISC_OFF + 256;
constexpr int LDS_BYTES = 147456;
static_assert(TS_OFF + 256 <= LDS_BYTES, "LDS map");

#define RLX_AGENT __ATOMIC_RELAXED, __HIP_MEMORY_SCOPE_AGENT
__device__ __forceinline__ unsigned cvtpk(float lo, float hi) { f32x2 v = {lo, hi}; bf16x2_t b = __builtin_convertvector(v, bf16x2_t); return __builtin_bit_cast(unsigned, b); }
__device__ __forceinline__ float bf2f(unsigned short h) { return __builtin_bit_cast(float, (unsigned)h << 16); }
__device__ __forceinline__ float wave_sum(float v) {
#pragma unroll
    for (int o = 1; o < 64; o <<= 1) v += __shfl_xor(v, o);
    return v;
}

__device__ __forceinline__ int opaque_tid() { int t = threadIdx.x; asm volatile("" : "+v"(t)); return t; }

#define XB_TMO      128
#define XB_XCNT(j)  (256  + 64 * (j))
#define XB_XSUB(j)  (1280 + 64 * (j))
#define XB_XGEN(j)  (2304 + 64 * (j))
#define XB_TOP      3328
#define XB_TOPGEN   3392
#define XCD_BAR_WORDS 3456
#define XB_SPIN_CAP (1u << 18)
__device__ __forceinline__ unsigned xb_ld(unsigned* p)              { return __hip_atomic_load(p, __ATOMIC_RELAXED, __HIP_MEMORY_SCOPE_AGENT); }
__device__ __forceinline__ unsigned xb_add(unsigned* p, unsigned v) { return __hip_atomic_fetch_add(p, v, __ATOMIC_RELAXED, __HIP_MEMORY_SCOPE_AGENT); }
__device__ __forceinline__ unsigned xb_xcc_id() { return (unsigned)__builtin_amdgcn_s_getreg((3 << 11) | 20) & 0xFu; }
#define XB_SPIN(cond, bar) do { unsigned _sp = 0; while (cond) { __builtin_amdgcn_s_sleep(1); \
    if ((++_sp & 255u) == 0u) { if (xb_ld(&(bar)[XB_TMO])) break; if (_sp > XB_SPIN_CAP) { atomicAdd(&(bar)[XB_TMO], 1u); break; } } } } while (0)
struct XcdBarrier { unsigned* bar; unsigned x; volatile LAS unsigned* st; };
__device__ __forceinline__ XcdBarrier xcd_barrier_post(unsigned* bar, volatile LAS unsigned* st) {
    XcdBarrier b; b.bar = bar; b.x = xb_xcc_id(); b.st = st;
    if (threadIdx.x == 0) (void)xb_add(&bar[XB_XCNT(b.x)], 1u);
    return b;
}
__device__ __forceinline__ void xcd_barrier_complete(unsigned* bar, unsigned x, unsigned& nloc, unsigned& nx) {
    const unsigned G = gridDim.x * gridDim.y * gridDim.z;
    unsigned sum, cnt, mine, sp = 0u;
    for (;;) {
        sum = 0u; cnt = 0u; mine = 0u;
#pragma unroll
        for (unsigned j = 0; j < 16; ++j) { const unsigned c = xb_ld(&bar[XB_XCNT(j)]); sum += c; cnt += (c > 0u) ? 1u : 0u; mine = (j == x) ? c : mine; }
        if (sum == G) break;
        __builtin_amdgcn_s_sleep(1);
        if ((++sp & 255u) == 0u) { if (xb_ld(&bar[XB_TMO])) break; if (sp > XB_SPIN_CAP) { atomicAdd(&bar[XB_TMO], 1u); break; } }
    }
    nloc = mine > 0u ? mine : 1u; nx = cnt > 0u ? cnt : 1u;
}
__device__ __forceinline__ void xcd_barrier(const XcdBarrier& b) {
    asm volatile("s_waitcnt vmcnt(0)" ::: "memory");
    __syncthreads();
    if (threadIdx.x == 0) {
        unsigned* bar = b.bar;
        __builtin_amdgcn_s_waitcnt(0);
        unsigned nloc = b.st[0], nx = b.st[1];
        if (nloc == 0u) { xcd_barrier_complete(bar, b.x, nloc, nx); b.st[0] = nloc; b.st[1] = nx; }
        const unsigned old = xb_add(&bar[XB_XSUB(b.x)], 1u);
        const unsigned gen = old / nloc;
        if (old + 1u == (gen + 1u) * nloc) {
            __builtin_amdgcn_fence(__ATOMIC_RELEASE, "agent");
            asm volatile("s_waitcnt vmcnt(0)" ::: "memory");
            const unsigned og = xb_add(&bar[XB_TOP], 1u);
            const unsigned tg = og / nx;
            if (og + 1u == (tg + 1u) * nx) xb_add(&bar[XB_TOPGEN], 1u);
            else XB_SPIN(xb_ld(&bar[XB_TOPGEN]) == tg, bar);
            __builtin_amdgcn_fence(__ATOMIC_ACQUIRE, "agent");
            xb_add(&bar[XB_XGEN(b.x)], 1u);
            asm volatile("s_waitcnt vmcnt(0)" ::: "memory");
        } else {
            XB_SPIN(xb_ld(&bar[XB_XGEN(b.x)]) == gen, bar);
            __builtin_amdgcn_fence(__ATOMIC_ACQUIRE, "agent");
            asm volatile("s_waitcnt vmcnt(0)" ::: "memory");
        }
    }
    __syncthreads();
}

namespace pg8 {
constexpr int BM = 256, BK = 64, HALF = 128, HTB = HALF * BK * 2, STAGE_BYTES = 8 * HTB;
__host__ __device__ __forceinline__ int lds_byte(int r, int c) { const int st = (r >> 4) * 2 + (c >> 5), rr = r & 15, cc = c & 31, ob = rr * 64 + cc * 2; return st * 1024 + (ob ^ (((ob >> 9) & 1) << 5)); }
__host__ __device__ __forceinline__ void stage_rc(int b, int& R, int& C) { const int st = b / 1024, sb = b % 1024, swz = sb ^ (((sb >> 9) & 1) << 5); R = (st >> 1) * 16 + swz / 64; C = (st & 1) * 32 + (swz % 64) / 2; }
__host__ __device__ __forceinline__ int perm32(int rho) { const int n = rho >> 4, i = rho & 15; return 8 * (i >> 2) + 4 * n + (i & 3); }
struct Unit { int pm, pn, e; };

template <class Epi, class Sched, bool ALIGN_EPI, bool FP8 = false>
__device__ __forceinline__ void gemm_phase(LAS unsigned char* lds, const int K, const Sched& S, const Epi& E) {
    const int tid = opaque_tid(), wid = __builtin_amdgcn_readfirstlane(tid >> 6), lane = tid & 63, wr = wid >> 2, wc = wid & 3, fr = lane & 15, fq = lane >> 4;
    const int nt = FP8 ? K / 128 : K / BK;
    int RA[2], CA[2]; unsigned voffB[2];
#pragma unroll
    for (int i = 0; i < 2; ++i) { int R, C; stage_rc(tid * 16 + i * 8192, R, C); RA[i] = R; CA[i] = C * 2;
        voffB[i] = (unsigned)(tid * 16 + i * 8192); }
    const size_t kstep = (size_t)(BK * 2);
    const size_t hstepB = 16384, kstepB = 32768;
    const unsigned ldsw = (unsigned)wid * 1024u;
    const int aoff = lds_byte(wr * 64 + fr, fq * 8), boff = lds_byte(wc * 32 + fr, fq * 8);
    const int aoff8 = lds_byte(wr * 64 + fr, fq * 16), boff8 = lds_byte(wc * 32 + fr, fq * 16);
#define PG8_SA(b, h) (((b) * 2 + (h)) * HTB)
#define PG8_SB(b, h) ((4 + (b) * 2 + (h)) * HTB)
#define PG8_STAGE(bufoff, gbase, v0, v1) do { const char* gb_ = (const char*)(gbase); unsigned v0_ = (v0), v1_ = (v1); asm volatile("" : "+s"(gb_), "+v"(v0_), "+v"(v1_)); \
        __builtin_amdgcn_global_load_lds((const unsigned*)(gb_ + v0_), (LAS unsigned*)(lds + (bufoff) + ldsw), 16, 0, 0); \
        __builtin_amdgcn_global_load_lds((const unsigned*)(gb_ + v1_), (LAS unsigned*)(lds + (bufoff) + ldsw + 8192), 16, 0, 0); } while (0)
#define PG8_STAGEA(bufoff, gbase, V, h) PG8_STAGE(bufoff, gbase, V[h][0], V[h][1])
#define PG8_STAGEB(bufoff, gbase) PG8_STAGE(bufoff, gbase, voffB[0], voffB[1])
#define PG8_LDA(dst, b, h) do { if constexpr (FP8) { _Pragma("unroll") for (int m = 0; m < 4; ++m) { const u32x4 l_ = *(const LAS u32x4*)(lds + PG8_SA(b, h) + aoff8 + m * 2048), h_ = *(const LAS u32x4*)(lds + PG8_SA(b, h) + aoff8 + m * 2048 + 16); \
            dst##8[m] = (i32x8){(int)l_.x, (int)l_.y, (int)l_.z, (int)l_.w, (int)h_.x, (int)h_.y, (int)h_.z, (int)h_.w}; } } \
        else { _Pragma("unroll") for (int m = 0; m < 4; ++m) _Pragma("unroll") for (int k = 0; k < 2; ++k) dst[m][k] = *(const LAS bf16x8*)(lds + PG8_SA(b, h) + aoff + m * 2048 + k * 1024); } } while (0)
#define PG8_LDB(dst, b, h) do { if constexpr (FP8) { _Pragma("unroll") for (int n = 0; n < 2; ++n) { const u32x4 l_ = *(const LAS u32x4*)(lds + PG8_SB(b, h) + boff8 + n * 2048), h_ = *(const LAS u32x4*)(lds + PG8_SB(b, h) + boff8 + n * 2048 + 16); \
            dst##8[n] = (i32x8){(int)l_.x, (int)l_.y, (int)l_.z, (int)l_.w, (int)h_.x, (int)h_.y, (int)h_.z, (int)h_.w}; } } \
        else { _Pragma("unroll") for (int n = 0; n < 2; ++n) _Pragma("unroll") for (int k = 0; k < 2; ++k) dst[n][k] = *(const LAS bf16x8*)(lds + PG8_SB(b, h) + boff + n * 2048 + k * 1024); } } while (0)
#define PG8_MMA(ai, bj, At, Bt) do { __builtin_amdgcn_s_setprio(1); \
        if constexpr (FP8) { _Pragma("unroll") for (int m = 0; m < 4; ++m) _Pragma("unroll") for (int n = 0; n < 2; ++n) \
            acc[ai][bj][m][n] = __builtin_amdgcn_mfma_scale_f32_16x16x128_f8f6f4(Bt##8[n], At##8[m], acc[ai][bj][m][n], 0, 0, 0, 0x7f7f7f7f, 0, 0x7f7f7f7f); } \
        else { _Pragma("unroll") for (int m = 0; m < 4; ++m) _Pragma("unroll") for (int n = 0; n < 2; ++n) _Pragma("unroll") for (int k = 0; k < 2; ++k) \
            acc[ai][bj][m][n] = __builtin_amdgcn_mfma_f32_16x16x32_bf16(Bt[n][k], At[m][k], acc[ai][bj][m][n], 0, 0, 0); } \
        __builtin_amdgcn_s_setprio(0); } while (0)
#define PG8_WAIT_V(n) asm volatile("s_waitcnt vmcnt(" #n ")" ::: "memory")
#define PG8_WAIT_L(n) asm volatile("s_waitcnt lgkmcnt(" #n ")" ::: "memory")
#define PG8_BAR __builtin_amdgcn_s_barrier()
#define PG8_SCHED __builtin_amdgcn_sched_barrier(0)
#define PG8_SCHED8 do { if constexpr (FP8) __builtin_amdgcn_sched_barrier(0); } while (0)
    Unit cur, nxt; int ui = 0;
    if (!S.next(0, cur)) return;
    f32x4 acc[2][2][4][2];
#pragma unroll
    for (int a = 0; a < 2; ++a)
#pragma unroll
        for (int b = 0; b < 2; ++b)
#pragma unroll
            for (int m = 0; m < 4; ++m)
#pragma unroll
                for (int n = 0; n < 2; ++n) acc[a][b][m][n] = (f32x4){0.f, 0.f, 0.f, 0.f};
    bf16x8 At[4][2], B0[2][2], B1[2][2]; i32x8 At8[4], B08[2], B18[2];
    const char* const Ab = S.a_base();
    unsigned cvA[2][2];
#pragma unroll
    for (int h = 0; h < 2; ++h)
#pragma unroll
        for (int i = 0; i < 2; ++i) cvA[h][i] = S.a_row_off(cur, h * HALF + RA[i]) + (unsigned)CA[i];
    const char* cB = S.b_base(cur);
    PG8_STAGEB(PG8_SB(0, 0), cB); PG8_STAGEB(PG8_SB(0, 1), cB + hstepB); PG8_STAGEA(PG8_SA(0, 0), Ab, cvA, 0); PG8_STAGEA(PG8_SA(0, 1), Ab, cvA, 1);
    if (wr == 1) PG8_BAR;
    PG8_WAIT_V(2); PG8_BAR;
    PG8_STAGEB(PG8_SB(1, 0), cB + kstepB); PG8_STAGEA(PG8_SA(1, 0), Ab + kstep, cvA, 0); PG8_STAGEB(PG8_SB(1, 1), cB + hstepB + kstepB);
    PG8_WAIT_V(6); PG8_BAR;
    for (;;) {
        const bool has_next = S.next(ui + 1, nxt);
        const char* nB = has_next ? S.b_base(nxt) : cB;
        for (int t = 0; t < nt; t += 2) {
            const bool last = (t == nt - 2);
            const char* a1 = Ab + (size_t)(t + 1) * kstep;
            const char* a2 = last ? Ab : Ab + (size_t)(t + 2) * kstep; const char* b2 = last ? nB : cB + (size_t)(t + 2) * kstepB;
            const char* a3 = a2 + kstep; const char* b3 = b2 + kstepB;
            PG8_LDB(B0, 0, 0); PG8_LDB(B1, 0, 1); PG8_SCHED; PG8_LDA(At, 0, 0); PG8_STAGEA(PG8_SA(1, 1), a1, cvA, 1);
            if (last && has_next) {
#pragma unroll
                for (int h = 0; h < 2; ++h)
#pragma unroll
                    for (int i = 0; i < 2; ++i) cvA[h][i] = S.a_row_off(nxt, h * HALF + RA[i]) + (unsigned)CA[i]; }
            PG8_WAIT_V(8); PG8_WAIT_L(0); PG8_BAR; PG8_SCHED8; PG8_MMA(0, 0, At, B0); PG8_MMA(0, 1, At, B1); PG8_SCHED8; PG8_BAR; PG8_SCHED;
            PG8_LDA(At, 0, 1); PG8_STAGEB(PG8_SB(0, 0), b2); PG8_STAGEB(PG8_SB(0, 1), b2 + hstepB); PG8_STAGEA(PG8_SA(0, 0), a2, cvA, 0);
            PG8_WAIT_V(8); PG8_WAIT_L(0); PG8_BAR; PG8_SCHED8; PG8_MMA(1, 0, At, B0); PG8_MMA(1, 1, At, B1); PG8_SCHED8; PG8_BAR; PG8_SCHED;
            PG8_LDB(B0, 1, 0); PG8_LDB(B1, 1, 1); PG8_SCHED; PG8_LDA(At, 1, 0); PG8_STAGEA(PG8_SA(0, 1), a2, cvA, 1);
            PG8_WAIT_V(8); PG8_WAIT_L(0); PG8_BAR; PG8_SCHED8; PG8_MMA(0, 0, At, B0); PG8_MMA(0, 1, At, B1); PG8_SCHED8; PG8_BAR; PG8_SCHED;
            PG8_LDA(At, 1, 1); PG8_STAGEB(PG8_SB(1, 0), b3); PG8_STAGEB(PG8_SB(1, 1), b3 + hstepB); PG8_STAGEA(PG8_SA(1, 0), a3, cvA, 0);
            PG8_WAIT_V(8); PG8_WAIT_L(0); PG8_BAR; PG8_SCHED8; PG8_MMA(1, 0, At, B0); PG8_MMA(1, 1, At, B1); PG8_SCHED8; PG8_BAR; PG8_SCHED;
        }
        if constexpr (ALIGN_EPI) { if (wr == 0) PG8_BAR; }
        E(acc, cur, wr, wc, fr, fq);
        if (!has_next) break;
#pragma unroll
        for (int a = 0; a < 2; ++a)
#pragma unroll
            for (int b = 0; b < 2; ++b)
#pragma unroll
                for (int m = 0; m < 4; ++m)
#pragma unroll
                    for (int n = 0; n < 2; ++n) acc[a][b][m][n] = (f32x4){0.f, 0.f, 0.f, 0.f};
        cur = nxt; cB = nB; ++ui;
        if constexpr (ALIGN_EPI) { if (wr == 1) PG8_BAR; }
    }
    PG8_WAIT_V(0);
    if constexpr (!ALIGN_EPI) { if (wr == 0) PG8_BAR; }
    PG8_BAR;
#undef PG8_SA
#undef PG8_SB
#undef PG8_STAGE
#undef PG8_STAGEA
#undef PG8_STAGEB
#undef PG8_LDA
#undef PG8_LDB
#undef PG8_MMA
#undef PG8_WAIT_V
#undef PG8_WAIT_L
#undef PG8_BAR
#undef PG8_SCHED
#undef PG8_SCHED8
}
}

struct SchedBase { int x, j, G8, NGp; __device__ __forceinline__ void init_grid() { const int G = gridDim.x, bx = blockIdx.x; if (G % 8 == 0) { NGp = 8; x = bx % 8; j = bx / 8; G8 = G / 8; } else { NGp = 1; x = 0; j = bx; G8 = G; } } };
struct PlainSched : SchedBase {
    const char* A; unsigned lda; const char* Bt; int K, nN, nrt;
    __device__ __forceinline__ bool next(int i, pg8::Unit& u) const { const int U = i * G8 + j, nrtg = (nrt - x + NGp - 1) / NGp; if (U >= nrtg * nN) return false; const int q = U / nN; u.pn = U - q * nN; u.pm = x + NGp * q; return true; }
    __device__ __forceinline__ const char* a_base() const { return A; }
    __device__ __forceinline__ unsigned a_row_off(const pg8::Unit& u, int r) const { return (unsigned)(u.pm * 256 + r) * lda; }
    __device__ __forceinline__ const char* b_base(const pg8::Unit& u) const { return Bt + (size_t)u.pn * 256 * K * 2; }
};
struct GroupSched : SchedBase {
    const char* A; unsigned lda; const int* slot_tok; const char* Bt; size_t strideE; int K; const LAS int* ts;
    __device__ __forceinline__ bool next(int i, pg8::Unit& u) const {
        const int U = i * G8 + j; int q = U >> 2; u.pn = U & 3;
        for (int e = x; e < NEXP; e += NGp) { const int t0 = __builtin_amdgcn_readfirstlane(ts[e]), n = __builtin_amdgcn_readfirstlane(ts[e + 1]) - t0; if (q < n) { u.pm = t0 + q; u.e = e; return true; } q -= n; }
        return false; }
    __device__ __forceinline__ const char* a_base() const { return A; }
    __device__ __forceinline__ unsigned a_row_off(const pg8::Unit& u, int r) const { int row = u.pm * 256 + r; if (slot_tok) row = slot_tok[row]; return (unsigned)row * lda; }
    __device__ __forceinline__ const char* b_base(const pg8::Unit& u) const { return Bt + (size_t)u.e * strideE + (size_t)u.pn * 256 * K * 2; }
};

typedef f32x4 Acc[2][2][4][2];
struct EpiQKV {
    bf16_t* Q; const float* rstd; const LAS float* gl;
    __device__ __forceinline__ void operator()(const Acc& acc, const pg8::Unit& u, int wr, int wc, int fr, int fq) const {
        const int part = u.pn >> 2, colp = (u.pn & 3) * 256 + wc * 64 + 8 * fq;
        bf16_t* base = Q + (size_t)part * NTOK * DM;
        const float qs = part == 0 ? 0.125f * LOG2E : 1.f;
#pragma unroll
        for (int ai = 0; ai < 2; ++ai)
#pragma unroll
            for (int m = 0; m < 4; ++m) {
                const int row = u.pm * 256 + ai * 128 + wr * 64 + m * 16 + fr;
                const float rs = rstd[row];
                float f = rs;
                if (part < 2) { float ss = 0.f;
#pragma unroll
                    for (int bj = 0; bj < 2; ++bj)
#pragma unroll
                        for (int n = 0; n < 2; ++n) { const f32x4 t = acc[ai][bj][m][n] * rs; const f32x4 t2 = t * t; ss += (t2[0] + t2[1]) + (t2[2] + t2[3]); }
                    ss += __shfl_xor(ss, 16); ss += __shfl_xor(ss, 32); f = rs * __builtin_amdgcn_rsqf(ss * (1.f / 64.f) + EPS) * qs; }
                const int hh = (u.pn & 3) * 2 + (wc >> 1), tl = (row & (SEQ - 1)) >> 6, rr = row & 63;
                const size_t tb = ((size_t)((row >> 12) * NHEAD + hh) * 64 + tl) * 8192;
#pragma unroll
                for (int bj = 0; bj < 2; ++bj) {
                    f32x4 g0 = {f, f, f, f}, g1 = g0;
                    if (part < 2) { const LAS f32x4* gp = (const LAS f32x4*)(gl + part * 64 + 32 * bj + 8 * fq); g0 = gp[0] * f; g1 = gp[1] * f; }
                    const f32x4 a = acc[ai][bj][m][0] * g0, b = acc[ai][bj][m][1] * g1;
                    u32x4 w; w.x = cvtpk(a[0], a[1]); w.y = cvtpk(a[2], a[3]); w.z = cvtpk(b[0], b[1]); w.w = cvtpk(b[2], b[3]);
                    if (part == 0) *(u32x4*)(base + (size_t)row * DM + colp + 32 * bj) = w;
                    else if (part == 1) *(u32x4*)(base + tb + ((wc & 1) * 8 + 4 * bj + fq) * 512 + rr * 8) = w;
                    else *(u32x4*)(base + tb + (2 * (wc & 1) + bj) * 2048 + rr * 32 + 8 * fq) = w; }
            }
    }
};
__device__ __forceinline__ int cvt8(float a, float b, int old, bool hi) {
    a = __builtin_amdgcn_fmed3f(a, -448.f, 448.f); b = __builtin_amdgcn_fmed3f(b, -448.f, 448.f);
    return hi ? __builtin_amdgcn_cvt_pk_fp8_f32(a, b, old, true) : __builtin_amdgcn_cvt_pk_fp8_f32(a, b, old, false);
}
struct EpiBf16 {
    bf16_t* O; int ldc; const float* rstd;
    __device__ __forceinline__ void operator()(const Acc& acc, const pg8::Unit& u, int wr, int wc, int fr, int fq) const {
        const int col = u.pn * 256 + wc * 64 + 8 * fq;
        float rsv[2][4];
#pragma unroll
        for (int ai = 0; ai < 2; ++ai)
#pragma unroll
            for (int m = 0; m < 4; ++m) rsv[ai][m] = rstd ? rstd[u.pm * 256 + ai * 128 + wr * 64 + m * 16 + fr] : 1.f;
        asm volatile("" : "+v"(rsv[0][0]), "+v"(rsv[0][1]), "+v"(rsv[0][2]), "+v"(rsv[0][3]), "+v"(rsv[1][0]), "+v"(rsv[1][1]), "+v"(rsv[1][2]), "+v"(rsv[1][3]) :: "memory");
#pragma unroll
        for (int ai = 0; ai < 2; ++ai)
#pragma unroll
            for (int m = 0; m < 4; ++m) {
                const int row = u.pm * 256 + ai * 128 + wr * 64 + m * 16 + fr;
                const float rs = rsv[ai][m];
#pragma unroll
                for (int bj = 0; bj < 2; ++bj) { const f32x4 a = acc[ai][bj][m][0] * rs, b = acc[ai][bj][m][1] * rs; u32x4 w; w.x = cvtpk(a[0], a[1]); w.y = cvtpk(a[2], a[3]); w.z = cvtpk(b[0], b[1]); w.w = cvtpk(b[2], b[3]);
                    *(u32x4*)(O + (size_t)row * ldc + col + 32 * bj) = w; }
            }
    }
};
constexpr float Y8_SCALE = 16.f;
struct EpiY8 {
    static constexpr int NSTORES = 8;
    unsigned char* Y;
    __device__ __forceinline__ void operator()(const Acc& acc, const pg8::Unit& u, int wr, int wc, int fr, int fq) const {
        const int pos = u.pn * 256 + wc * 64 + 16 * fq;
        constexpr float YS = Y8_SCALE / (16.f * 64.f);
#pragma unroll
        for (int ai = 0; ai < 2; ++ai)
#pragma unroll
            for (int m = 0; m < 4; ++m) {
                const int row = u.pm * 256 + ai * 128 + wr * 64 + m * 16 + fr;
                u32x4 w;
#pragma unroll
                for (int bj = 0; bj < 2; ++bj) { const f32x4 a = acc[ai][bj][m][0] * YS, b = acc[ai][bj][m][1] * YS;
                    int lo = cvt8(a[0], a[1], 0, false); lo = cvt8(a[2], a[3], lo, true);
                    int hi = cvt8(b[0], b[1], 0, false); hi = cvt8(b[2], b[3], hi, true);
                    w[2 * bj] = (unsigned)lo; w[2 * bj + 1] = (unsigned)hi; }
                *(u32x4*)(Y + (size_t)row * DM + pos) = w;
            }
    }
};
constexpr float X8_SCALE = 4.f, WG8_SCALE = 64.f;
struct EpiRes {
    bf16_t* xb; const float* scale; unsigned char* x8; float mul;
    __device__ __forceinline__ void operator()(const Acc& acc, const pg8::Unit& u, int wr, int wc, int fr, int fq) const {
        const int col = u.pn * 256 + wc * 64 + 8 * fq;
        f32x4 sc[2][2];
#pragma unroll
        for (int bj = 0; bj < 2; ++bj)
#pragma unroll
            for (int n = 0; n < 2; ++n) sc[bj][n] = (scale ? *(const f32x4*)(scale + col + 32 * bj + 4 * n) : (f32x4){1.f, 1.f, 1.f, 1.f}) * mul;
#pragma unroll
        for (int ai = 0; ai < 2; ++ai) {
            u32x4 r[2][4][2];
#pragma unroll
            for (int m = 0; m < 4; ++m)
#pragma unroll
                for (int bj = 0; bj < 2; ++bj) r[ai][m][bj] = *(const u32x4*)(xb + (size_t)(u.pm * 256 + ai * 128 + wr * 64 + m * 16 + fr) * DM + col + 32 * bj);
            asm volatile("" ::: "memory");
#pragma unroll
            for (int m = 0; m < 4; ++m) {
                const size_t off = (size_t)(u.pm * 256 + ai * 128 + wr * 64 + m * 16 + fr) * DM + col;
                u32x4 w8;
#pragma unroll
                for (int bj = 0; bj < 2; ++bj) {
                    const u32x4 q = r[ai][m][bj];
                    const f32x4 a = acc[ai][bj][m][0] * sc[bj][0], b = acc[ai][bj][m][1] * sc[bj][1];
                    const float x0 = __builtin_bit_cast(float, q.x << 16) + a[0], x1 = __builtin_bit_cast(float, q.x & 0xffff0000u) + a[1], x2 = __builtin_bit_cast(float, q.y << 16) + a[2], x3 = __builtin_bit_cast(float, q.y & 0xffff0000u) + a[3];
                    const float x4 = __builtin_bit_cast(float, q.z << 16) + b[0], x5 = __builtin_bit_cast(float, q.z & 0xffff0000u) + b[1], x6 = __builtin_bit_cast(float, q.w << 16) + b[2], x7 = __builtin_bit_cast(float, q.w & 0xffff0000u) + b[3];
                    u32x4 w; w.x = cvtpk(x0, x1); w.y = cvtpk(x2, x3); w.z = cvtpk(x4, x5); w.w = cvtpk(x6, x7);
                    *(u32x4*)(xb + off + 32 * bj) = w;
                    int lo = cvt8(x0 * X8_SCALE, x1 * X8_SCALE, 0, false); lo = cvt8(x2 * X8_SCALE, x3 * X8_SCALE, lo, true);
                    int hi = cvt8(x4 * X8_SCALE, x5 * X8_SCALE, 0, false); hi = cvt8(x6 * X8_SCALE, x7 * X8_SCALE, hi, true);
                    w8[2 * bj] = (unsigned)lo; w8[2 * bj + 1] = (unsigned)hi; }
                *(u32x4*)(x8 + (size_t)(u.pm * 256 + ai * 128 + wr * 64 + m * 16 + fr) * DM + u.pn * 256 + wc * 64 + 16 * fq) = w8;
            }
        }
    }
};
constexpr float H8_SCALE = 16.f, WD8_SCALE = 64.f;
struct EpiGateUp {
    static constexpr int NSTORES = 8;
    unsigned char* H; const float* slot_rs;
    __device__ __forceinline__ void operator()(const Acc& acc, const pg8::Unit& u, int wr, int wc, int fr, int fq) const {
#pragma unroll
        for (int ai = 0; ai < 2; ++ai) {
            float rsv[4];
#pragma unroll
            for (int m = 0; m < 4; ++m) rsv[m] = slot_rs[u.pm * 256 + ai * 128 + wr * 64 + m * 16 + fr];
            asm volatile("" : "+v"(rsv[0]), "+v"(rsv[1]), "+v"(rsv[2]), "+v"(rsv[3]) :: "memory");
            u32x2 w[4];
#pragma unroll
            for (int m = 0; m < 4; ++m) {
                const float rs = rsv[m] * (1.f / (X8_SCALE * WG8_SCALE));
                float h[8];
#pragma unroll
                for (int n = 0; n < 2; ++n)
#pragma unroll
                    for (int i = 0; i < 4; ++i) { const float g = acc[ai][0][m][n][i] * rs, up = acc[ai][1][m][n][i] * rs;
                        h[4 * n + i] = g * up * __builtin_amdgcn_rcpf(1.f + __builtin_amdgcn_exp2f(-g * LOG2E)) * H8_SCALE; }
                int lo = cvt8(h[0], h[1], 0, false); lo = cvt8(h[2], h[3], lo, true);
                int hi = cvt8(h[4], h[5], 0, false); hi = cvt8(h[6], h[7], hi, true);
                w[m].x = (unsigned)lo; w[m].y = (unsigned)hi;
            }
            const int odd = fq & 1;
#pragma unroll
            for (int mp = 0; mp < 4; mp += 2) {
                const u32x2 snd = odd ? w[mp] : w[mp + 1], own = odd ? w[mp + 1] : w[mp];
                u32x2 rcv; rcv.x = (unsigned)__shfl_xor((int)snd.x, 16); rcv.y = (unsigned)__shfl_xor((int)snd.y, 16);
                u32x4 o; o.x = odd ? rcv.x : own.x; o.y = odd ? rcv.y : own.y; o.z = odd ? own.x : rcv.x; o.w = odd ? own.y : rcv.y;
                const int row = u.pm * 256 + ai * 128 + wr * 64 + (mp + odd) * 16 + fr;
                *(u32x4*)(H + (size_t)row * EFF + u.pn * 128 + wc * 32 + 8 * (fq & 2)) = o;
            }
        }
    }
};

namespace attn {
constexpr int SLOT = 32768, V_OFF = 16384, NSLOT = 3, X_OFF = NSLOT * SLOT, WSF_OFF = TS_OFF + 256;
static_assert(X_OFF + 4 * 8192 <= RING_BYTES && WSF_OFF + NWAVES * 256 <= LDS_BYTES, "attn LDS");
constexpr int DMAXI = 206;
__device__ __forceinline__ int crow(int r, int hi) { return (r & 3) + 8 * (r >> 2) + 4 * hi; }
__device__ __forceinline__ int rel_bucket(int n) {
    if (n < 16) return n;
    const int l = 16 + (int)(logf((float)n / 16.f) / logf(8.f) * 16.f);
    return l < 31 ? l : 31;
}
struct Params { const bf16_t* Q; const bf16_t* K; const bf16_t* V; bf16_t* O; const float* rel_bias; const float* subln; float lam; float one_minus_li; };

__device__ __forceinline__ void build_lut(LAS unsigned char* lds, const float* rel_bias) {
    LAS float* lut = (LAS float*)(lds + LUT_OFF);
    for (int idx = opaque_tid(); idx < NHEAD * LUT_N; idx += NTHREADS) {
        const int h = idx / LUT_N, i = idx - h * LUT_N, dist = DMAXI - i;
        lut[idx] = dist < 0 ? -INFINITY : (rel_bias[rel_bucket(dist) * NHEAD + h] - rel_bias[31 * NHEAD + h]) * LOG2E;
    }
}
#define ATT_WAIT_BAR(N) asm volatile("s_waitcnt vmcnt(" #N ") lgkmcnt(0)\n\ts_barrier" ::: "memory")
#define ATT_SBAR() __builtin_amdgcn_sched_barrier(0)
#define ATT_PIN(x) asm volatile("" : "+v"(x))
#define ATT_MF(a, b, c) __builtin_amdgcn_mfma_f32_32x32x16_bf16(a, b, c, 0, 0, 0)
#define ATT_VRD8(L, H, ks) do { _Pragma("unroll") for (int d_ = 0; d_ < 4; ++d_) { \
        asm volatile("ds_read_b64_tr_b16 %0, %1 offset:%c2" : "=&v"(L[d_]) : "v"(vaddr), "i"(V_OFF + d_ * 4096 + (ks) * 1024) : "memory"); \
        asm volatile("ds_read_b64_tr_b16 %0, %1 offset:%c2" : "=&v"(H[d_]) : "v"(vaddr), "i"(V_OFF + d_ * 4096 + (ks) * 1024 + 512) : "memory"); } } while (0)
#define ATT_VWAIT(N, L, H) do { asm volatile("s_waitcnt lgkmcnt(" #N ")" : "+v"(L[0]), "+v"(L[1]), "+v"(L[2]), "+v"(L[3]), "+v"(H[0]), "+v"(H[1]), "+v"(H[2]), "+v"(H[3]) :: "memory"); ATT_SBAR(); } while (0)
#define ATT_VF(L, H, d) ((bf16x8){L[d][0], L[d][1], L[d][2], L[d][3], H[d][0], H[d][1], H[d][2], H[d][3]})
#define ATT_PK(P, B) cvtpk(P[B], P[(B) + 1])
#define ATT_GAPA(VR, MFX, A0, A1, A2, A3, W0, W1, PW) do { VR; MFX; sacc += A0; sacc += A1; sacc += A2; sacc += A3; ATT_PIN(sacc); W0; W1; ATT_PIN(PW); ATT_SBAR(); } while (0)
#define ATT_VR1(L, H, d, ks) do { \
        asm volatile("ds_read_b64_tr_b16 %0, %1 offset:%c2" : "=&v"(L[d]) : "v"(vaddr), "i"(V_OFF + (d) * 4096 + (ks) * 1024) : "memory"); \
        asm volatile("ds_read_b64_tr_b16 %0, %1 offset:%c2" : "=&v"(H[d]) : "v"(vaddr), "i"(V_OFF + (d) * 4096 + (ks) * 1024 + 512) : "memory"); } while (0)
#define ATT_GAPB(KR, MFX, X, B) do { KR; MFX; X[B] = __builtin_amdgcn_exp2f(X[B]); X[(B) + 1] = __builtin_amdgcn_exp2f(X[(B) + 1]); ATT_PIN(X); ATT_SBAR(); } while (0)
#define ATT_VRW(N, L, H, d) asm volatile("s_waitcnt lgkmcnt(" #N ")" : "+v"(L[d]), "+v"(H[d]) :: "memory")
#define ATT_GAPB2(WT, MFX, VR, KR, DM, X, B) do { WT; MFX; VR; KR; DM; X[B] = __builtin_amdgcn_exp2f(X[B]); X[(B) + 1] = __builtin_amdgcn_exp2f(X[(B) + 1]); ATT_PIN(X); ATT_SBAR(); } while (0)
#define ATT_KR(GL, j) do { if (GL) { kf[2 * (j)] = *(const LAS bf16x8*)(kp0 + sl_next + (j) * 2048); kf[2 * (j) + 1] = *(const LAS bf16x8*)(kp0 + sl_next + (j) * 2048 + 512); } } while (0)
#define ATT_NOP() do { } while (0)
#define ATT_KLOAD(kp_) do { _Pragma("unroll") for (int d0_ = 0; d0_ < 4; ++d0_) { kf[2 * d0_] = *(const LAS bf16x8*)((kp_) + d0_ * 2048); kf[2 * d0_ + 1] = *(const LAS bf16x8*)((kp_) + d0_ * 2048 + 512); } } while (0)
#define ATT_BAND(C0, C1, tt) do { const int dd_ = q0w - 64 * (tt); if (dd_ - 63 < 113) { const LAS float* lb_ = lut + (DMAXI - (dd_ + r32 - 4 * hi)); \
        _Pragma("unroll") for (int r = 0; r < 16; ++r) { C0[r] += lb_[(r & 3) + 8 * (r >> 2)]; C1[r] += lb_[32 + (r & 3) + 8 * (r >> 2)]; } } } while (0)
#define ATT_STEP(C0, C1, P0, P1, tt, ITOP, I0, I1, I2, I3, GL, WN) do { \
        ATT_WAIT_BAR(WN); \
        ITOP; \
        const unsigned vaddr = lds_u + (unsigned)sl_prev + (unsigned)vlane; \
        float sacc = 0.f; \
        ATT_GAPA(ATT_VR1(la, ha, 0, 0), C0 = ATT_MF(kf[0], qr[0], zero16), P0[0], P0[1], P0[2], P0[3],     pw0[0] = ATT_PK(P0, 0),  pw0[1] = ATT_PK(P0, 2),  pw0); \
        ATT_GAPA(ATT_VR1(la, ha, 1, 0), C1 = ATT_MF(kf[1], qr[0], zero16), P0[4], P0[5], P0[6], P0[7],     pw0[2] = ATT_PK(P0, 4),  pw0[3] = ATT_PK(P0, 6),  pw0); \
        ATT_GAPA(ATT_VR1(la, ha, 2, 0), C0 = ATT_MF(kf[2], qr[1], C0),     P0[8], P0[9], P0[10], P0[11],   pw1[0] = ATT_PK(P0, 8),  pw1[1] = ATT_PK(P0, 10), pw1); \
        ATT_GAPA(ATT_VR1(la, ha, 3, 0), C1 = ATT_MF(kf[3], qr[1], C1),     P0[12], P0[13], P0[14], P0[15], pw1[2] = ATT_PK(P0, 12), pw1[3] = ATT_PK(P0, 14), pw1); \
        ATT_GAPA(ATT_NOP(), C0 = ATT_MF(kf[4], qr[2], C0),     P1[0], P1[1], P1[2], P1[3],     pw2[0] = ATT_PK(P1, 0),  pw2[1] = ATT_PK(P1, 2),  pw2); \
        ATT_GAPA(ATT_NOP(), C1 = ATT_MF(kf[5], qr[2], C1),     P1[4], P1[5], P1[6], P1[7],     pw2[2] = ATT_PK(P1, 4),  pw2[3] = ATT_PK(P1, 6),  pw2); \
        ATT_GAPA(ATT_NOP(), C0 = ATT_MF(kf[6], qr[3], C0),     P1[8], P1[9], P1[10], P1[11],   pw3[0] = ATT_PK(P1, 8),  pw3[1] = ATT_PK(P1, 10), pw3); \
        ATT_GAPA(ATT_NOP(), C1 = ATT_MF(kf[7], qr[3], C1),     P1[12], P1[13], P1[14], P1[15], pw3[2] = ATT_PK(P1, 12), pw3[3] = ATT_PK(P1, 14), pw3); \
        lsum += sacc; \
        ATT_BAND(C0, C1, tt); \
        ATT_GAPB2(ATT_VRW(6, la, ha, 0),   o[0] = ATT_MF(__builtin_bit_cast(bf16x8, pw0), ATT_VF(la, ha, 0), o[0]),   ATT_VR1(lb2, hb2, 0, 1), ATT_NOP(),      ATT_NOP(), C0, 0); \
        ATT_GAPB2(ATT_VRW(6, la, ha, 1),   o[1] = ATT_MF(__builtin_bit_cast(bf16x8, pw0), ATT_VF(la, ha, 1), o[1]),   ATT_VR1(lb2, hb2, 1, 1), ATT_NOP(),      ATT_NOP(), C0, 2); \
        ATT_GAPB2(ATT_VRW(6, la, ha, 2),   o[2] = ATT_MF(__builtin_bit_cast(bf16x8, pw0), ATT_VF(la, ha, 2), o[2]),   ATT_VR1(lb2, hb2, 2, 1), ATT_KR(GL, 0),  ATT_NOP(), C0, 4); \
        ATT_GAPB2(ATT_VRW(6, la, ha, 3),   o[3] = ATT_MF(__builtin_bit_cast(bf16x8, pw0), ATT_VF(la, ha, 3), o[3]),   ATT_VR1(lb2, hb2, 3, 1), ATT_KR(GL, 1),  ATT_NOP(), C0, 6); \
        ATT_GAPB2(ATT_VRW(6, lb2, hb2, 0), o[0] = ATT_MF(__builtin_bit_cast(bf16x8, pw1), ATT_VF(lb2, hb2, 0), o[0]), ATT_VR1(la, ha, 0, 2),   ATT_KR(GL, 2),  ATT_NOP(), C0, 8); \
        ATT_GAPB2(ATT_VRW(6, lb2, hb2, 1), o[1] = ATT_MF(__builtin_bit_cast(bf16x8, pw1), ATT_VF(lb2, hb2, 1), o[1]), ATT_VR1(la, ha, 1, 2),   ATT_KR(GL, 3),  ATT_NOP(), C0, 10); \
        ATT_GAPB2(ATT_VRW(6, lb2, hb2, 2), o[2] = ATT_MF(__builtin_bit_cast(bf16x8, pw1), ATT_VF(lb2, hb2, 2), o[2]), ATT_VR1(la, ha, 2, 2),   ATT_NOP(),      ATT_NOP(), C0, 12); \
        ATT_GAPB2(ATT_VRW(6, lb2, hb2, 3), o[3] = ATT_MF(__builtin_bit_cast(bf16x8, pw1), ATT_VF(lb2, hb2, 3), o[3]), ATT_VR1(la, ha, 3, 2),   ATT_NOP(),      ATT_NOP(), C0, 14); \
        ATT_GAPB2(ATT_VRW(6, la, ha, 0),   o[0] = ATT_MF(__builtin_bit_cast(bf16x8, pw2), ATT_VF(la, ha, 0), o[0]),   ATT_VR1(lb2, hb2, 0, 3), ATT_NOP(),      ATT_NOP(), C1, 0); \
        ATT_GAPB2(ATT_VRW(6, la, ha, 1),   o[1] = ATT_MF(__builtin_bit_cast(bf16x8, pw2), ATT_VF(la, ha, 1), o[1]),   ATT_VR1(lb2, hb2, 1, 3), ATT_NOP(),      ATT_NOP(), C1, 2); \
        ATT_GAPB2(ATT_VRW(6, la, ha, 2),   o[2] = ATT_MF(__builtin_bit_cast(bf16x8, pw2), ATT_VF(la, ha, 2), o[2]),   ATT_VR1(lb2, hb2, 2, 3), ATT_NOP(),      ATT_NOP(), C1, 4); \
        ATT_GAPB2(ATT_VRW(6, la, ha, 3),   o[3] = ATT_MF(__builtin_bit_cast(bf16x8, pw2), ATT_VF(la, ha, 3), o[3]),   ATT_VR1(lb2, hb2, 3, 3), ATT_NOP(),      ATT_NOP(), C1, 6); \
        ATT_GAPB2(ATT_VRW(6, lb2, hb2, 0), o[0] = ATT_MF(__builtin_bit_cast(bf16x8, pw3), ATT_VF(lb2, hb2, 0), o[0]), ATT_NOP(),               ATT_NOP(),      I0,        C1, 8); \
        ATT_GAPB2(ATT_VRW(4, lb2, hb2, 1), o[1] = ATT_MF(__builtin_bit_cast(bf16x8, pw3), ATT_VF(lb2, hb2, 1), o[1]), ATT_NOP(),               ATT_NOP(),      I1,        C1, 10); \
        ATT_GAPB2(ATT_VRW(2, lb2, hb2, 2), o[2] = ATT_MF(__builtin_bit_cast(bf16x8, pw3), ATT_VF(lb2, hb2, 2), o[2]), ATT_NOP(),               ATT_NOP(),      I2,        C1, 12); \
        ATT_GAPB2(ATT_VRW(0, lb2, hb2, 3), o[3] = ATT_MF(__builtin_bit_cast(bf16x8, pw3), ATT_VF(lb2, hb2, 3), o[3]), ATT_NOP(),               ATT_NOP(),      I3,        C1, 14); \
        { const int tmp_ = sl_prev; sl_prev = sl_cur; sl_cur = sl_next; sl_next = tmp_; } \
    } while (0)

__device__ __forceinline__ void attn_unit(const Params& P, int b, int h, int qblk, LAS unsigned char* lds) {
    const int tid = opaque_tid(), lane = tid & 63, r32 = lane & 31, hi = lane >> 5;
    const int wid = __builtin_amdgcn_readfirstlane(tid >> 6), c = wid >> 2, wq = wid & 3;
    const int q0 = qblk * 128, q0w = q0 + 32 * wq, NT = 2 * qblk + 2;
    const size_t rowbase = (size_t)b * SEQ;
    bf16x8 qr[4];
    { const bf16_t* Qw = P.Q + (rowbase + q0w + r32) * DM + h * 128 + c * 64 + hi * 8;
#pragma unroll
      for (int d0 = 0; d0 < 4; ++d0) qr[d0] = *(const bf16x8*)(Qw + d0 * 16); }
    const bf16_t* ksrc = P.K + (size_t)(b * NHEAD + h) * 64 * 8192 + wid * 512 + lane * 8;
    const bf16_t* vsrc = P.V + (size_t)(b * NHEAD + h) * 64 * 8192 + (wid >> 2) * 2048 + wq * 512 + lane * 8;
#define ATT_DMA_K0(t, slot) __builtin_amdgcn_global_load_lds((const unsigned*)(ksrc + (size_t)(t) * 8192), (LAS unsigned*)(lds + (slot) + wid * 1024), 16, 0, 0)
#define ATT_DMA_K1(t, slot) __builtin_amdgcn_global_load_lds((const unsigned*)(ksrc + (size_t)(t) * 8192 + 4096), (LAS unsigned*)(lds + (slot) + 8192 + wid * 1024), 16, 0, 0)
#define ATT_DMA_V0(t, slot) __builtin_amdgcn_global_load_lds((const unsigned*)(vsrc + (size_t)(t) * 8192), (LAS unsigned*)(lds + (slot) + V_OFF + (wid >> 2) * 4096 + wq * 1024), 16, 0, 0)
#define ATT_DMA_V1(t, slot) __builtin_amdgcn_global_load_lds((const unsigned*)(vsrc + (size_t)(t) * 8192 + 4096), (LAS unsigned*)(lds + (slot) + V_OFF + (2 + (wid >> 2)) * 4096 + wq * 1024), 16, 0, 0)
#define ATT_DMA_K(t, slot) do { ATT_DMA_K0(t, slot); ATT_DMA_K1(t, slot); } while (0)
#define ATT_DMA_V(t, slot) do { ATT_DMA_V0(t, slot); ATT_DMA_V1(t, slot); } while (0)
    ATT_DMA_K(0, 0);
    ATT_DMA_K(1, SLOT); ATT_DMA_V(0, 0);
    if (NT > 2) ATT_DMA_K(2, 2 * SLOT);
    f32x16 o[4];
#pragma unroll
    for (int d = 0; d < 4; ++d)
#pragma unroll
        for (int r = 0; r < 16; ++r) o[d][r] = 0.f;
    f32x16 zero16;
#pragma unroll
    for (int r = 0; r < 16; ++r) zero16[r] = 0.f;
    float lsum = 0.f;
    const LAS float* lut = (const LAS float*)(lds + LUT_OFF) + h * LUT_N;
    const int vlane = ((lane >> 4) & 1) * 32 + (lane & 3) * 8 + (4 * hi + ((lane & 15) >> 2)) * 64;
    const unsigned lds_u = (unsigned)(uintptr_t)lds;
    const LAS unsigned char* kp0 = lds + c * 8192 + hi * 1024 + r32 * 16;
    int sl_prev = 2 * SLOT, sl_cur = 0, sl_next = SLOT;
    bf16x8 kf[8]; s16x4 la[4], ha[4], lb2[4], hb2[4]; u32x4 pw0, pw1, pw2, pw3;
    f32x16 pA0, pA1, pB0, pB1;
    if (NT > 2) ATT_WAIT_BAR(6); else ATT_WAIT_BAR(4);
    ATT_DMA_V(1, SLOT);
    ATT_KLOAD(kp0);
    pA0 = ATT_MF(kf[0], qr[0], zero16); pA1 = ATT_MF(kf[1], qr[0], zero16);
    pA0 = ATT_MF(kf[2], qr[1], pA0); pA1 = ATT_MF(kf[3], qr[1], pA1);
    pA0 = ATT_MF(kf[4], qr[2], pA0); pA1 = ATT_MF(kf[5], qr[2], pA1);
    pA0 = ATT_MF(kf[6], qr[3], pA0); pA1 = ATT_MF(kf[7], qr[3], pA1);
    ATT_BAND(pA0, pA1, 0);
#pragma unroll
    for (int r = 0; r < 16; ++r) { pA0[r] = __builtin_amdgcn_exp2f(pA0[r]); pA1[r] = __builtin_amdgcn_exp2f(pA1[r]); }
    if (NT > 2) ATT_WAIT_BAR(6); else ATT_WAIT_BAR(4);
    ATT_KLOAD(kp0 + SLOT);
    { const int tmp_ = sl_prev; sl_prev = sl_cur; sl_cur = sl_next; sl_next = tmp_; }
    ATT_STEP(pB0, pB1, pA0, pA1, 1, { if (3 < NT) ATT_DMA_K(3, sl_prev); if (4 < NT) ATT_DMA_K(4, sl_cur); if (2 < NT) ATT_DMA_V(2, sl_next); }, ATT_NOP(), ATT_NOP(), ATT_NOP(), ATT_NOP(), (2 < NT), 2);
    if (NT > 2) {
        int t = 2;
        for (; t + 4 < NT; t += 2) {
            ATT_STEP(pA0, pA1, pB0, pB1, t,     ATT_NOP(), ATT_DMA_K0(t + 3, sl_cur), ATT_DMA_K1(t + 3, sl_cur), ATT_DMA_V0(t + 1, sl_next), ATT_DMA_V1(t + 1, sl_next), true, 4);
            ATT_STEP(pB0, pB1, pA0, pA1, t + 1, ATT_NOP(), ATT_DMA_K0(t + 4, sl_cur), ATT_DMA_K1(t + 4, sl_cur), ATT_DMA_V0(t + 2, sl_next), ATT_DMA_V1(t + 2, sl_next), true, 4);
        }
        if (NT - t == 4) {
            ATT_STEP(pA0, pA1, pB0, pB1, t,     ATT_NOP(), ATT_DMA_K0(t + 3, sl_cur), ATT_DMA_K1(t + 3, sl_cur), ATT_DMA_V0(t + 1, sl_next), ATT_DMA_V1(t + 1, sl_next), true, 4);
            ATT_STEP(pB0, pB1, pA0, pA1, t + 1, ATT_NOP(), ATT_NOP(), ATT_NOP(), ATT_DMA_V0(t + 2, sl_next), ATT_DMA_V1(t + 2, sl_next), true, 4);
            t += 2;
        }
        ATT_STEP(pA0, pA1, pB0, pB1, t,     ATT_NOP(), ATT_NOP(), ATT_NOP(), ATT_DMA_V0(t + 1, sl_next), ATT_DMA_V1(t + 1, sl_next), true, 2);
        ATT_STEP(pB0, pB1, pA0, pA1, t + 1, ATT_NOP(), ATT_NOP(), ATT_NOP(), ATT_NOP(), ATT_NOP(), false, 2);
    }
    { float sacc = 0.f;
#pragma unroll
      for (int r = 0; r < 16; ++r) sacc += pB0[r] + pB1[r];
      lsum += sacc;
#pragma unroll
      for (int q = 0; q < 4; ++q) { pw0[q] = ATT_PK(pB0, 2 * q); pw1[q] = ATT_PK(pB0, 8 + 2 * q); pw2[q] = ATT_PK(pB1, 2 * q); pw3[q] = ATT_PK(pB1, 8 + 2 * q); }
      ATT_WAIT_BAR(0);
      const unsigned vaddr = lds_u + (unsigned)sl_prev + (unsigned)vlane;
      ATT_VRD8(la, ha, 0); ATT_VRD8(lb2, hb2, 1);
      ATT_VWAIT(8, la, ha);
#pragma unroll
      for (int d = 0; d < 4; ++d) o[d] = ATT_MF(__builtin_bit_cast(bf16x8, pw0), ATT_VF(la, ha, d), o[d]);
      ATT_VRD8(la, ha, 2);
      ATT_VWAIT(8, lb2, hb2);
#pragma unroll
      for (int d = 0; d < 4; ++d) o[d] = ATT_MF(__builtin_bit_cast(bf16x8, pw1), ATT_VF(lb2, hb2, d), o[d]);
      ATT_VRD8(lb2, hb2, 3);
      ATT_VWAIT(8, la, ha);
#pragma unroll
      for (int d = 0; d < 4; ++d) o[d] = ATT_MF(__builtin_bit_cast(bf16x8, pw2), ATT_VF(la, ha, d), o[d]);
      ATT_VWAIT(0, lb2, hb2);
#pragma unroll
      for (int d = 0; d < 4; ++d) o[d] = ATT_MF(__builtin_bit_cast(bf16x8, pw3), ATT_VF(lb2, hb2, d), o[d]);
    }
#undef ATT_DMA_K
#undef ATT_DMA_V
#undef ATT_DMA_K0
#undef ATT_DMA_K1
#undef ATT_DMA_V0
#undef ATT_DMA_V1
    LAS float* wsf = (LAS float*)(lds + WSF_OFF) + wid * 64;
    lsum += __shfl_xor(lsum, 32);
    if (hi == 0) wsf[r32] = lsum;
    asm volatile("s_waitcnt lgkmcnt(0)" ::: "memory");
    float rl[16];
#pragma unroll
    for (int r = 0; r < 16; ++r) rl[r] = __builtin_amdgcn_rcpf(wsf[crow(r, hi)]);
    LAS unsigned short* X = (LAS unsigned short*)(lds + X_OFF) + wq * 4096;
    if (c == 1) {
#pragma unroll
        for (int d = 0; d < 4; ++d)
#pragma unroll
            for (int r = 0; r < 16; ++r) X[(d * 16 + r) * 64 + lane] = (unsigned short)(cvtpk(o[d][r] * (rl[r] * P.lam), 0.f) & 0xffffu);
    }
    asm volatile("s_waitcnt lgkmcnt(0)\n\ts_barrier" ::: "memory");
    if (c == 0) {
        float rs[16];
#pragma unroll
        for (int r = 0; r < 16; ++r) {
            float ss = 0.f;
#pragma unroll
            for (int d = 0; d < 4; ++d) { const float v = o[d][r] * rl[r] - bf2f(X[(d * 16 + r) * 64 + lane]); o[d][r] = v; ss += v * v; }
            ss += __shfl_xor(ss, 1); ss += __shfl_xor(ss, 2); ss += __shfl_xor(ss, 4); ss += __shfl_xor(ss, 8); ss += __shfl_xor(ss, 16);
            rs[r] = __builtin_amdgcn_rsqf(ss * (1.f / 128.f) + EPS) * P.one_minus_li;
        }
        asm volatile("s_waitcnt lgkmcnt(0)" ::: "memory");
        LAS unsigned short* stg = X;
#pragma unroll
        for (int d = 0; d < 4; ++d) { const float g = P.subln[32 * d + r32];
#pragma unroll
            for (int r = 0; r < 16; ++r) stg[crow(r, hi) * 128 + 32 * d + r32] = (unsigned short)(cvtpk(o[d][r] * rs[r] * g, 0.f) & 0xffffu); }
        asm volatile("s_waitcnt lgkmcnt(0)" ::: "memory");
        bf16_t* Ow = P.O + (rowbase + q0w) * DM + h * 128;
#pragma unroll
        for (int i = 0; i < 8; ++i) { const int idx = i * 64 + lane, row = idx >> 4, ch = idx & 15;
            const u32x4 v = *(const LAS u32x4*)((const LAS unsigned char*)stg + row * 256 + ch * 16);
            *(u32x4*)(Ow + (size_t)row * DM + ch * 8) = v; }
    }
}

__device__ __forceinline__ void attn_phase(const Params& P, LAS unsigned char* lds) {
    const int G = gridDim.x, bx = blockIdx.x;
    build_lut(lds, P.rel_bias);
    __syncthreads();
    if (G == 256) {
        const int x = bx & 7, j = bx >> 3;
        for (int r = 0; r < 16; ++r) { const int bh = x * 16 + r; attn_unit(P, bh >> 3, bh & 7, (r & 1) ? 31 - j : j, lds); }
    } else {
        for (int i = 0;; ++i) { const int p = bx + G * i; if (p >= 2048) break; const int bh = p >> 4, s2 = p & 15;
            attn_unit(P, bh >> 3, bh & 7, 31 - s2, lds); attn_unit(P, bh >> 3, bh & 7, s2, lds); }
    }
    __syncthreads();
}
}

#define BF_LO(u) __builtin_bit_cast(float, (u) << 16)
#define BF_HI(u) __builtin_bit_cast(float, (u) & 0xffff0000u)
template <int MODE>
__device__ __forceinline__ void row_pass(const float* xin, float* xout, bf16_t* xb, float* rstd, const unsigned char* Y, const int* tok_slot, const float* tok_w, LAS unsigned char* lds) {
    const int tid = opaque_tid(), lane = tid & 63, wid = tid >> 6;
    const int ypos = 256 * (lane >> 5) + 64 * ((lane & 31) >> 3) + 16 * (lane & 3) + 8 * (((lane & 31) >> 2) & 1);
    LAS int* sl = (LAS int*)lds; LAS float* wl = (LAS float*)(lds + 2048);
    for (int blk = blockIdx.x; blk < NTOK / 256; blk += gridDim.x) {
        if (MODE != 0) { sl[tid] = tok_slot[blk * 512 + tid]; wl[tid] = tok_w[blk * 512 + tid]; __syncthreads(); }
        for (int it = 0; it < 8; ++it) {
            const int r0 = it * 32 + wid * 4, m0 = blk * 256 + r0;
            float v[4][2][8];
            if (MODE == 0) {
#pragma unroll
                for (int rr = 0; rr < 4; ++rr) { const f32x4* xr = (const f32x4*)(xin + (size_t)(m0 + rr) * DM + 8 * lane);
#pragma unroll
                    for (int j = 0; j < 2; ++j) { const f32x4 a = xr[128 * j], b = xr[128 * j + 1];
#pragma unroll
                        for (int i = 0; i < 4; ++i) { v[rr][j][i] = a[i]; v[rr][j][4 + i] = b[i]; } } }
            } else {
                u32x4 xq[4][2]; u32x2 ya[4][2], yb[4][2]; float w0[4], w1[4];
#pragma unroll
                for (int rr = 0; rr < 4; ++rr) { const int s0 = sl[2 * (r0 + rr)], s1 = sl[2 * (r0 + rr) + 1]; w0[rr] = wl[2 * (r0 + rr)] * (1.f / Y8_SCALE); w1[rr] = wl[2 * (r0 + rr) + 1] * (1.f / Y8_SCALE);
                    const bf16_t* xr = xb + (size_t)(m0 + rr) * DM + 8 * lane;
                    const unsigned char* y0 = Y + (size_t)s0 * DM + ypos; const unsigned char* y1 = Y + (size_t)s1 * DM + ypos;
#pragma unroll
                    for (int j = 0; j < 2; ++j) { xq[rr][j] = *(const u32x4*)(xr + 512 * j); ya[rr][j] = *(const u32x2*)(y0 + 512 * j); yb[rr][j] = *(const u32x2*)(y1 + 512 * j); } }
#pragma unroll
                for (int rr = 0; rr < 4; ++rr)
#pragma unroll
                    for (int j = 0; j < 2; ++j) { const u32x4 x = xq[rr][j];
#pragma unroll
                        for (int q = 0; q < 2; ++q) { const unsigned xa = q ? x.z : x.x, xc = q ? x.w : x.y; const int yaq = (int)(q ? ya[rr][j].y : ya[rr][j].x), ybq = (int)(q ? yb[rr][j].y : yb[rr][j].x);
                            const f32x2 a0 = __builtin_amdgcn_cvt_pk_f32_fp8(yaq, false), a1 = __builtin_amdgcn_cvt_pk_f32_fp8(yaq, true);
                            const f32x2 b0 = __builtin_amdgcn_cvt_pk_f32_fp8(ybq, false), b1 = __builtin_amdgcn_cvt_pk_f32_fp8(ybq, true);
                            v[rr][j][4 * q + 0] = BF_LO(xa) + w0[rr] * a0.x + w1[rr] * b0.x;
                            v[rr][j][4 * q + 1] = BF_HI(xa) + w0[rr] * a0.y + w1[rr] * b0.y;
                            v[rr][j][4 * q + 2] = BF_LO(xc) + w0[rr] * a1.x + w1[rr] * b1.x;
                            v[rr][j][4 * q + 3] = BF_HI(xc) + w0[rr] * a1.y + w1[rr] * b1.y; } }
            }
            if (MODE == 2) {
#pragma unroll
                for (int rr = 0; rr < 4; ++rr) { f32x4* xo = (f32x4*)(xout + (size_t)(m0 + rr) * DM + 8 * lane);
#pragma unroll
                    for (int j = 0; j < 2; ++j) { xo[128 * j] = (f32x4){v[rr][j][0], v[rr][j][1], v[rr][j][2], v[rr][j][3]}; xo[128 * j + 1] = (f32x4){v[rr][j][4], v[rr][j][5], v[rr][j][6], v[rr][j][7]}; } }
            } else {
#pragma unroll
                for (int rr = 0; rr < 4; ++rr) {
                    float ss = 0.f;
                    bf16_t* o8 = xb + (size_t)(m0 + rr) * DM + 8 * lane;
#pragma unroll
                    for (int j = 0; j < 2; ++j) {
#pragma unroll
                        for (int i = 0; i < 8; i += 2) ss += v[rr][j][i] * v[rr][j][i] + v[rr][j][i + 1] * v[rr][j][i + 1];
                        u32x4 w; w.x = cvtpk(v[rr][j][0], v[rr][j][1]); w.y = cvtpk(v[rr][j][2], v[rr][j][3]); w.z = cvtpk(v[rr][j][4], v[rr][j][5]); w.w = cvtpk(v[rr][j][6], v[rr][j][7]);
                        *(u32x4*)(o8 + 512 * j) = w; }
                    ss = wave_sum(ss);
                    if (lane == 0) rstd[m0 + rr] = __builtin_amdgcn_rsqf(ss * (1.f / DM) + EPS);
                }
            }
        }
        if (MODE != 0) __syncthreads();
    }
}

__device__ __forceinline__ void router_pass(const bf16_t* x, const bf16_t* wt, const float* wg  , const float* bg, const float* be,
                                            float* rstd_out, int* tok_e, float* tok_w, int* cnt, LAS unsigned char* lds) {
    const int tid = opaque_tid(), lane = tid & 63, wid = tid >> 6, r32 = lane & 31, hi = lane >> 5;
    LAS f32x4* wgl = (LAS f32x4*)lds;
    LAS int* cntl = (LAS int*)(lds + 16384);
    for (int i = tid; i < 1024; i += NTHREADS) wgl[i] = *(const f32x4*)(wg + 4 * i);
    for (int blk = blockIdx.x; blk < NTOK / 256; blk += gridDim.x) {
        if (tid < NEXP) cntl[tid] = 0;
        __syncthreads();
        const int tok = blk * 256 + wid * 32 + r32;
        const u32x4* xp = (const u32x4*)(x + (size_t)tok * DM + 8 * hi);
        const u32x4* wph = (const u32x4*)wt + lane; const u32x4* wpl = wph + 64 * 64;
        const LAS f32x4* gp_ = wgl + 8 * hi;
        f32x16 D;
#pragma unroll
        for (int r = 0; r < 16; ++r) D[r] = 0.f;
        float ss = 0.f; f32x4 gl = {0.f, 0.f, 0.f, 0.f};
#pragma unroll 4
        for (int s = 0; s < 64; ++s) {
            const u32x4 xq_ = xp[2 * s], wh = wph[64 * s], wl = wpl[64 * s];
            D = __builtin_amdgcn_mfma_f32_32x32x16_bf16(__builtin_bit_cast(bf16x8, wh), __builtin_bit_cast(bf16x8, xq_), D, 0, 0, 0);
            D = __builtin_amdgcn_mfma_f32_32x32x16_bf16(__builtin_bit_cast(bf16x8, wl), __builtin_bit_cast(bf16x8, xq_), D, 0, 0, 0);
            const float xa[8] = {BF_LO(xq_.x), BF_HI(xq_.x), BF_LO(xq_.y), BF_HI(xq_.y), BF_LO(xq_.z), BF_HI(xq_.z), BF_LO(xq_.w), BF_HI(xq_.w)};
#pragma unroll
            for (int j = 0; j < 8; ++j) { gl += gp_[16 * s + j] * xa[j]; ss += xa[j] * xa[j]; }
        }
        ss += __shfl_xor(ss, 32);
#pragma unroll
        for (int g = 0; g < 4; ++g) gl[g] += __shfl_xor(gl[g], 32);
        const float rs = __builtin_amdgcn_rsqf(ss * (1.f / DM) + EPS);
        float glg[4]; float gmax = -INFINITY; int gidx = 0;
#pragma unroll
        for (int g = 0; g < 4; ++g) { glg[g] = gl[g] * rs + bg[g]; if (glg[g] > gmax) { gmax = glg[g]; gidx = g; } }
        float gsum = 0.f;
#pragma unroll
        for (int g = 0; g < 4; ++g) gsum += __expf(glg[g] - gmax);
        const float gprob = 1.f / gsum;
        float own[4], oth[4], v[8];
#pragma unroll
        for (int i = 0; i < 4; ++i) { const float d = gidx == 0 ? D[i] : gidx == 1 ? D[4 + i] : gidx == 2 ? D[8 + i] : D[12 + i];
            own[i] = d * rs + be[8 * gidx + 4 * hi + i]; oth[i] = __shfl_xor(own[i], 32); }
#pragma unroll
        for (int i = 0; i < 4; ++i) { v[i] = hi ? oth[i] : own[i]; v[4 + i] = hi ? own[i] : oth[i]; }
        int i1 = 0; float v1 = v[0];
#pragma unroll
        for (int i = 1; i < 8; ++i) if (v[i] > v1) { v1 = v[i]; i1 = i; }
        int i2 = -1; float v2 = -INFINITY;
#pragma unroll
        for (int i = 0; i < 8; ++i) if (i != i1 && v[i] > v2) { v2 = v[i]; i2 = i; }
        const float w1 = gprob / (1.f + __expf(v2 - v1)), w2 = gprob - w1;
        if (hi == 0) {
            const int e1 = 8 * gidx + i1, e2 = 8 * gidx + i2;
            tok_e[2 * tok] = e1; tok_e[2 * tok + 1] = e2; tok_w[2 * tok] = w1; tok_w[2 * tok + 1] = w2; rstd_out[tok] = rs;
            atomicAdd((int*)&cntl[e1], 1); atomicAdd((int*)&cntl[e2], 1);
        }
        __syncthreads();
        if (tid < NEXP) cnt[blk * NEXP + tid] = cntl[tid];
        __syncthreads();
    }
}

__device__ __forceinline__ void assign_pass(const int* cnt, const int* tok_e, const float* rstd_ffn, int* tok_slot, int* slot_tok, float* slot_rs, LAS unsigned char* lds) {
    const int tid = opaque_tid(), lane = tid & 63, wid = tid >> 6;
    LAS int* pall = (LAS int*)lds;
    LAS int* plt = pall + 512;
    LAS int* total = plt + 512;
    LAS int* mybase = total + 32;
    LAS int* wcnt = mybase + 32;
    LAS int* ts = (LAS int*)(lds + TS_OFF);
    { const int e = tid & 31, p = tid >> 5; int a = 0;
      for (int b = 16 * p; b < 16 * p + 16; ++b) a += cnt[b * NEXP + e];
      pall[p * 32 + e] = a; }
    __syncthreads();
    if (tid < NEXP) { int a = 0; for (int p = 0; p < 16; ++p) a += pall[p * 32 + tid]; total[tid] = a; }
    __syncthreads();
    if (tid == 0) { int acc = 0; for (int e = 0; e < NEXP; ++e) { ts[e] = acc; acc += (total[e] + 255) >> 8; } ts[NEXP] = acc; }
    __syncthreads();
    for (int blk = blockIdx.x; blk < NTOK / 256; blk += gridDim.x) {
        { const int e = tid & 31, p = tid >> 5; int l = 0;
          for (int b = 16 * p; b < 16 * p + 16; ++b) { const int c = cnt[b * NEXP + e]; if (b < blk) l += c; }
          plt[p * 32 + e] = l; }
        int e0 = -1, e1 = -1, r0 = 0, r1 = 0; float rs = 0.f;
        if (tid < 256) { const int tok = blk * 256 + tid; e0 = tok_e[2 * tok]; e1 = tok_e[2 * tok + 1]; rs = rstd_ffn[tok]; }
        if (wid < 4) {
            const unsigned long long lt = (1ull << lane) - 1ull;
#pragma unroll 4
            for (int e = 0; e < NEXP; ++e) {
                const unsigned long long m = __ballot(e0 == e || e1 == e);
                const int r = __popcll(m & lt);
                if (e0 == e) r0 = r;
                if (e1 == e) r1 = r;
                if (lane == 0) wcnt[e * 4 + wid] = __popcll(m);
            }
        }
        __syncthreads();
        if (tid < NEXP) { int l = 0; for (int p = 0; p < 16; ++p) l += plt[p * 32 + tid]; mybase[tid] = l; }
        __syncthreads();
        if (tid < 256) {
            const int tok = blk * 256 + tid;
            int p0 = ts[e0] * 256 + mybase[e0] + r0, p1 = ts[e1] * 256 + mybase[e1] + r1;
            for (int w = 0; w < wid; ++w) { p0 += wcnt[e0 * 4 + w]; p1 += wcnt[e1 * 4 + w]; }
            tok_slot[2 * tok] = p0; tok_slot[2 * tok + 1] = p1;
            slot_tok[p0] = tok; slot_tok[p1] = tok; slot_rs[p0] = rs; slot_rs[p1] = rs;
        }
        if (blk == 0) {
            for (int e = 0; e < NEXP; ++e) for (int p = ts[e] * 256 + total[e] + tid; p < ts[e + 1] * 256; p += NTHREADS) { slot_tok[p] = 0; slot_rs[p] = 0.f; }
        }
        __syncthreads();
    }
}

__device__ __forceinline__ void pool_pass(const bf16_t* U, unsigned char* Pq) {
    const int tid = opaque_tid(), lane = tid & 63, wid = tid >> 6;
    for (int task = blockIdx.x * NWAVES + wid; task < (NTOK / 64) * 2; task += gridDim.x * NWAVES) {
        const int rb = task >> 1, half = task & 1, T0 = rb * 64, col = half * 512 + lane * 8, w = 2 << (half * 2 + (lane >> 5)), tp0 = T0 & (SEQ - 1);
        float S[8];
#pragma unroll
        for (int k = 0; k < 8; ++k) S[k] = 0.f;
#define PL_LD(dst, row) do { const u32x4 q_ = *(const u32x4*)(U + (size_t)(row) * DM + col); \
        dst[0] = __builtin_bit_cast(float, q_.x << 16); dst[1] = __builtin_bit_cast(float, q_.x & 0xffff0000u); dst[2] = __builtin_bit_cast(float, q_.y << 16); dst[3] = __builtin_bit_cast(float, q_.y & 0xffff0000u); \
        dst[4] = __builtin_bit_cast(float, q_.z << 16); dst[5] = __builtin_bit_cast(float, q_.z & 0xffff0000u); dst[6] = __builtin_bit_cast(float, q_.w << 16); dst[7] = __builtin_bit_cast(float, q_.w & 0xffff0000u); } while (0)
        for (int jj = 1; jj < 16; ++jj) if (jj < w && tp0 - jj >= 0) { float a[8]; PL_LD(a, T0 - jj);
#pragma unroll
            for (int k = 0; k < 8; ++k) S[k] += a[k]; }
#define PL_UNP(dst, q_) do { dst[0] = __builtin_bit_cast(float, q_.x << 16); dst[1] = __builtin_bit_cast(float, q_.x & 0xffff0000u); dst[2] = __builtin_bit_cast(float, q_.y << 16); dst[3] = __builtin_bit_cast(float, q_.y & 0xffff0000u); \
        dst[4] = __builtin_bit_cast(float, q_.z << 16); dst[5] = __builtin_bit_cast(float, q_.z & 0xffff0000u); dst[6] = __builtin_bit_cast(float, q_.w << 16); dst[7] = __builtin_bit_cast(float, q_.w & 0xffff0000u); } while (0)
        for (int i0 = 0; i0 < 64; i0 += 8) {
            u32x4 cq[8], aq[8];
#pragma unroll
            for (int i = 0; i < 8; ++i) { const int t = T0 + i0 + i, tp = tp0 + i0 + i;
                cq[i] = *(const u32x4*)(U + (size_t)t * DM + col);
                aq[i] = (tp - (w - 1) >= 0) ? *(const u32x4*)(U + (size_t)(t - (w - 1)) * DM + col) : (u32x4){0u, 0u, 0u, 0u}; }
#pragma unroll
            for (int i = 0; i < 8; ++i) { const int t = T0 + i0 + i, tp = tp0 + i0 + i; float c[8], a[8]; PL_UNP(c, cq[i]); PL_UNP(a, aq[i]);
                const int n = tp + 1 < w ? tp + 1 : w; const float inv = 1.f / (float)n;
                float o[8];
#pragma unroll
                for (int k = 0; k < 8; ++k) { S[k] += c[k]; o[k] = S[k] * inv - c[k]; S[k] -= a[k]; }
                int lo = cvt8(o[0] * A8_SCALE, o[1] * A8_SCALE, 0, false); lo = cvt8(o[2] * A8_SCALE, o[3] * A8_SCALE, lo, true);
                int hi = cvt8(o[4] * A8_SCALE, o[5] * A8_SCALE, 0, false); hi = cvt8(o[6] * A8_SCALE, o[7] * A8_SCALE, hi, true);
                *(u32x2*)(Pq + (size_t)t * DM + col) = (u32x2){(unsigned)lo, (unsigned)hi}; }
        }
#undef PL_UNP
#undef PL_LD
    }
}

constexpr int ARG_OFF = attn::WSF_OFF + NWAVES * 256;
static_assert(ARG_OFF + 27 * 8 <= LDS_BYTES, "LDS map (args)");
__device__ __forceinline__ const void* arg_ptr(LAS unsigned char* lds, int i) {
    const unsigned long long v = ((const LAS unsigned long long*)(lds + ARG_OFF))[i];
    const unsigned lo = __builtin_amdgcn_readfirstlane((unsigned)v), hi = __builtin_amdgcn_readfirstlane((unsigned)(v >> 32));
    return (const void*)(const __attribute__((address_space(1))) char*)(((unsigned long long)hi << 32) | lo);
}
#define INP(i) ((const float*)arg_ptr(lds, (i)))
#define OUTP() ((float*)arg_ptr(lds, 25))
#define WSP() ((unsigned char*)arg_ptr(lds, 26))


__device__ __forceinline__ size_t wt_image_off(int n, int k, int Kd) {
    const int pn = n >> 8, nr = n & 255, wc = nr >> 6, bj = (nr >> 5) & 1, x = nr & 31, rho = 16 * ((x >> 2) & 1) + 4 * (x >> 3) + (x & 3);
    const int kt = k >> 6, kk = k & 63;
    return ((size_t)((pn * (Kd >> 6) + kt) * 2 + bj) * 16384 + pg8::lds_byte(wc * 32 + rho, kk)) >> 1;
}
__device__ __forceinline__ size_t wt_image_off8(int n, int k, int Kd) {
    const int pn = n >> 8, nr = n & 255, wc = nr >> 6, bj = (nr >> 5) & 1, x = nr & 31, rho = 16 * ((x >> 2) & 1) + 4 * (x >> 3) + (x & 3);
    const int kt = k >> 7, kb = k & 127;
    return (size_t)((pn * (Kd >> 7) + kt) * 2 + bj) * 16384 + pg8::lds_byte(wc * 32 + rho, kb >> 1);
}
struct TrDesc { const float* W; const float* gain; bf16_t* WT; int N, k0, n0, Kd, drow0; int f8; float f8s; };
__device__ __forceinline__ void tr_load(const TrDesc& d, f32x4 (&v)[8], float (&g)[8], int lane) {
    const int kr = lane >> 3, n4 = (lane & 7) * 4;
#pragma unroll
    for (int i = 0; i < 8; ++i) { v[i] = *(const f32x4*)(d.W + (size_t)(d.k0 + 8 * i + kr) * d.N + d.n0 + n4); g[i] = d.gain ? d.gain[d.k0 + 8 * i + kr] : 1.f; }
}
__device__ __forceinline__ void tr_finish(const TrDesc& d, const f32x4 (&v)[8], const float (&g)[8], LAS float* scr, int lane) {
    const int kr = lane >> 3, n4 = (lane & 7) * 4;
#pragma unroll
    for (int i = 0; i < 8; ++i) { LAS float* q = scr + (8 * i + kr) * 33 + n4; q[0] = v[i][0] * g[i]; q[1] = v[i][1] * g[i]; q[2] = v[i][2] * g[i]; q[3] = v[i][3] * g[i]; }
    asm volatile("s_waitcnt lgkmcnt(0)" ::: "memory");
    if (d.f8) {
#pragma unroll
        for (int j = 0; j < 2; ++j) { const int pc = lane * 2 + j, n = pc >> 2, kg = pc & 3; const float fs = d.f8s;
            u32x4 o;
#pragma unroll
            for (int q = 0; q < 4; ++q) { const int kb = d.f8 == 2 ? (q >> 1) * 32 + 8 * kg + 4 * (q & 1) : 16 * kg + 4 * q; const LAS float* t = scr + kb * 33 + n;
                int r = cvt8(t[0] * fs, t[33] * fs, 0, false);
                r = cvt8(t[66] * fs, t[99] * fs, r, true); o[q] = (unsigned)r; }
            *(u32x4*)((unsigned char*)d.WT + wt_image_off8(d.drow0 + n, d.k0 + 16 * kg, d.Kd)) = o; }
        asm volatile("s_waitcnt lgkmcnt(0)" ::: "memory");
        return;
    }
    const int c = lane & 7;
#pragma unroll
    for (int j = 0; j < 4; ++j) { const int n = (lane >> 3) + 8 * j; const LAS float* t = scr + (8 * c) * 33 + n;
        u32x4 o; o.x = cvtpk(t[0 * 33], t[1 * 33]); o.y = cvtpk(t[2 * 33], t[3 * 33]); o.z = cvtpk(t[4 * 33], t[5 * 33]); o.w = cvtpk(t[6 * 33], t[7 * 33]);
        *(u32x4*)(d.WT + wt_image_off(d.drow0 + n, d.k0 + 8 * c, d.Kd)) = o; }
    asm volatile("s_waitcnt lgkmcnt(0)" ::: "memory");
}
struct Args { const float* in[25]; float* out; unsigned char* ws; };
enum { I_X = 0, I_RELB, I_ANORM, I_WQKV, I_QG, I_KG, I_LQ1, I_LK1, I_LQ2, I_LK2, I_SUBLN, I_WO, I_PNORM, I_PWIN, I_PWG, I_PWOUT, I_PSCALE, I_FNORM, I_RGW, I_RGB, I_REW, I_REB, I_WGATE, I_WUP, I_WDOWN };

__device__ __forceinline__ TrDesc tr_decode(LAS unsigned char* lds, unsigned char* ws, int it) {
    constexpr int N_QKV = 2 * 16 * 96;
    TrDesc d; d.f8 = 0; d.f8s = 1.f;
    if (it < N_QKV) { const int l = it / 1536, r = it - l * 1536, kb = r / 96, nb = r - kb * 96;
        d.W = INP(I_WQKV) + (size_t)l * 1024 * 3072; d.N = 3072; d.k0 = 64 * kb; d.n0 = 32 * nb; d.WT = (bf16_t*)(ws + WS_WQKV) + (size_t)l * 3072 * 1024; d.Kd = 1024; d.drow0 = 32 * nb; d.gain = INP(I_ANORM) + l * 1024; return d; }
    it -= N_QKV;
    { const int l = it >> 9, r = it & 511, kb = r >> 5, nb = r & 31;
      d.W = INP(I_WO) + (size_t)l * 1024 * 1024; d.N = 1024; d.k0 = 64 * kb; d.n0 = 32 * nb; d.WT = (bf16_t*)(ws + WS_WO) + (size_t)l * 1024 * 1024; d.Kd = 1024; d.drow0 = 32 * nb; d.gain = nullptr; }
    return d;
}
__device__ __forceinline__ void w8_items(LAS unsigned char* lds, unsigned char* ws, int lane, int wid) {
    constexpr int S_GU = 128 * 2 * 8 * 2, S_DN = 128 * 4 * 4, S_PO = 2 * 8 * 4;
    for (int S0 = blockIdx.x; S0 < S_GU + S_DN + S_PO; S0 += gridDim.x) {
        const int S = __builtin_amdgcn_readfirstlane(S0);
        const float* W; const float* gain; unsigned char* WT; int N, k0, n, Kd, drow; bool perm; float fs;
        if (S < S_GU) { const int le = S >> 5, r = S & 31, isup = r >> 4, kt = (r >> 1) & 7, nh = r & 1;
            W = (isup ? INP(I_WUP) : INP(I_WGATE)) + (size_t)le * 1024 * 512; N = 512; k0 = 128 * kt; n = 256 * nh + 4 * lane; WT = ws + WS_WGU + (size_t)le * 1024 * 1024; Kd = 1024;
            drow = 256 * (n >> 7) + 64 * ((n >> 5) & 3) + 32 * isup + (n & 31); gain = INP(I_FNORM) + (le >> 5) * 1024; perm = true; fs = WG8_SCALE; }
        else if (S < S_GU + S_DN) { const int i2 = S - S_GU, le = i2 >> 4, r = i2 & 15, kt = r >> 2, nq = r & 3;
            W = INP(I_WDOWN) + (size_t)le * 512 * 1024; N = 1024; k0 = 128 * kt; n = 256 * nq + 4 * lane; WT = ws + WS_WDN + (size_t)le * 1024 * 512; Kd = 512; drow = n; gain = nullptr; perm = false; fs = WD8_SCALE; }
        else { const int i3 = S - S_GU - S_DN, l = i3 >> 5, r = i3 & 31, kt = r >> 2, nq = r & 3;
            W = INP(I_PWOUT) + (size_t)l * 1024 * 1024; N = 1024; k0 = 128 * kt; n = 256 * nq + 4 * lane; WT = ws + WS_WPO + (size_t)l * 1024 * 1024; Kd = 1024; drow = n; gain = nullptr; perm = false; fs = WN8_SCALE; }
        const int r0 = perm ? 64 * (wid >> 2) + 8 * (wid & 3) : 16 * wid, r1 = perm ? r0 + 32 : r0 + 8;
        const float* gp = gain ? gain : W;
        f32x4 v[16]; float g[16];
#pragma unroll
        for (int j = 0; j < 8; ++j) { v[j] = *(const f32x4*)(W + (size_t)(k0 + r0 + j) * N + n); v[8 + j] = *(const f32x4*)(W + (size_t)(k0 + r1 + j) * N + n);
            g[j] = gp[k0 + r0 + j]; g[8 + j] = gp[k0 + r1 + j]; }
#pragma unroll
        for (int j = 0; j < 16; ++j) g[j] = gain ? g[j] * fs : fs;
#pragma unroll
        for (int c = 0; c < 4; ++c) {
            u32x4 o;
#pragma unroll
            for (int q = 0; q < 4; ++q) { int r = cvt8(v[4 * q][c] * g[4 * q], v[4 * q + 1][c] * g[4 * q + 1], 0, false); r = cvt8(v[4 * q + 2][c] * g[4 * q + 2], v[4 * q + 3][c] * g[4 * q + 3], r, true); o[q] = (unsigned)r; }
            *(u32x4*)(WT + wt_image_off8(drow + c, k0 + 16 * wid, Kd)) = o;
        }
    }
}
__device__ __forceinline__ void prologue(LAS unsigned char* lds) {
    const int tid = opaque_tid(), lane = tid & 63, wid = tid >> 6;
    LAS float* scr = (LAS float*)(lds + wid * 16384);
    const int gw = blockIdx.x * NWAVES + wid, NGW = gridDim.x * NWAVES;
    unsigned char* ws = WSP();
    constexpr int N_QKV = 2 * 16 * 96, N_WO = 2 * 16 * 32, N_PC = 2 * 64 * 16;
    constexpr int NTR = N_QKV + N_WO;
    w8_items(lds, ws, lane, __builtin_amdgcn_readfirstlane(wid));
    if (gw < NTR) {
        TrDesc dA = tr_decode(lds, ws, gw), dB; f32x4 va[8], vb[8]; float ga[8], gb[8];
        tr_load(dA, va, ga, lane);
        for (int itA = gw;;) {
            const int itB = itA + NGW; const bool hasB = itB < NTR;
            if (hasB) { dB = tr_decode(lds, ws, itB); tr_load(dB, vb, gb, lane); }
            tr_finish(dA, va, ga, scr, lane);
            if (!hasB) break;
            itA = itB + NGW; const bool hasA = itA < NTR;
            if (hasA) { dA = tr_decode(lds, ws, itA); tr_load(dA, va, ga, lane); }
            tr_finish(dB, vb, gb, scr, lane);
            if (!hasA) break;
        }
    }
    for (int it = gw; it < N_PC; it += NGW) {
        {
            const int l = it >> 10, r = it & 1023, k0 = (r >> 4) * 16, n0 = (r & 15) * 64, g = n0 >> 8, e = (n0 & 255) + lane;
            const float* win = INP(I_PWIN) + (size_t)l * 1024 * 1024 + (size_t)k0 * 1024 + g * 256;
            const float* wgp = INP(I_PWG) + (size_t)l * 4 * 256 * 256 + (size_t)g * 256 * 256 + e;
            float acc[16];
#pragma unroll
            for (int kk = 0; kk < 16; ++kk) acc[kk] = 0.f;
            {
                f32x4 wv[16];
#pragma unroll
                for (int kk = 0; kk < 16; ++kk) wv[kk] = *(const f32x4*)(win + (size_t)kk * 1024 + 4 * lane);
#pragma unroll
                for (int kk = 0; kk < 16; ++kk) *(LAS f32x4*)(scr + kk * 256 + 4 * lane) = wv[kk];
                asm volatile("s_waitcnt lgkmcnt(0)" ::: "memory"); }
#pragma unroll 8
            for (int c4 = 0; c4 < 64; ++c4) {
                float b[4];
#pragma unroll
                for (int cc = 0; cc < 4; ++cc) b[cc] = wgp[(size_t)(4 * c4 + cc) * 256];
#pragma unroll
                for (int kk = 0; kk < 16; ++kk) { const f32x4 av = *(const LAS f32x4*)(scr + kk * 256 + 4 * c4); acc[kk] += (av[0] * b[0] + av[1] * b[1]) + (av[2] * b[2] + av[3] * b[3]); }
            }
            const float* pn = INP(I_PNORM) + l * 1024 + k0;
#pragma unroll
            for (int h8 = 0; h8 < 2; ++h8) {
                u32x4 o; o.x = cvtpk(acc[8 * h8 + 0] * pn[8 * h8 + 0], acc[8 * h8 + 1] * pn[8 * h8 + 1]); o.y = cvtpk(acc[8 * h8 + 2] * pn[8 * h8 + 2], acc[8 * h8 + 3] * pn[8 * h8 + 3]);
                o.z = cvtpk(acc[8 * h8 + 4] * pn[8 * h8 + 4], acc[8 * h8 + 5] * pn[8 * h8 + 5]); o.w = cvtpk(acc[8 * h8 + 6] * pn[8 * h8 + 6], acc[8 * h8 + 7] * pn[8 * h8 + 7]);
                *(u32x4*)((bf16_t*)(ws + WS_WPC) + (size_t)l * 1024 * 1024 + wt_image_off(n0 + lane, k0 + 8 * h8, 1024)) = o; }
            asm volatile("s_waitcnt lgkmcnt(0)" ::: "memory");
        }
    }
    float* rwt = (float*)(ws + WS_RWT); float* rwg = (float*)(ws + WS_RWG);
    { bf16_t* rwb = (bf16_t*)rwt;
      for (int i = blockIdx.x * NTHREADS + tid; i < DEPTH * NEXP * DM; i += gridDim.x * NTHREADS) { const int l = i >> 15, r = i & 32767, sx = r >> 9, ln = (r >> 3) & 63, jj = r & 7, k = 16 * sx + 8 * (ln >> 5) + jj, e = ln & 31;
        const float v = INP(I_FNORM)[l * 1024 + k] * INP(I_REW)[(size_t)l * 1024 * 32 + k * 32 + e];
        const unsigned hb = cvtpk(v, 0.f) & 0xffffu; const float vh = __builtin_bit_cast(float, hb << 16);
        rwb[(size_t)l * 65536 + r] = (bf16_t)hb; rwb[(size_t)l * 65536 + 32768 + r] = (bf16_t)(cvtpk(v - vh, 0.f) & 0xffffu); } }
    for (int i = blockIdx.x * NTHREADS + tid; i < DEPTH * DM * NGRP; i += gridDim.x * NTHREADS) { const int l = i >> 12, k = (i >> 2) & 1023;
        rwg[i] = INP(I_FNORM)[l * 1024 + k] * INP(I_RGW)[i]; }
}

__device__ __forceinline__ void moe_layer(LAS unsigned char* lds, const XcdBarrier& bar, const int L, const bool fin) {
    const LAS int* ts = (const LAS int*)(lds + TS_OFF);
    {   unsigned char* ws = WSP();
        router_pass((const bf16_t*)(ws + WS_XB), (const bf16_t*)(ws + WS_RWT) + (size_t)L * 65536, (const float*)(ws + WS_RWG) + (size_t)L * DM * NGRP, INP(I_RGB) + L * NGRP, INP(I_REB) + L * NEXP,
                    (float*)(ws + WS_RSFFN), (int*)(ws + WS_TOKE), (float*)(ws + WS_TOKW), (int*)(ws + WS_CNT), lds); }
    xcd_barrier(bar);
    {   unsigned char* ws = WSP();
        assign_pass((const int*)(ws + WS_CNT), (const int*)(ws + WS_TOKE), (const float*)(ws + WS_RSFFN), (int*)(ws + WS_TOKS), (int*)(ws + WS_SLOTTOK), (float*)(ws + WS_SLOTRS), lds); }
    xcd_barrier(bar);
    {   unsigned char* ws = WSP();
        GroupSched S; S.init_grid(); S.A = (const char*)(ws + WS_ACT + ACT_X8); S.lda = DM; S.slot_tok = (const int*)(ws + WS_SLOTTOK); S.Bt = (const char*)(ws + WS_WGU) + (size_t)L * NEXP * 1024 * 1024; S.strideE = (size_t)1024 * 1024; S.K = DM / 2; S.ts = ts;
        EpiGateUp E{ws + WS_ACT + ACT_H, (const float*)(ws + WS_SLOTRS)};
        int kx = DM; asm volatile("" : "+s"(kx));
        pg8::gemm_phase<EpiGateUp, GroupSched, true, true>(lds, kx, S, E); }
    xcd_barrier(bar);
    {   unsigned char* ws = WSP();
        GroupSched S; S.init_grid(); S.A = (const char*)(ws + WS_ACT + ACT_H); S.lda = EFF; S.slot_tok = nullptr; S.Bt = (const char*)(ws + WS_WDN) + (size_t)L * NEXP * 1024 * 512; S.strideE = (size_t)1024 * 512; S.K = EFF / 2; S.ts = ts;
        EpiY8 E{ws + WS_ACT + ACT_Y};
        int kx = EFF; asm volatile("" : "+s"(kx));
        pg8::gemm_phase<EpiY8, GroupSched, true, true>(lds, kx, S, E); }
    xcd_barrier(bar);
    {   unsigned char* ws = WSP(); float* xo = OUTP();
        if (fin) row_pass<2>(nullptr, xo, (bf16_t*)(ws + WS_XB), nullptr, (const unsigned char*)(ws + WS_ACT + ACT_Y), (const int*)(ws + WS_TOKS), (const float*)(ws + WS_TOKW), lds);
        else { row_pass<1>(nullptr, nullptr, (bf16_t*)(ws + WS_XB), (float*)(ws + WS_RSMIX), (const unsigned char*)(ws + WS_ACT + ACT_Y), (const int*)(ws + WS_TOKS), (const float*)(ws + WS_TOKW), lds); } }
    if (!fin) xcd_barrier(bar);
}

__global__ void __launch_bounds__(NTHREADS, 2) hybrid_fwd(Args a) {
    extern __shared__ __attribute__((aligned(16))) unsigned char lds_raw[];
    LAS unsigned char* lds = (LAS unsigned char*)lds_raw;
    volatile LAS unsigned* MISC = (volatile LAS unsigned*)(lds + MISC_OFF);
    const int tid = threadIdx.x;
    if (tid < 64) MISC[tid] = 0u;
    if (tid < 27) ((LAS unsigned long long*)(lds + ARG_OFF))[tid] = ((const __attribute__((address_space(4))) unsigned long long*)__builtin_amdgcn_kernarg_segment_ptr())[tid];
    __syncthreads();
    XcdBarrier bar = xcd_barrier_post((unsigned*)(a.ws + WS_CTL) + CW_BAR, MISC + 8);

    prologue(lds);
    {   unsigned char* ws = WSP();
        row_pass<0>(INP(I_X), nullptr, (bf16_t*)(ws + WS_XB), (float*)(ws + WS_RSMIX), nullptr, nullptr, nullptr, lds); }
    xcd_barrier(bar);

    for (int lp = 0; lp < 2; ++lp) {
        {   unsigned char* ws = WSP();
            PlainSched S; S.init_grid(); S.A = (const char*)(ws + WS_XB); S.lda = DM * 2; S.Bt = (const char*)(ws + WS_WQKV) + (size_t)lp * 3072 * 1024 * 2; S.K = DM; S.nN = 12; S.nrt = NTOK / 256;
            LAS float* gl = (LAS float*)(lds + attn::WSF_OFF);
            { const int t_ = opaque_tid(); if (t_ < 128) gl[t_] = t_ < 64 ? INP(I_QG)[lp * HD + t_] : INP(I_KG)[lp * HD + t_ - 64]; }
            __syncthreads();
            EpiQKV E{(bf16_t*)(ws + WS_ACT + ACT_Q), (const float*)(ws + WS_RSMIX), gl};
            pg8::gemm_phase<EpiQKV, PlainSched, true>(lds, DM, S, E); }
        xcd_barrier(bar);
        {   unsigned char* ws = WSP();
            const float* lq1 = INP(I_LQ1) + lp * HD; const float* lk1 = INP(I_LK1) + lp * HD; const float* lq2 = INP(I_LQ2) + lp * HD; const float* lk2 = INP(I_LK2) + lp * HD;
            float d1 = 0.f, d2 = 0.f;
            for (int i = 0; i < HD; ++i) { d1 += lq1[i] * lk1[i]; d2 += lq2[i] * lk2[i]; }
            const float li = 0.8f - 0.6f * expf(-0.3f * (float)(2 * lp));
            bf16_t* Qb = (bf16_t*)(ws + WS_ACT + ACT_Q);
            attn::Params P{Qb, Qb + (size_t)NTOK * DM, Qb + (size_t)2 * NTOK * DM, Qb, INP(I_RELB), INP(I_SUBLN) + lp * 128, expf(d1) - expf(d2) + li, 1.f - li};
            attn::attn_phase(P, lds); }
        xcd_barrier(bar);
        {   unsigned char* ws = WSP(); float* xo = OUTP();
            PlainSched S; S.init_grid(); S.A = (const char*)(ws + WS_ACT + ACT_Q); S.lda = DM * 2; S.Bt = (const char*)(ws + WS_WO) + (size_t)lp * 1024 * 1024 * 2; S.K = DM; S.nN = 4; S.nrt = NTOK / 256;
            EpiRes E{(bf16_t*)(ws + WS_XB), nullptr, ws + WS_ACT + ACT_X8, 1.f};
            pg8::gemm_phase<EpiRes, PlainSched, true>(lds, DM, S, E); }
        xcd_barrier(bar);
        moe_layer(lds, bar, 2 * lp, false);
        {   unsigned char* ws = WSP();
            PlainSched S; S.init_grid(); S.A = (const char*)(ws + WS_XB); S.lda = DM * 2; S.Bt = (const char*)(ws + WS_WPC) + (size_t)lp * 1024 * 1024 * 2; S.K = DM; S.nN = 4; S.nrt = NTOK / 256;
            EpiBf16 E{(bf16_t*)(ws + WS_ACT + ACT_U), DM, (const float*)(ws + WS_RSMIX)};
            pg8::gemm_phase<EpiBf16, PlainSched, true>(lds, DM, S, E); }
        xcd_barrier(bar);
        {   unsigned char* ws = WSP(); pool_pass((const bf16_t*)(ws + WS_ACT + ACT_U), ws + WS_ACT + ACT_P); }
        xcd_barrier(bar);
        {   unsigned char* ws = WSP(); float* xo = OUTP();
            PlainSched S; S.init_grid(); S.A = (const char*)(ws + WS_ACT + ACT_P); S.lda = DM; S.Bt = (const char*)(ws + WS_WPO) + (size_t)lp * 1024 * 1024; S.K = DM / 2; S.nN = 4; S.nrt = NTOK / 256;
            EpiRes E{(bf16_t*)(ws + WS_XB), INP(I_PSCALE) + lp * DM, ws + WS_ACT + ACT_X8, 1.f / (A8_SCALE * WN8_SCALE)};
            int kx = DM; asm volatile("" : "+s"(kx));
            pg8::gemm_phase<EpiRes, PlainSched, true, true>(lds, kx, S, E); }
        xcd_barrier(bar);
        moe_layer(lds, bar, 2 * lp + 1, lp == 1);
    }
}

extern "C" void kernel_launch(void* const* d_in, const int* in_sizes, int n_in, void* d_out, int out_size, void* d_ws, size_t ws_size, hipStream_t stream) {
    static int grid = 0;
    if (grid == 0) {
        if (n_in != 25 || out_size != NTOK * DM || ws_size < WS_END) { fprintf(stderr, "kernel_launch: unexpected problem (n_in %d, out %d, ws %zu)\n", n_in, out_size, ws_size); grid = -1; return; }
        int dev = 0, cus = 0;
        if (hipGetDevice(&dev) != hipSuccess || hipDeviceGetAttribute(&cus, hipDeviceAttributeMultiprocessorCount, dev) != hipSuccess) { grid = -1; return; }
        if (hipFuncSetAttribute((const void*)hybrid_fwd, hipFuncAttributeMaxDynamicSharedMemorySize, LDS_BYTES) != hipSuccess) { fprintf(stderr, "kernel_launch: hipFuncSetAttribute failed\n"); grid = -1; return; }
        int per_cu = 0;
        if (hipOccupancyMaxActiveBlocksPerMultiprocessor(&per_cu, (const void*)hybrid_fwd, NTHREADS, LDS_BYTES) != hipSuccess || per_cu < 1) fprintf(stderr, "kernel_launch: occupancy query says %d\n", per_cu);
        (void)hipGetLastError();
        grid = cus > 256 ? 256 : cus;
    }
    if (grid < 0) return;
    (void)hipMemsetAsync((char*)d_ws + WS_CTL, 0, CTL_ZERO_BYTES, stream);
    Args a{};
    for (int i = 0; i < 25; ++i) a.in[i] = (const float*)d_in[i];
    a.out = (float*)d_out; a.ws = (unsigned char*)d_ws;
    hipLaunchKernelGGL(hybrid_fwd, dim3(grid), dim3(NTHREADS), LDS_BYTES, stream, a);
}
```

```cpp
#include <hip/hip_runtime.h>
#include <cstdio>
#include <cstdint>

#define GAS __attribute__((address_space(1)))
#define LAS __attribute__((address_space(3)))
typedef unsigned short bf16_t;
typedef short bf16x8 __attribute__((ext_vector_type(8)));
typedef short s16x4 __attribute__((ext_vector_type(4)));
typedef float f32x2 __attribute__((ext_vector_type(2)));
typedef float f32x4 __attribute__((ext_vector_type(4)));
typedef float f32x16 __attribute__((ext_vector_type(16)));
typedef unsigned u32x2 __attribute__((ext_vector_type(2)));
typedef unsigned u32x4 __attribute__((ext_vector_type(4)));
typedef int i32x8 __attribute__((ext_vector_type(8)));
typedef __bf16 bf16x2_t __attribute__((ext_vector_type(2)));

constexpr int NB = 16, SEQ = 4096, DM = 1024, NTOK = NB * SEQ, DEPTH = 4;
constexpr int NHEAD = 8, HD = 64;
constexpr int NEXP = 32, EPG = 8, NGRP = 4, EFF = 512;
constexpr int MAXSLOT = 139264;
constexpr float EPS = 1e-6f;
constexpr float LOG2E = 1.4426950408889634f;
constexpr int NWAVES = 8, NTHREADS = 512;

constexpr size_t MiB = 1u << 20;
constexpr size_t WS_CTL = 0, CTL_ZERO_BYTES = 1 * MiB;
constexpr size_t WS_RSMIX = 4 * MiB;
constexpr size_t WS_RSFFN = WS_RSMIX + 256 * 1024;
constexpr size_t WS_TOKE = WS_RSFFN + 256 * 1024;
constexpr size_t WS_TOKW = WS_TOKE + 512 * 1024;
constexpr size_t WS_TOKS = WS_TOKW + 512 * 1024;
constexpr size_t WS_SLOTTOK = WS_TOKS + 512 * 1024;
constexpr size_t WS_SLOTRS = WS_SLOTTOK + 576 * 1024;
constexpr size_t WS_CNT = WS_SLOTRS + 576 * 1024;
constexpr size_t WS_RWT = WS_CNT + 64 * 1024;
constexpr size_t WS_RWG = WS_RWT + 512 * 1024;
constexpr size_t WS_SMALL_END = WS_RWG + 64 * 1024;
static_assert(WS_SMALL_END <= 16 * MiB, "small arrays");
constexpr size_t WS_WQKV = 16 * MiB;
constexpr size_t WS_WO = WS_WQKV + 12 * MiB;
constexpr size_t WS_WPC = WS_WO + 4 * MiB;
constexpr size_t WS_WPO = WS_WPC + 4 * MiB;
constexpr size_t WS_WGU = WS_WPO + 4 * MiB;
constexpr size_t WS_WDN = WS_WGU + 256 * MiB;
constexpr size_t WS_XB = WS_WDN + 128 * MiB;
constexpr size_t WS_ACT = WS_XB + 128 * MiB;
constexpr size_t WS_END = WS_ACT + 408 * MiB;
static_assert(WS_END <= 1126807104ull, "d_ws map exceeds the guaranteed workspace");
constexpr float A8_SCALE = 8.f, WN8_SCALE = 64.f;
constexpr size_t ACT_Q = 0, ACT_K = 128 * MiB, ACT_V = 256 * MiB;
constexpr size_t ACT_U = 0, ACT_P = 128 * MiB;
constexpr size_t ACT_H = 0, ACT_Y = 136 * MiB, ACT_X8 = 288 * MiB;
constexpr int CW_BAR = 4096;
constexpr int CW_TILES = 16384;

constexpr int RING_BYTES = 131072;
constexpr int LUT_OFF = RING_BYTES;
constexpr int LUT_N = 336;
constexpr int MISC_OFF = LUT_OFF + NHEAD * LUT_N * 4;
constexpr int TS_OFF = MISC_OFF + 256;
constexpr int LDS_BYTES = 147456;
static_assert(TS_OFF + 256 <= LDS_BYTES, "LDS map");

#define RLX_AGENT __ATOMIC_RELAXED, __HIP_MEMORY_SCOPE_AGENT
__device__ __forceinline__ unsigned cvtpk(float lo, float hi) { f32x2 v = {lo, hi}; bf16x2_t b = __builtin_convertvector(v, bf16x2_t); return __builtin_bit_cast(unsigned, b); }
__device__ __forceinline__ float bf2f(unsigned short h) { return __builtin_bit_cast(float, (unsigned)h << 16); }
__device__ __forceinline__ float wave_sum(float v) {
#pragma unroll
    for (int o = 1; o < 64; o <<= 1) v += __shfl_xor(v, o);
    return v;
}

__device__ __forceinline__ int opaque_tid() { int t = threadIdx.x; asm volatile("" : "+v"(t)); return t; }

#define XB_TMO      128
#define XB_XCNT(j)  (256  + 64 * (j))
#define XB_XSUB(j)  (1280 + 64 * (j))
#define XB_XGEN(j)  (2304 + 64 * (j))
#define XB_TOP      3328
#define XB_TOPGEN   3392
#define XCD_BAR_WORDS 3456
#define XB_SPIN_CAP (1u << 18)
__device__ __forceinline__ unsigned xb_ld(unsigned* p)              { return __hip_atomic_load(p, __ATOMIC_RELAXED, __HIP_MEMORY_SCOPE_AGENT); }
__device__ __forceinline__ unsigned xb_add(unsigned* p, unsigned v) { return __hip_atomic_fetch_add(p, v, __ATOMIC_RELAXED, __HIP_MEMORY_SCOPE_AGENT); }
__device__ __forceinline__ unsigned xb_xcc_id() { return (unsigned)__builtin_amdgcn_s_getreg((3 << 11) | 20) & 0xFu; }
#define XB_SPIN(cond, bar) do { unsigned _sp = 0; while (cond) { __builtin_amdgcn_s_sleep(1); \
    if ((++_sp & 255u) == 0u) { if (xb_ld(&(bar)[XB_TMO])) break; if (_sp > XB_SPIN_CAP) { atomicAdd(&(bar)[XB_TMO], 1u); break; } } } } while (0)
struct XcdBarrier { unsigned* bar; unsigned x; volatile LAS unsigned* st; };
__device__ __forceinline__ XcdBarrier xcd_barrier_post(unsigned* bar, volatile LAS unsigned* st) {
    XcdBarrier b; b.bar = bar; b.x = xb_xcc_id(); b.st = st;
    if (threadIdx.x == 0) (void)xb_add(&bar[XB_XCNT(b.x)], 1u);
    return b;
}
__device__ __forceinline__ void xcd_barrier_complete(unsigned* bar, unsigned x, unsigned& nloc, unsigned& nx) {
    const unsigned G = gridDim.x * gridDim.y * gridDim.z;
    unsigned sum, cnt, mine, sp = 0u;
    for (;;) {
        sum = 0u; cnt = 0u; mine = 0u;
#pragma unroll
        for (unsigned j = 0; j < 16; ++j) { const unsigned c = xb_ld(&bar[XB_XCNT(j)]); sum += c; cnt += (c > 0u) ? 1u : 0u; mine = (j == x) ? c : mine; }
        if (sum == G) break;
        __builtin_amdgcn_s_sleep(1);
        if ((++sp & 255u) == 0u) { if (xb_ld(&bar[XB_TMO])) break; if (sp > XB_SPIN_CAP) { atomicAdd(&bar[XB_TMO], 1u); break; } }
    }
    nloc = mine > 0u ? mine : 1u; nx = cnt > 0u ? cnt : 1u;
}
__device__ __forceinline__ void xcd_barrier(const XcdBarrier& b) {
    asm volatile("s_waitcnt vmcnt(0)" ::: "memory");
    __syncthreads();
    if (threadIdx.x == 0) {
        unsigned* bar = b.bar;
        __builtin_amdgcn_s_waitcnt(0);
        unsigned nloc = b.st[0], nx = b.st[1];
        if (nloc == 0u) { xcd_barrier_complete(bar, b.x, nloc, nx); b.st[0] = nloc; b.st[1] = nx; }
        const unsigned old = xb_add(&bar[XB_XSUB(b.x)], 1u);
        const unsigned gen = old / nloc;
        if (old + 1u == (gen + 1u) * nloc) {
            __builtin_amdgcn_fence(__ATOMIC_RELEASE, "agent");
            asm volatile("s_waitcnt vmcnt(0)" ::: "memory");
            const unsigned og = xb_add(&bar[XB_TOP], 1u);
            const unsigned tg = og / nx;
            if (og + 1u == (tg + 1u) * nx) xb_add(&bar[XB_TOPGEN], 1u);
            else XB_SPIN(xb_ld(&bar[XB_TOPGEN]) == tg, bar);
            __builtin_amdgcn_fence(__ATOMIC_ACQUIRE, "agent");
            xb_add(&bar[XB_XGEN(b.x)], 1u);
            asm volatile("s_waitcnt vmcnt(0)" ::: "memory");
        } else {
            XB_SPIN(xb_ld(&bar[XB_XGEN(b.x)]) == gen, bar);
            __builtin_amdgcn_fence(__ATOMIC_ACQUIRE, "agent");
            asm volatile("s_waitcnt vmcnt(0)" ::: "memory");
        }
    }
    __syncthreads();
}

namespace pg8 {
constexpr int BM = 256, BK = 64, HALF = 128, HTB = HALF * BK * 2, STAGE_BYTES = 8 * HTB;
__host__ __device__ __forceinline__ int lds_byte(int r, int c) { const int st = (r >> 4) * 2 + (c >> 5), rr = r & 15, cc = c & 31, ob = rr * 64 + cc * 2; return st * 1024 + (ob ^ (((ob >> 9) & 1) << 5)); }
__host__ __device__ __forceinline__ void stage_rc(int b, int& R, int& C) { const int st = b / 1024, sb = b % 1024, swz = sb ^ (((sb >> 9) & 1) << 5); R = (st >> 1) * 16 + swz / 64; C = (st & 1) * 32 + (swz % 64) / 2; }
__host__ __device__ __forceinline__ int perm32(int rho) { const int n = rho >> 4, i = rho & 15; return 8 * (i >> 2) + 4 * n + (i & 3); }
struct Unit { int pm, pn, e; };

template <class Epi, class Sched, bool ALIGN_EPI, bool FP8 = false>
__device__ __forceinline__ void gemm_phase(LAS unsigned char* lds, const int K, const Sched& S, const Epi& E) {
    const int tid = opaque_tid(), wid = __builtin_amdgcn_readfirstlane(tid >> 6), lane = tid & 63, wr = wid >> 2, wc = wid & 3, fr = lane & 15, fq = lane >> 4;
    const int nt = FP8 ? K / 128 : K / BK;
    int RA[2], CA[2]; unsigned voffB[2];
#pragma unroll
    for (int i = 0; i < 2; ++i) { int R, C; stage_rc(tid * 16 + i * 8192, R, C); RA[i] = R; CA[i] = C * 2;
        voffB[i] = (unsigned)(tid * 16 + i * 8192); }
    const size_t kstep = (size_t)(BK * 2);
    const size_t hstepB = 16384, kstepB = 32768;
    const unsigned ldsw = (unsigned)wid * 1024u;
    const int aoff = lds_byte(wr * 64 + fr, fq * 8), boff = lds_byte(wc * 32 + fr, fq * 8);
    const int aoff8 = lds_byte(wr * 64 + fr, fq * 16), boff8 = lds_byte(wc * 32 + fr, fq * 16);
#define PG8_SA(b, h) (((b) * 2 + (h)) * HTB)
#define PG8_SB(b, h) ((4 + (b) * 2 + (h)) * HTB)
#define PG8_STAGE(bufoff, gbase, v0, v1) do { const char* gb_ = (const char*)(gbase); unsigned v0_ = (v0), v1_ = (v1); asm volatile("" : "+s"(gb_), "+v"(v0_), "+v"(v1_)); \
        __builtin_amdgcn_global_load_lds((const unsigned*)(gb_ + v0_), (LAS unsigned*)(lds + (bufoff) + ldsw), 16, 0, 0); \
        __builtin_amdgcn_global_load_lds((const unsigned*)(gb_ + v1_), (LAS unsigned*)(lds + (bufoff) + ldsw + 8192), 16, 0, 0); } while (0)
#define PG8_STAGEA(bufoff, gbase, V, h) PG8_STAGE(bufoff, gbase, V[h][0], V[h][1])
#define PG8_STAGEB(bufoff, gbase) PG8_STAGE(bufoff, gbase, voffB[0], voffB[1])
#define PG8_LDA(dst, b, h) do { if constexpr (FP8) { _Pragma("unroll") for (int m = 0; m < 4; ++m) { const u32x4 l_ = *(const LAS u32x4*)(lds + PG8_SA(b, h) + aoff8 + m * 2048), h_ = *(const LAS u32x4*)(lds + PG8_SA(b, h) + aoff8 + m * 2048 + 16); \
            dst##8[m] = (i32x8){(int)l_.x, (int)l_.y, (int)l_.z, (int)l_.w, (int)h_.x, (int)h_.y, (int)h_.z, (int)h_.w}; } } \
        else { _Pragma("unroll") for (int m = 0; m < 4; ++m) _Pragma("unroll") for (int k = 0; k < 2; ++k) dst[m][k] = *(const LAS bf16x8*)(lds + PG8_SA(b, h) + aoff + m * 2048 + k * 1024); } } while (0)
#define PG8_LDB(dst, b, h) do { if constexpr (FP8) { _Pragma("unroll") for (int n = 0; n < 2; ++n) { const u32x4 l_ = *(const LAS u32x4*)(lds + PG8_SB(b, h) + boff8 + n * 2048), h_ = *(const LAS u32x4*)(lds + PG8_SB(b, h) + boff8 + n * 2048 + 16); \
            dst##8[n] = (i32x8){(int)l_.x, (int)l_.y, (int)l_.z, (int)l_.w, (int)h_.x, (int)h_.y, (int)h_.z, (int)h_.w}; } } \
        else { _Pragma("unroll") for (int n = 0; n < 2; ++n) _Pragma("unroll") for (int k = 0; k < 2; ++k) dst[n][k] = *(const LAS bf16x8*)(lds + PG8_SB(b, h) + boff + n * 2048 + k * 1024); } } while (0)
#define PG8_MMA(ai, bj, At, Bt) do { __builtin_amdgcn_s_setprio(1); \
        if constexpr (FP8) { _Pragma("unroll") for (int m = 0; m < 4; ++m) _Pragma("unroll") for (int n = 0; n < 2; ++n) \
            acc[ai][bj][m][n] = __builtin_amdgcn_mfma_scale_f32_16x16x128_f8f6f4(Bt##8[n], At##8[m], acc[ai][bj][m][n], 0, 0, 0, 0x7f7f7f7f, 0, 0x7f7f7f7f); } \
        else { _Pragma("unroll") for (int m = 0; m < 4; ++m) _Pragma("unroll") for (int n = 0; n < 2; ++n) _Pragma("unroll") for (int k = 0; k < 2; ++k) \
            acc[ai][bj][m][n] = __builtin_amdgcn_mfma_f32_16x16x32_bf16(Bt[n][k], At[m][k], acc[ai][bj][m][n], 0, 0, 0); } \
        __builtin_amdgcn_s_setprio(0); } while (0)
#define PG8_WAIT_V(n) asm volatile("s_waitcnt vmcnt(" #n ")" ::: "memory")
#define PG8_WAIT_L(n) asm volatile("s_waitcnt lgkmcnt(" #n ")" ::: "memory")
#define PG8_BAR __builtin_amdgcn_s_barrier()
#define PG8_SCHED __builtin_amdgcn_sched_barrier(0)
#define PG8_SCHED8 do { if constexpr (FP8) __builtin_amdgcn_sched_barrier(0); } while (0)
    Unit cur, nxt; int ui = 0;
    if (!S.next(0, cur)) return;
    f32x4 acc[2][2][4][2];
#pragma unroll
    for (int a = 0; a < 2; ++a)
#pragma unroll
        for (int b = 0; b < 2; ++b)
#pragma unroll
            for (int m = 0; m < 4; ++m)
#pragma unroll
                for (int n = 0; n < 2; ++n) acc[a][b][m][n] = (f32x4){0.f, 0.f, 0.f, 0.f};
    bf16x8 At[4][2], B0[2][2], B1[2][2]; i32x8 At8[4], B08[2], B18[2];
    const char* const Ab = S.a_base();
    unsigned cvA[2][2];
#pragma unroll
    for (int h = 0; h < 2; ++h)
#pragma unroll
        for (int i = 0; i < 2; ++i) cvA[h][i] = S.a_row_off(cur, h * HALF + RA[i]) + (unsigned)CA[i];
    const char* cB = S.b_base(cur);
    PG8_STAGEB(PG8_SB(0, 0), cB); PG8_STAGEB(PG8_SB(0, 1), cB + hstepB); PG8_STAGEA(PG8_SA(0, 0), Ab, cvA, 0); PG8_STAGEA(PG8_SA(0, 1), Ab, cvA, 1);
    if (wr == 1) PG8_BAR;
    PG8_WAIT_V(2); PG8_BAR;
    PG8_STAGEB(PG8_SB(1, 0), cB + kstepB); PG8_STAGEA(PG8_SA(1, 0), Ab + kstep, cvA, 0); PG8_STAGEB(PG8_SB(1, 1), cB + hstepB + kstepB);
    PG8_WAIT_V(6); PG8_BAR;
    for (;;) {
        const bool has_next = S.next(ui + 1, nxt);
        const char* nB = has_next ? S.b_base(nxt) : cB;
        for (int t = 0; t < nt; t += 2) {
            const bool last = (t == nt - 2);
            const char* a1 = Ab + (size_t)(t + 1) * kstep;
            const char* a2 = last ? Ab : Ab + (size_t)(t + 2) * kstep; const char* b2 = last ? nB : cB + (size_t)(t + 2) * kstepB;
            const char* a3 = a2 + kstep; const char* b3 = b2 + kstepB;
            PG8_LDB(B0, 0, 0); PG8_LDB(B1, 0, 1); PG8_SCHED; PG8_LDA(At, 0, 0); PG8_STAGEA(PG8_SA(1, 1), a1, cvA, 1);
            if (last && has_next) {
#pragma unroll
                for (int h = 0; h < 2; ++h)
#pragma unroll
                    for (int i = 0; i < 2; ++i) cvA[h][i] = S.a_row_off(nxt, h * HALF + RA[i]) + (unsigned)CA[i]; }
            PG8_WAIT_V(8); PG8_WAIT_L(0); PG8_BAR; PG8_SCHED8; PG8_MMA(0, 0, At, B0); PG8_MMA(0, 1, At, B1); PG8_SCHED8; PG8_BAR; PG8_SCHED;
            PG8_LDA(At, 0, 1); PG8_STAGEB(PG8_SB(0, 0), b2); PG8_STAGEB(PG8_SB(0, 1), b2 + hstepB); PG8_STAGEA(PG8_SA(0, 0), a2, cvA, 0);
            PG8_WAIT_V(8); PG8_WAIT_L(0); PG8_BAR; PG8_SCHED8; PG8_MMA(1, 0, At, B0); PG8_MMA(1, 1, At, B1); PG8_SCHED8; PG8_BAR; PG8_SCHED;
            PG8_LDB(B0, 1, 0); PG8_LDB(B1, 1, 1); PG8_SCHED; PG8_LDA(At, 1, 0); PG8_STAGEA(PG8_SA(0, 1), a2, cvA, 1);
            PG8_WAIT_V(8); PG8_WAIT_L(0); PG8_BAR; PG8_SCHED8; PG8_MMA(0, 0, At, B0); PG8_MMA(0, 1, At, B1); PG8_SCHED8; PG8_BAR; PG8_SCHED;
            PG8_LDA(At, 1, 1); PG8_STAGEB(PG8_SB(1, 0), b3); PG8_STAGEB(PG8_SB(1, 1), b3 + hstepB); PG8_STAGEA(PG8_SA(1, 0), a3, cvA, 0);
            PG8_WAIT_V(8); PG8_WAIT_L(0); PG8_BAR; PG8_SCHED8; PG8_MMA(1, 0, At, B0); PG8_MMA(1, 1, At, B1); PG8_SCHED8; PG8_BAR; PG8_SCHED;
        }
        if constexpr (ALIGN_EPI) { if (wr == 0) PG8_BAR; }
        E(acc, cur, wr, wc, fr, fq);
        if (!has_next) break;
#pragma unroll
        for (int a = 0; a < 2; ++a)
#pragma unroll
            for (int b = 0; b < 2; ++b)
#pragma unroll
                for (int m = 0; m < 4; ++m)
#pragma unroll
                    for (int n = 0; n < 2; ++n) acc[a][b][m][n] = (f32x4){0.f, 0.f, 0.f, 0.f};
        cur = nxt; cB = nB; ++ui;
        if constexpr (ALIGN_EPI) { if (wr == 1) PG8_BAR; }
    }
    PG8_WAIT_V(0);
    if constexpr (!ALIGN_EPI) { if (wr == 0) PG8_BAR; }
    PG8_BAR;
#undef PG8_SA
#undef PG8_SB
#undef PG8_STAGE
#undef PG8_STAGEA
#undef PG8_STAGEB
#undef PG8_LDA
#undef PG8_LDB
#undef PG8_MMA
#undef PG8_WAIT_V
#undef PG8_WAIT_L
#undef PG8_BAR
#undef PG8_SCHED
#undef PG8_SCHED8
}
}

struct SchedBase { int x, j, G8, NGp; __device__ __forceinline__ void init_grid() { const int G = gridDim.x, bx = blockIdx.x; if (G % 8 == 0) { NGp = 8; x = bx % 8; j = bx / 8; G8 = G / 8; } else { NGp = 1; x = 0; j = bx; G8 = G; } } };
struct PlainSched : SchedBase {
    const char* A; unsigned lda; const char* Bt; int K, nN, nrt;
    __device__ __forceinline__ bool next(int i, pg8::Unit& u) const { const int U = i * G8 + j, nrtg = (nrt - x + NGp - 1) / NGp; if (U >= nrtg * nN) return false; const int q = U / nN; u.pn = U - q * nN; u.pm = x + NGp * q; return true; }
    __device__ __forceinline__ const char* a_base() const { return A; }
    __device__ __forceinline__ unsigned a_row_off(const pg8::Unit& u, int r) const { return (unsigned)(u.pm * 256 + r) * lda; }
    __device__ __forceinline__ const char* b_base(const pg8::Unit& u) const { return Bt + (size_t)u.pn * 256 * K * 2; }
};
struct GroupSched : SchedBase {
    const char* A; unsigned lda; const int* slot_tok; const char* Bt; size_t strideE; int K; const LAS int* ts;
    __device__ __forceinline__ bool next(int i, pg8::Unit& u) const {
        const int U = i * G8 + j; int q = U >> 2; u.pn = U & 3;
        for (int e = x; e < NEXP; e += NGp) { const int t0 = __builtin_amdgcn_readfirstlane(ts[e]), n = __builtin_amdgcn_readfirstlane(ts[e + 1]) - t0; if (q < n) { u.pm = t0 + q; u.e = e; return true; } q -= n; }
        return false; }
    __device__ __forceinline__ const char* a_base() const { return A; }
    __device__ __forceinline__ unsigned a_row_off(const pg8::Unit& u, int r) const { int row = u.pm * 256 + r; if (slot_tok) row = slot_tok[row]; return (unsigned)row * lda; }
    __device__ __forceinline__ const char* b_base(const pg8::Unit& u) const { return Bt + (size_t)u.e * strideE + (size_t)u.pn * 256 * K * 2; }
};

typedef f32x4 Acc[2][2][4][2];
struct EpiQKV {
    bf16_t* Q; const float* rstd; const LAS float* gl;
    __device__ __forceinline__ void operator()(const Acc& acc, const pg8::Unit& u, int wr, int wc, int fr, int fq) const {
        const int part = u.pn >> 2, colp = (u.pn & 3) * 256 + wc * 64 + 8 * fq;
        bf16_t* base = Q + (size_t)part * NTOK * DM;
        const float qs = part == 0 ? 0.125f * LOG2E : 1.f;
#pragma unroll
        for (int ai = 0; ai < 2; ++ai)
#pragma unroll
            for (int m = 0; m < 4; ++m) {
                const int row = u.pm * 256 + ai * 128 + wr * 64 + m * 16 + fr;
                const float rs = rstd[row];
                float f = rs;
                if (part < 2) { float ss = 0.f;
#pragma unroll
                    for (int bj = 0; bj < 2; ++bj)
#pragma unroll
                        for (int n = 0; n < 2; ++n) { const f32x4 t = acc[ai][bj][m][n] * rs; const f32x4 t2 = t * t; ss += (t2[0] + t2[1]) + (t2[2] + t2[3]); }
                    ss += __shfl_xor(ss, 16); ss += __shfl_xor(ss, 32); f = rs * __builtin_amdgcn_rsqf(ss * (1.f / 64.f) + EPS) * qs; }
                const int hh = (u.pn & 3) * 2 + (wc >> 1), tl = (row & (SEQ - 1)) >> 6, rr = row & 63;
                const size_t tb = ((size_t)((row >> 12) * NHEAD + hh) * 64 + tl) * 8192;
#pragma unroll
                for (int bj = 0; bj < 2; ++bj) {
                    f32x4 g0 = {f, f, f, f}, g1 = g0;
                    if (part < 2) { const LAS f32x4* gp = (const LAS f32x4*)(gl + part * 64 + 32 * bj + 8 * fq); g0 = gp[0] * f; g1 = gp[1] * f; }
                    const f32x4 a = acc[ai][bj][m][0] * g0, b = acc[ai][bj][m][1] * g1;
                    u32x4 w; w.x = cvtpk(a[0], a[1]); w.y = cvtpk(a[2], a[3]); w.z = cvtpk(b[0], b[1]); w.w = cvtpk(b[2], b[3]);
                    if (part == 0) *(u32x4*)(base + (size_t)row * DM + colp + 32 * bj) = w;
                    else if (part == 1) *(u32x4*)(base + tb + ((wc & 1) * 8 + 4 * bj + fq) * 512 + rr * 8) = w;
                    else *(u32x4*)(base + tb + (2 * (wc & 1) + bj) * 2048 + rr * 32 + 8 * fq) = w; }
            }
    }
};
__device__ __forceinline__ int cvt8(float a, float b, int old, bool hi) {
    a = __builtin_amdgcn_fmed3f(a, -448.f, 448.f); b = __builtin_amdgcn_fmed3f(b, -448.f, 448.f);
    return hi ? __builtin_amdgcn_cvt_pk_fp8_f32(a, b, old, true) : __builtin_amdgcn_cvt_pk_fp8_f32(a, b, old, false);
}
struct EpiBf16 {
    bf16_t* O; int ldc; const float* rstd; float mul;
    __device__ __forceinline__ void operator()(const Acc& acc, const pg8::Unit& u, int wr, int wc, int fr, int fq) const {
        const int col = u.pn * 256 + wc * 64 + 8 * fq;
        float rsv[2][4];
#pragma unroll
        for (int ai = 0; ai < 2; ++ai)
#pragma unroll
            for (int m = 0; m < 4; ++m) rsv[ai][m] = (rstd ? rstd[u.pm * 256 + ai * 128 + wr * 64 + m * 16 + fr] : 1.f) * mul;
        asm volatile("" : "+v"(rsv[0][0]), "+v"(rsv[0][1]), "+v"(rsv[0][2]), "+v"(rsv[0][3]), "+v"(rsv[1][0]), "+v"(rsv[1][1]), "+v"(rsv[1][2]), "+v"(rsv[1][3]) :: "memory");
#pragma unroll
        for (int ai = 0; ai < 2; ++ai)
#pragma unroll
            for (int m = 0; m < 4; ++m) {
                const int row = u.pm * 256 + ai * 128 + wr * 64 + m * 16 + fr;
                const float rs = rsv[ai][m];
#pragma unroll
                for (int bj = 0; bj < 2; ++bj) { const f32x4 a = acc[ai][bj][m][0] * rs, b = acc[ai][bj][m][1] * rs; u32x4 w; w.x = cvtpk(a[0], a[1]); w.y = cvtpk(a[2], a[3]); w.z = cvtpk(b[0], b[1]); w.w = cvtpk(b[2], b[3]);
                    *(u32x4*)(O + (size_t)row * ldc + col + 32 * bj) = w; }
            }
    }
};
constexpr float Y8_SCALE = 16.f;
struct EpiY8 {
    static constexpr int NSTORES = 8;
    unsigned char* Y;
    __device__ __forceinline__ void operator()(const Acc& acc, const pg8::Unit& u, int wr, int wc, int fr, int fq) const {
        const int pos = u.pn * 256 + wc * 64 + 16 * fq;
        constexpr float YS = Y8_SCALE / (16.f * 64.f);
#pragma unroll
        for (int ai = 0; ai < 2; ++ai)
#pragma unroll
            for (int m = 0; m < 4; ++m) {
                const int row = u.pm * 256 + ai * 128 + wr * 64 + m * 16 + fr;
                u32x4 w;
#pragma unroll
                for (int bj = 0; bj < 2; ++bj) { const f32x4 a = acc[ai][bj][m][0] * YS, b = acc[ai][bj][m][1] * YS;
                    int lo = cvt8(a[0], a[1], 0, false); lo = cvt8(a[2], a[3], lo, true);
                    int hi = cvt8(b[0], b[1], 0, false); hi = cvt8(b[2], b[3], hi, true);
                    w[2 * bj] = (unsigned)lo; w[2 * bj + 1] = (unsigned)hi; }
                *(u32x4*)(Y + (size_t)row * DM + pos) = w;
            }
    }
};
constexpr float X8_SCALE = 4.f, WG8_SCALE = 64.f, WPC8_SCALE = 64.f;
struct EpiRes {
    bf16_t* xb; const float* scale; unsigned char* x8; float mul;
    __device__ __forceinline__ void operator()(const Acc& acc, const pg8::Unit& u, int wr, int wc, int fr, int fq) const {
        const int col = u.pn * 256 + wc * 64 + 8 * fq;
        f32x4 sc[2][2];
#pragma unroll
        for (int bj = 0; bj < 2; ++bj)
#pragma unroll
            for (int n = 0; n < 2; ++n) sc[bj][n] = (scale ? *(const f32x4*)(scale + col + 32 * bj + 4 * n) : (f32x4){1.f, 1.f, 1.f, 1.f}) * mul;
#pragma unroll
        for (int ai = 0; ai < 2; ++ai) {
            u32x4 r[2][4][2];
#pragma unroll
            for (int m = 0; m < 4; ++m)
#pragma unroll
                for (int bj = 0; bj < 2; ++bj) r[ai][m][bj] = *(const u32x4*)(xb + (size_t)(u.pm * 256 + ai * 128 + wr * 64 + m * 16 + fr) * DM + col + 32 * bj);
            asm volatile("" ::: "memory");
#pragma unroll
            for (int m = 0; m < 4; ++m) {
                const size_t off = (size_t)(u.pm * 256 + ai * 128 + wr * 64 + m * 16 + fr) * DM + col;
                u32x4 w8;
#pragma unroll
                for (int bj = 0; bj < 2; ++bj) {
                    const u32x4 q = r[ai][m][bj];
                    const f32x4 a = acc[ai][bj][m][0] * sc[bj][0], b = acc[ai][bj][m][1] * sc[bj][1];
                    const float x0 = __builtin_bit_cast(float, q.x << 16) + a[0], x1 = __builtin_bit_cast(float, q.x & 0xffff0000u) + a[1], x2 = __builtin_bit_cast(float, q.y << 16) + a[2], x3 = __builtin_bit_cast(float, q.y & 0xffff0000u) + a[3];
                    const float x4 = __builtin_bit_cast(float, q.z << 16) + b[0], x5 = __builtin_bit_cast(float, q.z & 0xffff0000u) + b[1], x6 = __builtin_bit_cast(float, q.w << 16) + b[2], x7 = __builtin_bit_cast(float, q.w & 0xffff0000u) + b[3];
                    u32x4 w; w.x = cvtpk(x0, x1); w.y = cvtpk(x2, x3); w.z = cvtpk(x4, x5); w.w = cvtpk(x6, x7);
                    *(u32x4*)(xb + off + 32 * bj) = w;
                    int lo = cvt8(x0 * X8_SCALE, x1 * X8_SCALE, 0, false); lo = cvt8(x2 * X8_SCALE, x3 * X8_SCALE, lo, true);
                    int hi = cvt8(x4 * X8_SCALE, x5 * X8_SCALE, 0, false); hi = cvt8(x6 * X8_SCALE, x7 * X8_SCALE, hi, true);
                    w8[2 * bj] = (unsigned)lo; w8[2 * bj + 1] = (unsigned)hi; }
                *(u32x4*)(x8 + (size_t)(u.pm * 256 + ai * 128 + wr * 64 + m * 16 + fr) * DM + u.pn * 256 + wc * 64 + 16 * fq) = w8;
            }
        }
    }
};
constexpr float H8_SCALE = 16.f, WD8_SCALE = 64.f;
struct EpiGateUp {
    static constexpr int NSTORES = 8;
    unsigned char* H; const float* slot_rs;
    __device__ __forceinline__ void operator()(const Acc& acc, const pg8::Unit& u, int wr, int wc, int fr, int fq) const {
#pragma unroll
        for (int ai = 0; ai < 2; ++ai) {
            float rsv[4];
#pragma unroll
            for (int m = 0; m < 4; ++m) rsv[m] = slot_rs[u.pm * 256 + ai * 128 + wr * 64 + m * 16 + fr];
            asm volatile("" : "+v"(rsv[0]), "+v"(rsv[1]), "+v"(rsv[2]), "+v"(rsv[3]) :: "memory");
            u32x2 w[4];
#pragma unroll
            for (int m = 0; m < 4; ++m) {
                const float rs = rsv[m] * (1.f / (X8_SCALE * WG8_SCALE));
                float h[8];
#pragma unroll
                for (int n = 0; n < 2; ++n)
#pragma unroll
                    for (int i = 0; i < 4; ++i) { const float g = acc[ai][0][m][n][i] * rs, up = acc[ai][1][m][n][i] * rs;
                        h[4 * n + i] = g * up * __builtin_amdgcn_rcpf(1.f + __builtin_amdgcn_exp2f(-g * LOG2E)) * H8_SCALE; }
                int lo = cvt8(h[0], h[1], 0, false); lo = cvt8(h[2], h[3], lo, true);
                int hi = cvt8(h[4], h[5], 0, false); hi = cvt8(h[6], h[7], hi, true);
                w[m].x = (unsigned)lo; w[m].y = (unsigned)hi;
            }
            const int odd = fq & 1;
#pragma unroll
            for (int mp = 0; mp < 4; mp += 2) {
                const u32x2 snd = odd ? w[mp] : w[mp + 1], own = odd ? w[mp + 1] : w[mp];
                u32x2 rcv; rcv.x = (unsigned)__shfl_xor((int)snd.x, 16); rcv.y = (unsigned)__shfl_xor((int)snd.y, 16);
                u32x4 o; o.x = odd ? rcv.x : own.x; o.y = odd ? rcv.y : own.y; o.z = odd ? own.x : rcv.x; o.w = odd ? own.y : rcv.y;
                const int row = u.pm * 256 + ai * 128 + wr * 64 + (mp + odd) * 16 + fr;
                *(u32x4*)(H + (size_t)row * EFF + u.pn * 128 + wc * 32 + 8 * (fq & 2)) = o;
            }
        }
    }
};

namespace attn {
constexpr int SLOT = 32768, V_OFF = 16384, NSLOT = 3, X_OFF = NSLOT * SLOT, WSF_OFF = TS_OFF + 256;
static_assert(X_OFF + 4 * 8192 <= RING_BYTES && WSF_OFF + NWAVES * 256 <= LDS_BYTES, "attn LDS");
constexpr int DMAXI = 206;
__device__ __forceinline__ int crow(int r, int hi) { return (r & 3) + 8 * (r >> 2) + 4 * hi; }
__device__ __forceinline__ int rel_bucket(int n) {
    if (n < 16) return n;
    const int l = 16 + (int)(logf((float)n / 16.f) / logf(8.f) * 16.f);
    return l < 31 ? l : 31;
}
struct Params { const bf16_t* Q; const bf16_t* K; const bf16_t* V; bf16_t* O; const float* rel_bias; const float* subln; float lam; float one_minus_li; };

__device__ __forceinline__ void build_lut(LAS unsigned char* lds, const float* rel_bias) {
    LAS float* lut = (LAS float*)(lds + LUT_OFF);
    for (int idx = opaque_tid(); idx < NHEAD * LUT_N; idx += NTHREADS) {
        const int h = idx / LUT_N, i = idx - h * LUT_N, dist = DMAXI - i;
        lut[idx] = dist < 0 ? -INFINITY : (rel_bias[rel_bucket(dist) * NHEAD + h] - rel_bias[31 * NHEAD + h]) * LOG2E;
    }
}
#define ATT_WAIT_BAR(N) asm volatile("s_waitcnt vmcnt(" #N ") lgkmcnt(0)\n\ts_barrier" ::: "memory")
#define ATT_SBAR() __builtin_amdgcn_sched_barrier(0)
#define ATT_PIN(x) asm volatile("" : "+v"(x))
#define ATT_MF(a, b, c) __builtin_amdgcn_mfma_f32_32x32x16_bf16(a, b, c, 0, 0, 0)
#define ATT_VRD8(L, H, ks) do { _Pragma("unroll") for (int d_ = 0; d_ < 4; ++d_) { \
        asm volatile("ds_read_b64_tr_b16 %0, %1 offset:%c2" : "=&v"(L[d_]) : "v"(vaddr), "i"(V_OFF + d_ * 4096 + (ks) * 1024) : "memory"); \
        asm volatile("ds_read_b64_tr_b16 %0, %1 offset:%c2" : "=&v"(H[d_]) : "v"(vaddr), "i"(V_OFF + d_ * 4096 + (ks) * 1024 + 512) : "memory"); } } while (0)
#define ATT_VWAIT(N, L, H) do { asm volatile("s_waitcnt lgkmcnt(" #N ")" : "+v"(L[0]), "+v"(L[1]), "+v"(L[2]), "+v"(L[3]), "+v"(H[0]), "+v"(H[1]), "+v"(H[2]), "+v"(H[3]) :: "memory"); ATT_SBAR(); } while (0)
#define ATT_VF(L, H, d) ((bf16x8){L[d][0], L[d][1], L[d][2], L[d][3], H[d][0], H[d][1], H[d][2], H[d][3]})
#define ATT_PK(P, B) cvtpk(P[B], P[(B) + 1])
#define ATT_GAPA(VR, MFX, A0, A1, A2, A3, W0, W1, PW) do { VR; MFX; sacc += A0; sacc += A1; sacc += A2; sacc += A3; ATT_PIN(sacc); W0; W1; ATT_PIN(PW); ATT_SBAR(); } while (0)
#define ATT_VR1(L, H, d, ks) do { \
        asm volatile("ds_read_b64_tr_b16 %0, %1 offset:%c2" : "=&v"(L[d]) : "v"(vaddr), "i"(V_OFF + (d) * 4096 + (ks) * 1024) : "memory"); \
        asm volatile("ds_read_b64_tr_b16 %0, %1 offset:%c2" : "=&v"(H[d]) : "v"(vaddr), "i"(V_OFF + (d) * 4096 + (ks) * 1024 + 512) : "memory"); } while (0)
#define ATT_GAPB(KR, MFX, X, B) do { KR; MFX; X[B] = __builtin_amdgcn_exp2f(X[B]); X[(B) + 1] = __builtin_amdgcn_exp2f(X[(B) + 1]); ATT_PIN(X); ATT_SBAR(); } while (0)
#define ATT_VRW(N, L, H, d) asm volatile("s_waitcnt lgkmcnt(" #N ")" : "+v"(L[d]), "+v"(H[d]) :: "memory")
#define ATT_GAPB2(WT, MFX, VR, KR, DM, X, B) do { WT; MFX; VR; KR; DM; X[B] = __builtin_amdgcn_exp2f(X[B]); X[(B) + 1] = __builtin_amdgcn_exp2f(X[(B) + 1]); ATT_PIN(X); ATT_SBAR(); } while (0)
#define ATT_KR(GL, j) do { if (GL) { kf[2 * (j)] = *(const LAS bf16x8*)(kp0 + sl_next + (j) * 2048); kf[2 * (j) + 1] = *(const LAS bf16x8*)(kp0 + sl_next + (j) * 2048 + 512); } } while (0)
#define ATT_NOP() do { } while (0)
#define ATT_KLOAD(kp_) do { _Pragma("unroll") for (int d0_ = 0; d0_ < 4; ++d0_) { kf[2 * d0_] = *(const LAS bf16x8*)((kp_) + d0_ * 2048); kf[2 * d0_ + 1] = *(const LAS bf16x8*)((kp_) + d0_ * 2048 + 512); } } while (0)
#define ATT_BAND(C0, C1, tt) do { const int dd_ = q0w - 64 * (tt); if (dd_ - 63 < 113) { const LAS float* lb_ = lut + (DMAXI - (dd_ + r32 - 4 * hi)); \
        _Pragma("unroll") for (int r = 0; r < 16; ++r) { C0[r] += lb_[(r & 3) + 8 * (r >> 2)]; C1[r] += lb_[32 + (r & 3) + 8 * (r >> 2)]; } } } while (0)
#define ATT_STEP(C0, C1, P0, P1, tt, ITOP, I0, I1, I2, I3, GL, WN) do { \
        ATT_WAIT_BAR(WN); \
        ITOP; \
        const unsigned vaddr = lds_u + (unsigned)sl_prev + (unsigned)vlane; \
        float sacc = 0.f; \
        ATT_GAPA(ATT_VR1(la, ha, 0, 0), C0 = ATT_MF(kf[0], qr[0], zero16), P0[0], P0[1], P0[2], P0[3],     pw0[0] = ATT_PK(P0, 0),  pw0[1] = ATT_PK(P0, 2),  pw0); \
        ATT_GAPA(ATT_VR1(la, ha, 1, 0), C1 = ATT_MF(kf[1], qr[0], zero16), P0[4], P0[5], P0[6], P0[7],     pw0[2] = ATT_PK(P0, 4),  pw0[3] = ATT_PK(P0, 6),  pw0); \
        ATT_GAPA(ATT_VR1(la, ha, 2, 0), C0 = ATT_MF(kf[2], qr[1], C0),     P0[8], P0[9], P0[10], P0[11],   pw1[0] = ATT_PK(P0, 8),  pw1[1] = ATT_PK(P0, 10), pw1); \
        ATT_GAPA(ATT_VR1(la, ha, 3, 0), C1 = ATT_MF(kf[3], qr[1], C1),     P0[12], P0[13], P0[14], P0[15], pw1[2] = ATT_PK(P0, 12), pw1[3] = ATT_PK(P0, 14), pw1); \
        ATT_GAPA(ATT_NOP(), C0 = ATT_MF(kf[4], qr[2], C0),     P1[0], P1[1], P1[2], P1[3],     pw2[0] = ATT_PK(P1, 0),  pw2[1] = ATT_PK(P1, 2),  pw2); \
        ATT_GAPA(ATT_NOP(), C1 = ATT_MF(kf[5], qr[2], C1),     P1[4], P1[5], P1[6], P1[7],     pw2[2] = ATT_PK(P1, 4),  pw2[3] = ATT_PK(P1, 6),  pw2); \
        ATT_GAPA(ATT_NOP(), C0 = ATT_MF(kf[6], qr[3], C0),     P1[8], P1[9], P1[10], P1[11],   pw3[0] = ATT_PK(P1, 8),  pw3[1] = ATT_PK(P1, 10), pw3); \
        ATT_GAPA(ATT_NOP(), C1 = ATT_MF(kf[7], qr[3], C1),     P1[12], P1[13], P1[14], P1[15], pw3[2] = ATT_PK(P1, 12), pw3[3] = ATT_PK(P1, 14), pw3); \
        lsum += sacc; \
        ATT_BAND(C0, C1, tt); \
        ATT_GAPB2(ATT_VRW(6, la, ha, 0),   o[0] = ATT_MF(__builtin_bit_cast(bf16x8, pw0), ATT_VF(la, ha, 0), o[0]),   ATT_VR1(lb2, hb2, 0, 1), ATT_NOP(),      ATT_NOP(), C0, 0); \
        ATT_GAPB2(ATT_VRW(6, la, ha, 1),   o[1] = ATT_MF(__builtin_bit_cast(bf16x8, pw0), ATT_VF(la, ha, 1), o[1]),   ATT_VR1(lb2, hb2, 1, 1), ATT_NOP(),      ATT_NOP(), C0, 2); \
        ATT_GAPB2(ATT_VRW(6, la, ha, 2),   o[2] = ATT_MF(__builtin_bit_cast(bf16x8, pw0), ATT_VF(la, ha, 2), o[2]),   ATT_VR1(lb2, hb2, 2, 1), ATT_KR(GL, 0),  ATT_NOP(), C0, 4); \
        ATT_GAPB2(ATT_VRW(6, la, ha, 3),   o[3] = ATT_MF(__builtin_bit_cast(bf16x8, pw0), ATT_VF(la, ha, 3), o[3]),   ATT_VR1(lb2, hb2, 3, 1), ATT_KR(GL, 1),  ATT_NOP(), C0, 6); \
        ATT_GAPB2(ATT_VRW(6, lb2, hb2, 0), o[0] = ATT_MF(__builtin_bit_cast(bf16x8, pw1), ATT_VF(lb2, hb2, 0), o[0]), ATT_VR1(la, ha, 0, 2),   ATT_KR(GL, 2),  ATT_NOP(), C0, 8); \
        ATT_GAPB2(ATT_VRW(6, lb2, hb2, 1), o[1] = ATT_MF(__builtin_bit_cast(bf16x8, pw1), ATT_VF(lb2, hb2, 1), o[1]), ATT_VR1(la, ha, 1, 2),   ATT_KR(GL, 3),  ATT_NOP(), C0, 10); \
        ATT_GAPB2(ATT_VRW(6, lb2, hb2, 2), o[2] = ATT_MF(__builtin_bit_cast(bf16x8, pw1), ATT_VF(lb2, hb2, 2), o[2]), ATT_VR1(la, ha, 2, 2),   ATT_NOP(),      ATT_NOP(), C0, 12); \
        ATT_GAPB2(ATT_VRW(6, lb2, hb2, 3), o[3] = ATT_MF(__builtin_bit_cast(bf16x8, pw1), ATT_VF(lb2, hb2, 3), o[3]), ATT_VR1(la, ha, 3, 2),   ATT_NOP(),      ATT_NOP(), C0, 14); \
        ATT_GAPB2(ATT_VRW(6, la, ha, 0),   o[0] = ATT_MF(__builtin_bit_cast(bf16x8, pw2), ATT_VF(la, ha, 0), o[0]),   ATT_VR1(lb2, hb2, 0, 3), ATT_NOP(),      ATT_NOP(), C1, 0); \
        ATT_GAPB2(ATT_VRW(6, la, ha, 1),   o[1] = ATT_MF(__builtin_bit_cast(bf16x8, pw2), ATT_VF(la, ha, 1), o[1]),   ATT_VR1(lb2, hb2, 1, 3), ATT_NOP(),      ATT_NOP(), C1, 2); \
        ATT_GAPB2(ATT_VRW(6, la, ha, 2),   o[2] = ATT_MF(__builtin_bit_cast(bf16x8, pw2), ATT_VF(la, ha, 2), o[2]),   ATT_VR1(lb2, hb2, 2, 3), ATT_NOP(),      ATT_NOP(), C1, 4); \
        ATT_GAPB2(ATT_VRW(6, la, ha, 3),   o[3] = ATT_MF(__builtin_bit_cast(bf16x8, pw2), ATT_VF(la, ha, 3), o[3]),   ATT_VR1(lb2, hb2, 3, 3), ATT_NOP(),      ATT_NOP(), C1, 6); \
        ATT_GAPB2(ATT_VRW(6, lb2, hb2, 0), o[0] = ATT_MF(__builtin_bit_cast(bf16x8, pw3), ATT_VF(lb2, hb2, 0), o[0]), ATT_NOP(),               ATT_NOP(),      I0,        C1, 8); \
        ATT_GAPB2(ATT_VRW(4, lb2, hb2, 1), o[1] = ATT_MF(__builtin_bit_cast(bf16x8, pw3), ATT_VF(lb2, hb2, 1), o[1]), ATT_NOP(),               ATT_NOP(),      I1,        C1, 10); \
        ATT_GAPB2(ATT_VRW(2, lb2, hb2, 2), o[2] = ATT_MF(__builtin_bit_cast(bf16x8, pw3), ATT_VF(lb2, hb2, 2), o[2]), ATT_NOP(),               ATT_NOP(),      I2,        C1, 12); \
        ATT_GAPB2(ATT_VRW(0, lb2, hb2, 3), o[3] = ATT_MF(__builtin_bit_cast(bf16x8, pw3), ATT_VF(lb2, hb2, 3), o[3]), ATT_NOP(),               ATT_NOP(),      I3,        C1, 14); \
        { const int tmp_ = sl_prev; sl_prev = sl_cur; sl_cur = sl_next; sl_next = tmp_; } \
    } while (0)

__device__ __forceinline__ void attn_unit(const Params& P, int b, int h, int qblk, LAS unsigned char* lds) {
    const int tid = opaque_tid(), lane = tid & 63, r32 = lane & 31, hi = lane >> 5;
    const int wid = __builtin_amdgcn_readfirstlane(tid >> 6), c = wid >> 2, wq = wid & 3;
    const int q0 = qblk * 128, q0w = q0 + 32 * wq, NT = 2 * qblk + 2;
    const size_t rowbase = (size_t)b * SEQ;
    bf16x8 qr[4];
    { const bf16_t* Qw = P.Q + (rowbase + q0w + r32) * DM + h * 128 + c * 64 + hi * 8;
#pragma unroll
      for (int d0 = 0; d0 < 4; ++d0) qr[d0] = *(const bf16x8*)(Qw + d0 * 16); }
    const bf16_t* ksrc = P.K + (size_t)(b * NHEAD + h) * 64 * 8192 + wid * 512 + lane * 8;
    const bf16_t* vsrc = P.V + (size_t)(b * NHEAD + h) * 64 * 8192 + (wid >> 2) * 2048 + wq * 512 + lane * 8;
#define ATT_DMA_K0(t, slot) __builtin_amdgcn_global_load_lds((const unsigned*)(ksrc + (size_t)(t) * 8192), (LAS unsigned*)(lds + (slot) + wid * 1024), 16, 0, 0)
#define ATT_DMA_K1(t, slot) __builtin_amdgcn_global_load_lds((const unsigned*)(ksrc + (size_t)(t) * 8192 + 4096), (LAS unsigned*)(lds + (slot) + 8192 + wid * 1024), 16, 0, 0)
#define ATT_DMA_V0(t, slot) __builtin_amdgcn_global_load_lds((const unsigned*)(vsrc + (size_t)(t) * 8192), (LAS unsigned*)(lds + (slot) + V_OFF + (wid >> 2) * 4096 + wq * 1024), 16, 0, 0)
#define ATT_DMA_V1(t, slot) __builtin_amdgcn_global_load_lds((const unsigned*)(vsrc + (size_t)(t) * 8192 + 4096), (LAS unsigned*)(lds + (slot) + V_OFF + (2 + (wid >> 2)) * 4096 + wq * 1024), 16, 0, 0)
#define ATT_DMA_K(t, slot) do { ATT_DMA_K0(t, slot); ATT_DMA_K1(t, slot); } while (0)
#define ATT_DMA_V(t, slot) do { ATT_DMA_V0(t, slot); ATT_DMA_V1(t, slot); } while (0)
    ATT_DMA_K(0, 0);
    ATT_DMA_K(1, SLOT); ATT_DMA_V(0, 0);
    if (NT > 2) ATT_DMA_K(2, 2 * SLOT);
    f32x16 o[4];
#pragma unroll
    for (int d = 0; d < 4; ++d)
#pragma unroll
        for (int r = 0; r < 16; ++r) o[d][r] = 0.f;
    f32x16 zero16;
#pragma unroll
    for (int r = 0; r < 16; ++r) zero16[r] = 0.f;
    float lsum = 0.f;
    const LAS float* lut = (const LAS float*)(lds + LUT_OFF) + h * LUT_N;
    const int vlane = ((lane >> 4) & 1) * 32 + (lane & 3) * 8 + (4 * hi + ((lane & 15) >> 2)) * 64;
    const unsigned lds_u = (unsigned)(uintptr_t)lds;
    const LAS unsigned char* kp0 = lds + c * 8192 + hi * 1024 + r32 * 16;
    int sl_prev = 2 * SLOT, sl_cur = 0, sl_next = SLOT;
    bf16x8 kf[8]; s16x4 la[4], ha[4], lb2[4], hb2[4]; u32x4 pw0, pw1, pw2, pw3;
    f32x16 pA0, pA1, pB0, pB1;
    if (NT > 2) ATT_WAIT_BAR(6); else ATT_WAIT_BAR(4);
    ATT_DMA_V(1, SLOT);
    ATT_KLOAD(kp0);
    pA0 = ATT_MF(kf[0], qr[0], zero16); pA1 = ATT_MF(kf[1], qr[0], zero16);
    pA0 = ATT_MF(kf[2], qr[1], pA0); pA1 = ATT_MF(kf[3], qr[1], pA1);
    pA0 = ATT_MF(kf[4], qr[2], pA0); pA1 = ATT_MF(kf[5], qr[2], pA1);
    pA0 = ATT_MF(kf[6], qr[3], pA0); pA1 = ATT_MF(kf[7], qr[3], pA1);
    ATT_BAND(pA0, pA1, 0);
#pragma unroll
    for (int r = 0; r < 16; ++r) { pA0[r] = __builtin_amdgcn_exp2f(pA0[r]); pA1[r] = __builtin_amdgcn_exp2f(pA1[r]); }
    if (NT > 2) ATT_WAIT_BAR(6); else ATT_WAIT_BAR(4);
    ATT_KLOAD(kp0 + SLOT);
    { const int tmp_ = sl_prev; sl_prev = sl_cur; sl_cur = sl_next; sl_next = tmp_; }
    ATT_STEP(pB0, pB1, pA0, pA1, 1, { if (3 < NT) ATT_DMA_K(3, sl_prev); if (4 < NT) ATT_DMA_K(4, sl_cur); if (2 < NT) ATT_DMA_V(2, sl_next); }, ATT_NOP(), ATT_NOP(), ATT_NOP(), ATT_NOP(), (2 < NT), 2);
    if (NT > 2) {
        int t = 2;
        for (; t + 4 < NT; t += 2) {
            ATT_STEP(pA0, pA1, pB0, pB1, t,     ATT_NOP(), ATT_DMA_K0(t + 3, sl_cur), ATT_DMA_K1(t + 3, sl_cur), ATT_DMA_V0(t + 1, sl_next), ATT_DMA_V1(t + 1, sl_next), true, 4);
            ATT_STEP(pB0, pB1, pA0, pA1, t + 1, ATT_NOP(), ATT_DMA_K0(t + 4, sl_cur), ATT_DMA_K1(t + 4, sl_cur), ATT_DMA_V0(t + 2, sl_next), ATT_DMA_V1(t + 2, sl_next), true, 4);
        }
        if (NT - t == 4) {
            ATT_STEP(pA0, pA1, pB0, pB1, t,     ATT_NOP(), ATT_DMA_K0(t + 3, sl_cur), ATT_DMA_K1(t + 3, sl_cur), ATT_DMA_V0(t + 1, sl_next), ATT_DMA_V1(t + 1, sl_next), true, 4);
            ATT_STEP(pB0, pB1, pA0, pA1, t + 1, ATT_NOP(), ATT_NOP(), ATT_NOP(), ATT_DMA_V0(t + 2, sl_next), ATT_DMA_V1(t + 2, sl_next), true, 4);
            t += 2;
        }
        ATT_STEP(pA0, pA1, pB0, pB1, t,     ATT_NOP(), ATT_NOP(), ATT_NOP(), ATT_DMA_V0(t + 1, sl_next), ATT_DMA_V1(t + 1, sl_next), true, 2);
        ATT_STEP(pB0, pB1, pA0, pA1, t + 1, ATT_NOP(), ATT_NOP(), ATT_NOP(), ATT_NOP(), ATT_NOP(), false, 2);
    }
    { float sacc = 0.f;
#pragma unroll
      for (int r = 0; r < 16; ++r) sacc += pB0[r] + pB1[r];
      lsum += sacc;
#pragma unroll
      for (int q = 0; q < 4; ++q) { pw0[q] = ATT_PK(pB0, 2 * q); pw1[q] = ATT_PK(pB0, 8 + 2 * q); pw2[q] = ATT_PK(pB1, 2 * q); pw3[q] = ATT_PK(pB1, 8 + 2 * q); }
      ATT_WAIT_BAR(0);
      const unsigned vaddr = lds_u + (unsigned)sl_prev + (unsigned)vlane;
      ATT_VRD8(la, ha, 0); ATT_VRD8(lb2, hb2, 1);
      ATT_VWAIT(8, la, ha);
#pragma unroll
      for (int d = 0; d < 4; ++d) o[d] = ATT_MF(__builtin_bit_cast(bf16x8, pw0), ATT_VF(la, ha, d), o[d]);
      ATT_VRD8(la, ha, 2);
      ATT_VWAIT(8, lb2, hb2);
#pragma unroll
      for (int d = 0; d < 4; ++d) o[d] = ATT_MF(__builtin_bit_cast(bf16x8, pw1), ATT_VF(lb2, hb2, d), o[d]);
      ATT_VRD8(lb2, hb2, 3);
      ATT_VWAIT(8, la, ha);
#pragma unroll
      for (int d = 0; d < 4; ++d) o[d] = ATT_MF(__builtin_bit_cast(bf16x8, pw2), ATT_VF(la, ha, d), o[d]);
      ATT_VWAIT(0, lb2, hb2);
#pragma unroll
      for (int d = 0; d < 4; ++d) o[d] = ATT_MF(__builtin_bit_cast(bf16x8, pw3), ATT_VF(lb2, hb2, d), o[d]);
    }
#undef ATT_DMA_K
#undef ATT_DMA_V
#undef ATT_DMA_K0
#undef ATT_DMA_K1
#undef ATT_DMA_V0
#undef ATT_DMA_V1
    LAS float* wsf = (LAS float*)(lds + WSF_OFF) + wid * 64;
    lsum += __shfl_xor(lsum, 32);
    if (hi == 0) wsf[r32] = lsum;
    asm volatile("s_waitcnt lgkmcnt(0)" ::: "memory");
    float rl[16];
#pragma unroll
    for (int r = 0; r < 16; ++r) rl[r] = __builtin_amdgcn_rcpf(wsf[crow(r, hi)]);
    LAS unsigned short* X = (LAS unsigned short*)(lds + X_OFF) + wq * 4096;
    if (c == 1) {
#pragma unroll
        for (int d = 0; d < 4; ++d)
#pragma unroll
            for (int r = 0; r < 16; ++r) X[(d * 16 + r) * 64 + lane] = (unsigned short)(cvtpk(o[d][r] * (rl[r] * P.lam), 0.f) & 0xffffu);
    }
    asm volatile("s_waitcnt lgkmcnt(0)\n\ts_barrier" ::: "memory");
    if (c == 0) {
        float rs[16];
#pragma unroll
        for (int r = 0; r < 16; ++r) {
            float ss = 0.f;
#pragma unroll
            for (int d = 0; d < 4; ++d) { const float v = o[d][r] * rl[r] - bf2f(X[(d * 16 + r) * 64 + lane]); o[d][r] = v; ss += v * v; }
            ss += __shfl_xor(ss, 1); ss += __shfl_xor(ss, 2); ss += __shfl_xor(ss, 4); ss += __shfl_xor(ss, 8); ss += __shfl_xor(ss, 16);
            rs[r] = __builtin_amdgcn_rsqf(ss * (1.f / 128.f) + EPS) * P.one_minus_li;
        }
        asm volatile("s_waitcnt lgkmcnt(0)" ::: "memory");
        LAS unsigned short* stg = X;
#pragma unroll
        for (int d = 0; d < 4; ++d) { const float g = P.subln[32 * d + r32];
#pragma unroll
            for (int r = 0; r < 16; ++r) stg[crow(r, hi) * 128 + 32 * d + r32] = (unsigned short)(cvtpk(o[d][r] * rs[r] * g, 0.f) & 0xffffu); }
        asm volatile("s_waitcnt lgkmcnt(0)" ::: "memory");
        bf16_t* Ow = P.O + (rowbase + q0w) * DM + h * 128;
#pragma unroll
        for (int i = 0; i < 8; ++i) { const int idx = i * 64 + lane, row = idx >> 4, ch = idx & 15;
            const u32x4 v = *(const LAS u32x4*)((const LAS unsigned char*)stg + row * 256 + ch * 16);
            *(u32x4*)(Ow + (size_t)row * DM + ch * 8) = v; }
    }
}

__device__ __forceinline__ void attn_phase(const Params& P, LAS unsigned char* lds) {
    const int G = gridDim.x, bx = blockIdx.x;
    build_lut(lds, P.rel_bias);
    __syncthreads();
    if (G == 256) {
        const int x = bx & 7, j = bx >> 3;
        for (int r = 0; r < 16; ++r) { const int bh = x * 16 + r; attn_unit(P, bh >> 3, bh & 7, (r & 1) ? 31 - j : j, lds); }
    } else {
        for (int i = 0;; ++i) { const int p = bx + G * i; if (p >= 2048) break; const int bh = p >> 4, s2 = p & 15;
            attn_unit(P, bh >> 3, bh & 7, 31 - s2, lds); attn_unit(P, bh >> 3, bh & 7, s2, lds); }
    }
    __syncthreads();
}
}

#define BF_LO(u) __builtin_bit_cast(float, (u) << 16)
#define BF_HI(u) __builtin_bit_cast(float, (u) & 0xffff0000u)
template <int MODE>
__device__ __forceinline__ void row_pass(const float* xin, float* xout, bf16_t* xb, float* rstd, const unsigned char* Y, const int* tok_slot, const float* tok_w, unsigned char* x8, LAS unsigned char* lds) {
    const int tid = opaque_tid(), lane = tid & 63, wid = tid >> 6;
    const int ypos = 256 * (lane >> 5) + 64 * ((lane & 31) >> 3) + 16 * (lane & 3) + 8 * (((lane & 31) >> 2) & 1);
    LAS int* sl = (LAS int*)lds; LAS float* wl = (LAS float*)(lds + 2048);
    for (int blk = blockIdx.x; blk < NTOK / 256; blk += gridDim.x) {
        if (MODE != 0) { sl[tid] = tok_slot[blk * 512 + tid]; wl[tid] = tok_w[blk * 512 + tid]; __syncthreads(); }
        for (int it = 0; it < 8; ++it) {
            const int r0 = it * 32 + wid * 4, m0 = blk * 256 + r0;
            float v[4][2][8];
            if (MODE == 0) {
#pragma unroll
                for (int rr = 0; rr < 4; ++rr) { const f32x4* xr = (const f32x4*)(xin + (size_t)(m0 + rr) * DM + 8 * lane);
#pragma unroll
                    for (int j = 0; j < 2; ++j) { const f32x4 a = xr[128 * j], b = xr[128 * j + 1];
#pragma unroll
                        for (int i = 0; i < 4; ++i) { v[rr][j][i] = a[i]; v[rr][j][4 + i] = b[i]; } } }
            } else {
                u32x4 xq[4][2]; u32x2 ya[4][2], yb[4][2]; float w0[4], w1[4];
#pragma unroll
                for (int rr = 0; rr < 4; ++rr) { const int s0 = sl[2 * (r0 + rr)], s1 = sl[2 * (r0 + rr) + 1]; w0[rr] = wl[2 * (r0 + rr)] * (1.f / Y8_SCALE); w1[rr] = wl[2 * (r0 + rr) + 1] * (1.f / Y8_SCALE);
                    const bf16_t* xr = xb + (size_t)(m0 + rr) * DM + 8 * lane;
                    const unsigned char* y0 = Y + (size_t)s0 * DM + ypos; const unsigned char* y1 = Y + (size_t)s1 * DM + ypos;
#pragma unroll
                    for (int j = 0; j < 2; ++j) { xq[rr][j] = *(const u32x4*)(xr + 512 * j); ya[rr][j] = *(const u32x2*)(y0 + 512 * j); yb[rr][j] = *(const u32x2*)(y1 + 512 * j); } }
#pragma unroll
                for (int rr = 0; rr < 4; ++rr)
#pragma unroll
                    for (int j = 0; j < 2; ++j) { const u32x4 x = xq[rr][j];
#pragma unroll
                        for (int q = 0; q < 2; ++q) { const unsigned xa = q ? x.z : x.x, xc = q ? x.w : x.y; const int yaq = (int)(q ? ya[rr][j].y : ya[rr][j].x), ybq = (int)(q ? yb[rr][j].y : yb[rr][j].x);
                            const f32x2 a0 = __builtin_amdgcn_cvt_pk_f32_fp8(yaq, false), a1 = __builtin_amdgcn_cvt_pk_f32_fp8(yaq, true);
                            const f32x2 b0 = __builtin_amdgcn_cvt_pk_f32_fp8(ybq, false), b1 = __builtin_amdgcn_cvt_pk_f32_fp8(ybq, true);
                            v[rr][j][4 * q + 0] = BF_LO(xa) + w0[rr] * a0.x + w1[rr] * b0.x;
                            v[rr][j][4 * q + 1] = BF_HI(xa) + w0[rr] * a0.y + w1[rr] * b0.y;
                            v[rr][j][4 * q + 2] = BF_LO(xc) + w0[rr] * a1.x + w1[rr] * b1.x;
                            v[rr][j][4 * q + 3] = BF_HI(xc) + w0[rr] * a1.y + w1[rr] * b1.y; } }
            }
            if (MODE == 2) {
#pragma unroll
                for (int rr = 0; rr < 4; ++rr) { f32x4* xo = (f32x4*)(xout + (size_t)(m0 + rr) * DM + 8 * lane);
#pragma unroll
                    for (int j = 0; j < 2; ++j) { xo[128 * j] = (f32x4){v[rr][j][0], v[rr][j][1], v[rr][j][2], v[rr][j][3]}; xo[128 * j + 1] = (f32x4){v[rr][j][4], v[rr][j][5], v[rr][j][6], v[rr][j][7]}; } }
            } else {
#pragma unroll
                for (int rr = 0; rr < 4; ++rr) {
                    float ss = 0.f;
                    bf16_t* o8 = xb + (size_t)(m0 + rr) * DM + 8 * lane;
#pragma unroll
                    for (int j = 0; j < 2; ++j) {
#pragma unroll
                        for (int i = 0; i < 8; i += 2) ss += v[rr][j][i] * v[rr][j][i] + v[rr][j][i + 1] * v[rr][j][i + 1];
                        u32x4 w; w.x = cvtpk(v[rr][j][0], v[rr][j][1]); w.y = cvtpk(v[rr][j][2], v[rr][j][3]); w.z = cvtpk(v[rr][j][4], v[rr][j][5]); w.w = cvtpk(v[rr][j][6], v[rr][j][7]);
                        *(u32x4*)(o8 + 512 * j) = w;
                        if (MODE == 1 && x8) {
                            int lo = cvt8(v[rr][j][0] * X8_SCALE, v[rr][j][1] * X8_SCALE, 0, false); lo = cvt8(v[rr][j][2] * X8_SCALE, v[rr][j][3] * X8_SCALE, lo, true);
                            int h8 = cvt8(v[rr][j][4] * X8_SCALE, v[rr][j][5] * X8_SCALE, 0, false); h8 = cvt8(v[rr][j][6] * X8_SCALE, v[rr][j][7] * X8_SCALE, h8, true);
                            *(u32x2*)(x8 + (size_t)(m0 + rr) * DM + 512 * j + ypos) = (u32x2){(unsigned)lo, (unsigned)h8}; } }
                    ss = wave_sum(ss);
                    if (lane == 0) rstd[m0 + rr] = __builtin_amdgcn_rsqf(ss * (1.f / DM) + EPS);
                }
            }
        }
        if (MODE != 0) __syncthreads();
    }
}

__device__ __forceinline__ void router_pass(const bf16_t* x, const bf16_t* wt, const float* wg  , const float* bg, const float* be,
                                            float* rstd_out, int* tok_e, float* tok_w, int* cnt, LAS unsigned char* lds) {
    const int tid = opaque_tid(), lane = tid & 63, wid = tid >> 6, r32 = lane & 31, hi = lane >> 5;
    LAS f32x4* wgl = (LAS f32x4*)lds;
    LAS int* cntl = (LAS int*)(lds + 16384);
    for (int i = tid; i < 1024; i += NTHREADS) wgl[i] = *(const f32x4*)(wg + 4 * i);
    for (int blk = blockIdx.x; blk < NTOK / 256; blk += gridDim.x) {
        if (tid < NEXP) cntl[tid] = 0;
        __syncthreads();
        const int tok = blk * 256 + wid * 32 + r32;
        const u32x4* xp = (const u32x4*)(x + (size_t)tok * DM + 8 * hi);
        const u32x4* wph = (const u32x4*)wt + lane; const u32x4* wpl = wph + 64 * 64;
        const LAS f32x4* gp_ = wgl + 8 * hi;
        f32x16 D;
#pragma unroll
        for (int r = 0; r < 16; ++r) D[r] = 0.f;
        float ss = 0.f; f32x4 gl = {0.f, 0.f, 0.f, 0.f};
#pragma unroll 4
        for (int s = 0; s < 64; ++s) {
            const u32x4 xq_ = xp[2 * s], wh = wph[64 * s], wl = wpl[64 * s];
            D = __builtin_amdgcn_mfma_f32_32x32x16_bf16(__builtin_bit_cast(bf16x8, wh), __builtin_bit_cast(bf16x8, xq_), D, 0, 0, 0);
            D = __builtin_amdgcn_mfma_f32_32x32x16_bf16(__builtin_bit_cast(bf16x8, wl), __builtin_bit_cast(bf16x8, xq_), D, 0, 0, 0);
            const float xa[8] = {BF_LO(xq_.x), BF_HI(xq_.x), BF_LO(xq_.y), BF_HI(xq_.y), BF_LO(xq_.z), BF_HI(xq_.z), BF_LO(xq_.w), BF_HI(xq_.w)};
#pragma unroll
            for (int j = 0; j < 8; ++j) { gl += gp_[16 * s + j] * xa[j]; ss += xa[j] * xa[j]; }
        }
        ss += __shfl_xor(ss, 32);
#pragma unroll
        for (int g = 0; g < 4; ++g) gl[g] += __shfl_xor(gl[g], 32);
        const float rs = __builtin_amdgcn_rsqf(ss * (1.f / DM) + EPS);
        float glg[4]; float gmax = -INFINITY; int gidx = 0;
#pragma unroll
        for (int g = 0; g < 4; ++g) { glg[g] = gl[g] * rs + bg[g]; if (glg[g] > gmax) { gmax = glg[g]; gidx = g; } }
        float gsum = 0.f;
#pragma unroll
        for (int g = 0; g < 4; ++g) gsum += __expf(glg[g] - gmax);
        const float gprob = 1.f / gsum;
        float own[4], oth[4], v[8];
#pragma unroll
        for (int i = 0; i < 4; ++i) { const float d = gidx == 0 ? D[i] : gidx == 1 ? D[4 + i] : gidx == 2 ? D[8 + i] : D[12 + i];
            own[i] = d * rs + be[8 * gidx + 4 * hi + i]; oth[i] = __shfl_xor(own[i], 32); }
#pragma unroll
        for (int i = 0; i < 4; ++i) { v[i] = hi ? oth[i] : own[i]; v[4 + i] = hi ? own[i] : oth[i]; }
        int i1 = 0; float v1 = v[0];
#pragma unroll
        for (int i = 1; i < 8; ++i) if (v[i] > v1) { v1 = v[i]; i1 = i; }
        int i2 = -1; float v2 = -INFINITY;
#pragma unroll
        for (int i = 0; i < 8; ++i) if (i != i1 && v[i] > v2) { v2 = v[i]; i2 = i; }
        const float w1 = gprob / (1.f + __expf(v2 - v1)), w2 = gprob - w1;
        if (hi == 0) {
            const int e1 = 8 * gidx + i1, e2 = 8 * gidx + i2;
            tok_e[2 * tok] = e1; tok_e[2 * tok + 1] = e2; tok_w[2 * tok] = w1; tok_w[2 * tok + 1] = w2; rstd_out[tok] = rs;
            atomicAdd((int*)&cntl[e1], 1); atomicAdd((int*)&cntl[e2], 1);
        }
        __syncthreads();
        if (tid < NEXP) cnt[blk * NEXP + tid] = cntl[tid];
        __syncthreads();
    }
}

__device__ __forceinline__ void assign_pass(const int* cnt, const int* tok_e, const float* rstd_ffn, int* tok_slot, int* slot_tok, float* slot_rs, LAS unsigned char* lds) {
    const int tid = opaque_tid(), lane = tid & 63, wid = tid >> 6;
    LAS int* pall = (LAS int*)lds;
    LAS int* plt = pall + 512;
    LAS int* total = plt + 512;
    LAS int* mybase = total + 32;
    LAS int* wcnt = mybase + 32;
    LAS int* ts = (LAS int*)(lds + TS_OFF);
    { const int e = tid & 31, p = tid >> 5; int a = 0;
      for (int b = 16 * p; b < 16 * p + 16; ++b) a += cnt[b * NEXP + e];
      pall[p * 32 + e] = a; }
    __syncthreads();
    if (tid < NEXP) { int a = 0; for (int p = 0; p < 16; ++p) a += pall[p * 32 + tid]; total[tid] = a; }
    __syncthreads();
    if (tid == 0) { int acc = 0; for (int e = 0; e < NEXP; ++e) { ts[e] = acc; acc += (total[e] + 255) >> 8; } ts[NEXP] = acc; }
    __syncthreads();
    for (int blk = blockIdx.x; blk < NTOK / 256; blk += gridDim.x) {
        { const int e = tid & 31, p = tid >> 5; int l = 0;
          for (int b = 16 * p; b < 16 * p + 16; ++b) { const int c = cnt[b * NEXP + e]; if (b < blk) l += c; }
          plt[p * 32 + e] = l; }
        int e0 = -1, e1 = -1, r0 = 0, r1 = 0; float rs = 0.f;
        if (tid < 256) { const int tok = blk * 256 + tid; e0 = tok_e[2 * tok]; e1 = tok_e[2 * tok + 1]; rs = rstd_ffn[tok]; }
        if (wid < 4) {
            const unsigned long long lt = (1ull << lane) - 1ull;
#pragma unroll 4
            for (int e = 0; e < NEXP; ++e) {
                const unsigned long long m = __ballot(e0 == e || e1 == e);
                const int r = __popcll(m & lt);
                if (e0 == e) r0 = r;
                if (e1 == e) r1 = r;
                if (lane == 0) wcnt[e * 4 + wid] = __popcll(m);
            }
        }
        __syncthreads();
        if (tid < NEXP) { int l = 0; for (int p = 0; p < 16; ++p) l += plt[p * 32 + tid]; mybase[tid] = l; }
        __syncthreads();
        if (tid < 256) {
            const int tok = blk * 256 + tid;
            int p0 = ts[e0] * 256 + mybase[e0] + r0, p1 = ts[e1] * 256 + mybase[e1] + r1;
            for (int w = 0; w < wid; ++w) { p0 += wcnt[e0 * 4 + w]; p1 += wcnt[e1 * 4 + w]; }
            tok_slot[2 * tok] = p0; tok_slot[2 * tok + 1] = p1;
            slot_tok[p0] = tok; slot_tok[p1] = tok; slot_rs[p0] = rs; slot_rs[p1] = rs;
        }
        if (blk == 0) {
            for (int e = 0; e < NEXP; ++e) for (int p = ts[e] * 256 + total[e] + tid; p < ts[e + 1] * 256; p += NTHREADS) { slot_tok[p] = 0; slot_rs[p] = 0.f; }
        }
        __syncthreads();
    }
}

__device__ __forceinline__ void pool_pass(const bf16_t* U, unsigned char* Pq) {
    const int tid = opaque_tid(), lane = tid & 63, wid = tid >> 6;
    for (int task = blockIdx.x * NWAVES + wid; task < (NTOK / 64) * 2; task += gridDim.x * NWAVES) {
        const int rb = task >> 1, half = task & 1, T0 = rb * 64, col = half * 512 + lane * 8, w = 2 << (half * 2 + (lane >> 5)), tp0 = T0 & (SEQ - 1);
        float S[8];
#pragma unroll
        for (int k = 0; k < 8; ++k) S[k] = 0.f;
#define PL_LD(dst, row) do { const u32x4 q_ = *(const u32x4*)(U + (size_t)(row) * DM + col); \
        dst[0] = __builtin_bit_cast(float, q_.x << 16); dst[1] = __builtin_bit_cast(float, q_.x & 0xffff0000u); dst[2] = __builtin_bit_cast(float, q_.y << 16); dst[3] = __builtin_bit_cast(float, q_.y & 0xffff0000u); \
        dst[4] = __builtin_bit_cast(float, q_.z << 16); dst[5] = __builtin_bit_cast(float, q_.z & 0xffff0000u); dst[6] = __builtin_bit_cast(float, q_.w << 16); dst[7] = __builtin_bit_cast(float, q_.w & 0xffff0000u); } while (0)
        for (int jj = 1; jj < 16; ++jj) if (jj < w && tp0 - jj >= 0) { float a[8]; PL_LD(a, T0 - jj);
#pragma unroll
            for (int k = 0; k < 8; ++k) S[k] += a[k]; }
#define PL_UNP(dst, q_) do { dst[0] = __builtin_bit_cast(float, q_.x << 16); dst[1] = __builtin_bit_cast(float, q_.x & 0xffff0000u); dst[2] = __builtin_bit_cast(float, q_.y << 16); dst[3] = __builtin_bit_cast(float, q_.y & 0xffff0000u); \
        dst[4] = __builtin_bit_cast(float, q_.z << 16); dst[5] = __builtin_bit_cast(float, q_.z & 0xffff0000u); dst[6] = __builtin_bit_cast(float, q_.w << 16); dst[7] = __builtin_bit_cast(float, q_.w & 0xffff0000u); } while (0)
        for (int i0 = 0; i0 < 64; i0 += 8) {
            u32x4 cq[8], aq[8];
#pragma unroll
            for (int i = 0; i < 8; ++i) { const int t = T0 + i0 + i, tp = tp0 + i0 + i;
                cq[i] = *(const u32x4*)(U + (size_t)t * DM + col);
                aq[i] = (tp - (w - 1) >= 0) ? *(const u32x4*)(U + (size_t)(t - (w - 1)) * DM + col) : (u32x4){0u, 0u, 0u, 0u}; }
#pragma unroll
            for (int i = 0; i < 8; ++i) { const int t = T0 + i0 + i, tp = tp0 + i0 + i; float c[8], a[8]; PL_UNP(c, cq[i]); PL_UNP(a, aq[i]);
                const int n = tp + 1 < w ? tp + 1 : w; const float inv = 1.f / (float)n;
                float o[8];
#pragma unroll
                for (int k = 0; k < 8; ++k) { S[k] += c[k]; o[k] = S[k] * inv - c[k]; S[k] -= a[k]; }
                int lo = cvt8(o[0] * A8_SCALE, o[1] * A8_SCALE, 0, false); lo = cvt8(o[2] * A8_SCALE, o[3] * A8_SCALE, lo, true);
                int hi = cvt8(o[4] * A8_SCALE, o[5] * A8_SCALE, 0, false); hi = cvt8(o[6] * A8_SCALE, o[7] * A8_SCALE, hi, true);
                *(u32x2*)(Pq + (size_t)t * DM + col) = (u32x2){(unsigned)lo, (unsigned)hi}; }
        }
#undef PL_UNP
#undef PL_LD
    }
}

constexpr int ARG_OFF = attn::WSF_OFF + NWAVES * 256;
static_assert(ARG_OFF + 27 * 8 <= LDS_BYTES, "LDS map (args)");
__device__ __forceinline__ const void* arg_ptr(LAS unsigned char* lds, int i) {
    const unsigned long long v = ((const LAS unsigned long long*)(lds + ARG_OFF))[i];
    const unsigned lo = __builtin_amdgcn_readfirstlane((unsigned)v), hi = __builtin_amdgcn_readfirstlane((unsigned)(v >> 32));
    return (const void*)(const __attribute__((address_space(1))) char*)(((unsigned long long)hi << 32) | lo);
}
#define INP(i) ((const float*)arg_ptr(lds, (i)))
#define OUTP() ((float*)arg_ptr(lds, 25))
#define WSP() ((unsigned char*)arg_ptr(lds, 26))


__device__ __forceinline__ size_t wt_image_off(int n, int k, int Kd) {
    const int pn = n >> 8, nr = n & 255, wc = nr >> 6, bj = (nr >> 5) & 1, x = nr & 31, rho = 16 * ((x >> 2) & 1) + 4 * (x >> 3) + (x & 3);
    const int kt = k >> 6, kk = k & 63;
    return ((size_t)((pn * (Kd >> 6) + kt) * 2 + bj) * 16384 + pg8::lds_byte(wc * 32 + rho, kk)) >> 1;
}
__device__ __forceinline__ size_t wt_image_off8(int n, int k, int Kd) {
    const int pn = n >> 8, nr = n & 255, wc = nr >> 6, bj = (nr >> 5) & 1, x = nr & 31, rho = 16 * ((x >> 2) & 1) + 4 * (x >> 3) + (x & 3);
    const int kt = k >> 7, kb = k & 127;
    return (size_t)((pn * (Kd >> 7) + kt) * 2 + bj) * 16384 + pg8::lds_byte(wc * 32 + rho, kb >> 1);
}
struct TrDesc { const float* W; const float* gain; bf16_t* WT; int N, k0, n0, Kd, drow0; int f8; float f8s; };
__device__ __forceinline__ void tr_load(const TrDesc& d, f32x4 (&v)[8], float (&g)[8], int lane) {
    const int kr = lane >> 3, n4 = (lane & 7) * 4;
#pragma unroll
    for (int i = 0; i < 8; ++i) { v[i] = *(const f32x4*)(d.W + (size_t)(d.k0 + 8 * i + kr) * d.N + d.n0 + n4); g[i] = d.gain ? d.gain[d.k0 + 8 * i + kr] : 1.f; }
}
__device__ __forceinline__ void tr_finish(const TrDesc& d, const f32x4 (&v)[8], const float (&g)[8], LAS float* scr, int lane) {
    const int kr = lane >> 3, n4 = (lane & 7) * 4;
#pragma unroll
    for (int i = 0; i < 8; ++i) { LAS float* q = scr + (8 * i + kr) * 33 + n4; q[0] = v[i][0] * g[i]; q[1] = v[i][1] * g[i]; q[2] = v[i][2] * g[i]; q[3] = v[i][3] * g[i]; }
    asm volatile("s_waitcnt lgkmcnt(0)" ::: "memory");
    if (d.f8) {
#pragma unroll
        for (int j = 0; j < 2; ++j) { const int pc = lane * 2 + j, n = pc >> 2, kg = pc & 3; const float fs = d.f8s;
            u32x4 o;
#pragma unroll
            for (int q = 0; q < 4; ++q) { const int kb = d.f8 == 2 ? (q >> 1) * 32 + 8 * kg + 4 * (q & 1) : 16 * kg + 4 * q; const LAS float* t = scr + kb * 33 + n;
                int r = cvt8(t[0] * fs, t[33] * fs, 0, false);
                r = cvt8(t[66] * fs, t[99] * fs, r, true); o[q] = (unsigned)r; }
            *(u32x4*)((unsigned char*)d.WT + wt_image_off8(d.drow0 + n, d.k0 + 16 * kg, d.Kd)) = o; }
        asm volatile("s_waitcnt lgkmcnt(0)" ::: "memory");
        return;
    }
    const int c = lane & 7;
#pragma unroll
    for (int j = 0; j < 4; ++j) { const int n = (lane >> 3) + 8 * j; const LAS float* t = scr + (8 * c) * 33 + n;
        u32x4 o; o.x = cvtpk(t[0 * 33], t[1 * 33]); o.y = cvtpk(t[2 * 33], t[3 * 33]); o.z = cvtpk(t[4 * 33], t[5 * 33]); o.w = cvtpk(t[6 * 33], t[7 * 33]);
        *(u32x4*)(d.WT + wt_image_off(d.drow0 + n, d.k0 + 8 * c, d.Kd)) = o; }
    asm volatile("s_waitcnt lgkmcnt(0)" ::: "memory");
}
struct Args { const float* in[25]; float* out; unsigned char* ws; };
enum { I_X = 0, I_RELB, I_ANORM, I_WQKV, I_QG, I_KG, I_LQ1, I_LK1, I_LQ2, I_LK2, I_SUBLN, I_WO, I_PNORM, I_PWIN, I_PWG, I_PWOUT, I_PSCALE, I_FNORM, I_RGW, I_RGB, I_REW, I_REB, I_WGATE, I_WUP, I_WDOWN };

__device__ __forceinline__ TrDesc tr_decode(LAS unsigned char* lds, unsigned char* ws, int it) {
    constexpr int N_QKV = 2 * 16 * 96;
    TrDesc d; d.f8 = 0; d.f8s = 1.f;
    if (it < N_QKV) { const int l = it / 1536, r = it - l * 1536, kb = r / 96, nb = r - kb * 96;
        d.W = INP(I_WQKV) + (size_t)l * 1024 * 3072; d.N = 3072; d.k0 = 64 * kb; d.n0 = 32 * nb; d.WT = (bf16_t*)(ws + WS_WQKV) + (size_t)l * 3072 * 1024; d.Kd = 1024; d.drow0 = 32 * nb; d.gain = INP(I_ANORM) + l * 1024; return d; }
    it -= N_QKV;
    { const int l = it >> 9, r = it & 511, kb = r >> 5, nb = r & 31;
      d.W = INP(I_WO) + (size_t)l * 1024 * 1024; d.N = 1024; d.k0 = 64 * kb; d.n0 = 32 * nb; d.WT = (bf16_t*)(ws + WS_WO) + (size_t)l * 1024 * 1024; d.Kd = 1024; d.drow0 = 32 * nb; d.gain = nullptr; }
    return d;
}
__device__ __forceinline__ void w8_items(LAS unsigned char* lds, unsigned char* ws, int lane, int wid) {
    constexpr int S_GU = 128 * 2 * 8 * 2, S_DN = 128 * 4 * 4, S_PO = 2 * 8 * 4;
    for (int S0 = blockIdx.x; S0 < S_GU + S_DN + S_PO; S0 += gridDim.x) {
        const int S = __builtin_amdgcn_readfirstlane(S0);
        const float* W; const float* gain; unsigned char* WT; int N, k0, n, Kd, drow; bool perm; float fs;
        if (S < S_GU) { const int le = S >> 5, r = S & 31, isup = r >> 4, kt = (r >> 1) & 7, nh = r & 1;
            W = (isup ? INP(I_WUP) : INP(I_WGATE)) + (size_t)le * 1024 * 512; N = 512; k0 = 128 * kt; n = 256 * nh + 4 * lane; WT = ws + WS_WGU + (size_t)le * 1024 * 1024; Kd = 1024;
            drow = 256 * (n >> 7) + 64 * ((n >> 5) & 3) + 32 * isup + (n & 31); gain = INP(I_FNORM) + (le >> 5) * 1024; perm = true; fs = WG8_SCALE; }
        else if (S < S_GU + S_DN) { const int i2 = S - S_GU, le = i2 >> 4, r = i2 & 15, kt = r >> 2, nq = r & 3;
            W = INP(I_WDOWN) + (size_t)le * 512 * 1024; N = 1024; k0 = 128 * kt; n = 256 * nq + 4 * lane; WT = ws + WS_WDN + (size_t)le * 1024 * 512; Kd = 512; drow = n; gain = nullptr; perm = false; fs = WD8_SCALE; }
        else { const int i3 = S - S_GU - S_DN, l = i3 >> 5, r = i3 & 31, kt = r >> 2, nq = r & 3;
            W = INP(I_PWOUT) + (size_t)l * 1024 * 1024; N = 1024; k0 = 128 * kt; n = 256 * nq + 4 * lane; WT = ws + WS_WPO + (size_t)l * 1024 * 1024; Kd = 1024; drow = n; gain = nullptr; perm = false; fs = WN8_SCALE; }
        const int r0 = perm ? 64 * (wid >> 2) + 8 * (wid & 3) : 16 * wid, r1 = perm ? r0 + 32 : r0 + 8;
        const float* gp = gain ? gain : W;
        f32x4 v[16]; float g[16];
#pragma unroll
        for (int j = 0; j < 8; ++j) { v[j] = *(const f32x4*)(W + (size_t)(k0 + r0 + j) * N + n); v[8 + j] = *(const f32x4*)(W + (size_t)(k0 + r1 + j) * N + n);
            g[j] = gp[k0 + r0 + j]; g[8 + j] = gp[k0 + r1 + j]; }
#pragma unroll
        for (int j = 0; j < 16; ++j) g[j] = gain ? g[j] * fs : fs;
#pragma unroll
        for (int c = 0; c < 4; ++c) {
            u32x4 o;
#pragma unroll
            for (int q = 0; q < 4; ++q) { int r = cvt8(v[4 * q][c] * g[4 * q], v[4 * q + 1][c] * g[4 * q + 1], 0, false); r = cvt8(v[4 * q + 2][c] * g[4 * q + 2], v[4 * q + 3][c] * g[4 * q + 3], r, true); o[q] = (unsigned)r; }
            *(u32x4*)(WT + wt_image_off8(drow + c, k0 + 16 * wid, Kd)) = o;
        }
    }
}
__device__ __forceinline__ void prologue(LAS unsigned char* lds) {
    const int tid = opaque_tid(), lane = tid & 63, wid = tid >> 6;
    LAS float* scr = (LAS float*)(lds + wid * 16384);
    const int gw = blockIdx.x * NWAVES + wid, NGW = gridDim.x * NWAVES;
    unsigned char* ws = WSP();
    constexpr int N_QKV = 2 * 16 * 96, N_WO = 2 * 16 * 32, N_PC = 2 * 64 * 16;
    constexpr int NTR = N_QKV + N_WO;
    w8_items(lds, ws, lane, __builtin_amdgcn_readfirstlane(wid));
    if (gw < NTR) {
        TrDesc dA = tr_decode(lds, ws, gw), dB; f32x4 va[8], vb[8]; float ga[8], gb[8];
        tr_load(dA, va, ga, lane);
        for (int itA = gw;;) {
            const int itB = itA + NGW; const bool hasB = itB < NTR;
            if (hasB) { dB = tr_decode(lds, ws, itB); tr_load(dB, vb, gb, lane); }
            tr_finish(dA, va, ga, scr, lane);
            if (!hasB) break;
            itA = itB + NGW; const bool hasA = itA < NTR;
            if (hasA) { dA = tr_decode(lds, ws, itA); tr_load(dA, va, ga, lane); }
            tr_finish(dB, vb, gb, scr, lane);
            if (!hasA) break;
        }
    }
    for (int it = gw; it < N_PC; it += NGW) {
        {
            const int l = it >> 10, r = it & 1023, kt = r >> 7, p = (r >> 4) & 7, kb0 = 128 * kt + 64 * (p >> 2) + 8 * (p & 3), n0 = (r & 15) * 64, g = n0 >> 8, e = (n0 & 255) + lane;
            const float* win = INP(I_PWIN) + (size_t)l * 1024 * 1024 + g * 256;
            const float* wgp = INP(I_PWG) + (size_t)l * 4 * 256 * 256 + (size_t)g * 256 * 256 + e;
            float acc[16];
#pragma unroll
            for (int kk = 0; kk < 16; ++kk) acc[kk] = 0.f;
            {
                f32x4 wv[16];
#pragma unroll
                for (int kk = 0; kk < 16; ++kk) wv[kk] = *(const f32x4*)(win + (size_t)(kb0 + (kk & 7) + 32 * (kk >> 3)) * 1024 + 4 * lane);
#pragma unroll
                for (int kk = 0; kk < 16; ++kk) *(LAS f32x4*)(scr + kk * 256 + 4 * lane) = wv[kk];
                asm volatile("s_waitcnt lgkmcnt(0)" ::: "memory"); }
#pragma unroll 8
            for (int c4 = 0; c4 < 64; ++c4) {
                float b[4];
#pragma unroll
                for (int cc = 0; cc < 4; ++cc) b[cc] = wgp[(size_t)(4 * c4 + cc) * 256];
#pragma unroll
                for (int kk = 0; kk < 16; ++kk) { const f32x4 av = *(const LAS f32x4*)(scr + kk * 256 + 4 * c4); acc[kk] += (av[0] * b[0] + av[1] * b[1]) + (av[2] * b[2] + av[3] * b[3]); }
            }
            const float* pn = INP(I_PNORM) + l * 1024 + kb0;
            u32x4 o;
#pragma unroll
            for (int q = 0; q < 4; ++q) { const int j0 = 4 * q, kq = (j0 & 7) + 32 * (j0 >> 3);
                int rr = cvt8(acc[j0] * pn[kq] * WPC8_SCALE, acc[j0 + 1] * pn[kq + 1] * WPC8_SCALE, 0, false);
                rr = cvt8(acc[j0 + 2] * pn[kq + 2] * WPC8_SCALE, acc[j0 + 3] * pn[kq + 3] * WPC8_SCALE, rr, true); o[q] = (unsigned)rr; }
            *(u32x4*)(ws + WS_WPC + (size_t)l * 1024 * 1024 + wt_image_off8(n0 + lane, 128 * kt + 16 * p, 1024)) = o;
            asm volatile("s_waitcnt lgkmcnt(0)" ::: "memory");
        }
    }
    float* rwt = (float*)(ws + WS_RWT); float* rwg = (float*)(ws + WS_RWG);
    { bf16_t* rwb = (bf16_t*)rwt;
      for (int i = blockIdx.x * NTHREADS + tid; i < DEPTH * NEXP * DM; i += gridDim.x * NTHREADS) { const int l = i >> 15, r = i & 32767, sx = r >> 9, ln = (r >> 3) & 63, jj = r & 7, k = 16 * sx + 8 * (ln >> 5) + jj, e = ln & 31;
        const float v = INP(I_FNORM)[l * 1024 + k] * INP(I_REW)[(size_t)l * 1024 * 32 + k * 32 + e];
        const unsigned hb = cvtpk(v, 0.f) & 0xffffu; const float vh = __builtin_bit_cast(float, hb << 16);
        rwb[(size_t)l * 65536 + r] = (bf16_t)hb; rwb[(size_t)l * 65536 + 32768 + r] = (bf16_t)(cvtpk(v - vh, 0.f) & 0xffffu); } }
    for (int i = blockIdx.x * NTHREADS + tid; i < DEPTH * DM * NGRP; i += gridDim.x * NTHREADS) { const int l = i >> 12, k = (i >> 2) & 1023;
        rwg[i] = INP(I_FNORM)[l * 1024 + k] * INP(I_RGW)[i]; }
}

__device__ __forceinline__ void moe_layer(LAS unsigned char* lds, const XcdBarrier& bar, const int L, const bool fin) {
    const LAS int* ts = (const LAS int*)(lds + TS_OFF);
    {   unsigned char* ws = WSP();
        router_pass((const bf16_t*)(ws + WS_XB), (const bf16_t*)(ws + WS_RWT) + (size_t)L * 65536, (const float*)(ws + WS_RWG) + (size_t)L * DM * NGRP, INP(I_RGB) + L * NGRP, INP(I_REB) + L * NEXP,
                    (float*)(ws + WS_RSFFN), (int*)(ws + WS_TOKE), (float*)(ws + WS_TOKW), (int*)(ws + WS_CNT), lds); }
    xcd_barrier(bar);
    {   unsigned char* ws = WSP();
        assign_pass((const int*)(ws + WS_CNT), (const int*)(ws + WS_TOKE), (const float*)(ws + WS_RSFFN), (int*)(ws + WS_TOKS), (int*)(ws + WS_SLOTTOK), (float*)(ws + WS_SLOTRS), lds); }
    xcd_barrier(bar);
    {   unsigned char* ws = WSP();
        GroupSched S; S.init_grid(); S.A = (const char*)(ws + WS_ACT + ACT_X8); S.lda = DM; S.slot_tok = (const int*)(ws + WS_SLOTTOK); S.Bt = (const char*)(ws + WS_WGU) + (size_t)L * NEXP * 1024 * 1024; S.strideE = (size_t)1024 * 1024; S.K = DM / 2; S.ts = ts;
        EpiGateUp E{ws + WS_ACT + ACT_H, (const float*)(ws + WS_SLOTRS)};
        int kx = DM; asm volatile("" : "+s"(kx));
        pg8::gemm_phase<EpiGateUp, GroupSched, true, true>(lds, kx, S, E); }
    xcd_barrier(bar);
    {   unsigned char* ws = WSP();
        GroupSched S; S.init_grid(); S.A = (const char*)(ws + WS_ACT + ACT_H); S.lda = EFF; S.slot_tok = nullptr; S.Bt = (const char*)(ws + WS_WDN) + (size_t)L * NEXP * 1024 * 512; S.strideE = (size_t)1024 * 512; S.K = EFF / 2; S.ts = ts;
        EpiY8 E{ws + WS_ACT + ACT_Y};
        int kx = EFF; asm volatile("" : "+s"(kx));
        pg8::gemm_phase<EpiY8, GroupSched, true, true>(lds, kx, S, E); }
    xcd_barrier(bar);
    {   unsigned char* ws = WSP(); float* xo = OUTP();
        if (fin) row_pass<2>(nullptr, xo, (bf16_t*)(ws + WS_XB), nullptr, (const unsigned char*)(ws + WS_ACT + ACT_Y), (const int*)(ws + WS_TOKS), (const float*)(ws + WS_TOKW), nullptr, lds);
        else { row_pass<1>(nullptr, nullptr, (bf16_t*)(ws + WS_XB), (float*)(ws + WS_RSMIX), (const unsigned char*)(ws + WS_ACT + ACT_Y), (const int*)(ws + WS_TOKS), (const float*)(ws + WS_TOKW), (L & 1) ? nullptr : ws + WS_ACT + ACT_X8, lds); } }
    if (!fin) xcd_barrier(bar);
}

__global__ void __launch_bounds__(NTHREADS, 2) hybrid_fwd(Args a) {
    extern __shared__ __attribute__((aligned(16))) unsigned char lds_raw[];
    LAS unsigned char* lds = (LAS unsigned char*)lds_raw;
    volatile LAS unsigned* MISC = (volatile LAS unsigned*)(lds + MISC_OFF);
    const int tid = threadIdx.x;
    if (tid < 64) MISC[tid] = 0u;
    if (tid < 27) ((LAS unsigned long long*)(lds + ARG_OFF))[tid] = ((const __attribute__((address_space(4))) unsigned long long*)__builtin_amdgcn_kernarg_segment_ptr())[tid];
    __syncthreads();
    XcdBarrier bar = xcd_barrier_post((unsigned*)(a.ws + WS_CTL) + CW_BAR, MISC + 8);

    prologue(lds);
    {   unsigned char* ws = WSP();
        row_pass<0>(INP(I_X), nullptr, (bf16_t*)(ws + WS_XB), (float*)(ws + WS_RSMIX), nullptr, nullptr, nullptr, nullptr, lds); }
    xcd_barrier(bar);

    for (int lp = 0; lp < 2; ++lp) {
        {   unsigned char* ws = WSP();
            PlainSched S; S.init_grid(); S.A = (const char*)(ws + WS_XB); S.lda = DM * 2; S.Bt = (const char*)(ws + WS_WQKV) + (size_t)lp * 3072 * 1024 * 2; S.K = DM; S.nN = 12; S.nrt = NTOK / 256;
            LAS float* gl = (LAS float*)(lds + attn::WSF_OFF);
            { const int t_ = opaque_tid(); if (t_ < 128) gl[t_] = t_ < 64 ? INP(I_QG)[lp * HD + t_] : INP(I_KG)[lp * HD + t_ - 64]; }
            __syncthreads();
            EpiQKV E{(bf16_t*)(ws + WS_ACT + ACT_Q), (const float*)(ws + WS_RSMIX), gl};
            pg8::gemm_phase<EpiQKV, PlainSched, true>(lds, DM, S, E); }
        xcd_barrier(bar);
        {   unsigned char* ws = WSP();
            const float* lq1 = INP(I_LQ1) + lp * HD; const float* lk1 = INP(I_LK1) + lp * HD; const float* lq2 = INP(I_LQ2) + lp * HD; const float* lk2 = INP(I_LK2) + lp * HD;
            float d1 = 0.f, d2 = 0.f;
            for (int i = 0; i < HD; ++i) { d1 += lq1[i] * lk1[i]; d2 += lq2[i] * lk2[i]; }
            const float li = 0.8f - 0.6f * expf(-0.3f * (float)(2 * lp));
            bf16_t* Qb = (bf16_t*)(ws + WS_ACT + ACT_Q);
            attn::Params P{Qb, Qb + (size_t)NTOK * DM, Qb + (size_t)2 * NTOK * DM, Qb, INP(I_RELB), INP(I_SUBLN) + lp * 128, expf(d1) - expf(d2) + li, 1.f - li};
            attn::attn_phase(P, lds); }
        xcd_barrier(bar);
        {   unsigned char* ws = WSP(); float* xo = OUTP();
            PlainSched S; S.init_grid(); S.A = (const char*)(ws + WS_ACT + ACT_Q); S.lda = DM * 2; S.Bt = (const char*)(ws + WS_WO) + (size_t)lp * 1024 * 1024 * 2; S.K = DM; S.nN = 4; S.nrt = NTOK / 256;
            EpiRes E{(bf16_t*)(ws + WS_XB), nullptr, ws + WS_ACT + ACT_X8, 1.f};
            pg8::gemm_phase<EpiRes, PlainSched, true>(lds, DM, S, E); }
        xcd_barrier(bar);
        moe_layer(lds, bar, 2 * lp, false);
        {   unsigned char* ws = WSP();
            PlainSched S; S.init_grid(); S.A = (const char*)(ws + WS_ACT + ACT_X8); S.lda = DM; S.Bt = (const char*)(ws + WS_WPC) + (size_t)lp * 1024 * 1024; S.K = DM / 2; S.nN = 4; S.nrt = NTOK / 256;
            EpiBf16 E{(bf16_t*)(ws + WS_ACT + ACT_U), DM, (const float*)(ws + WS_RSMIX), 1.f / (X8_SCALE * WPC8_SCALE)};
            int kx = DM; asm volatile("" : "+s"(kx));
            pg8::gemm_phase<EpiBf16, PlainSched, true, true>(lds, kx, S, E); }
        xcd_barrier(bar);
        {   unsigned char* ws = WSP(); pool_pass((const bf16_t*)(ws + WS_ACT + ACT_U), ws + WS_ACT + ACT_P); }
        xcd_barrier(bar);
        {   unsigned char* ws = WSP(); float* xo = OUTP();
            PlainSched S; S.init_grid(); S.A = (const char*)(ws + WS_ACT + ACT_P); S.lda = DM; S.Bt = (const char*)(ws + WS_WPO) + (size_t)lp * 1024 * 1024; S.K = DM / 2; S.nN = 4; S.nrt = NTOK / 256;
            EpiRes E{(bf16_t*)(ws + WS_XB), INP(I_PSCALE) + lp * DM, ws + WS_ACT + ACT_X8, 1.f / (A8_SCALE * WN8_SCALE)};
            int kx = DM; asm volatile("" : "+s"(kx));
            pg8::gemm_phase<EpiRes, PlainSched, true, true>(lds, kx, S, E); }
        xcd_barrier(bar);
        moe_layer(lds, bar, 2 * lp + 1, lp == 1);
    }
}

extern "C" void kernel_launch(void* const* d_in, const int* in_sizes, int n_in, void* d_out, int out_size, void* d_ws, size_t ws_size, hipStream_t stream) {
    static int grid = 0;
    if (grid == 0) {
        if (n_in != 25 || out_size != NTOK * DM || ws_size < WS_END) { fprintf(stderr, "kernel_launch: unexpected problem (n_in %d, out %d, ws %zu)\n", n_in, out_size, ws_size); grid = -1; return; }
        int dev = 0, cus = 0;
        if (hipGetDevice(&dev) != hipSuccess || hipDeviceGetAttribute(&cus, hipDeviceAttributeMultiprocessorCount, dev) != hipSuccess) { grid = -1; return; }
        if (hipFuncSetAttribute((const void*)hybrid_fwd, hipFuncAttributeMaxDynamicSharedMemorySize, LDS_BYTES) != hipSuccess) { fprintf(stderr, "kernel_launch: hipFuncSetAttribute failed\n"); grid = -1; return; }
        int per_cu = 0;
        if (hipOccupancyMaxActiveBlocksPerMultiprocessor(&per_cu, (const void*)hybrid_fwd, NTHREADS, LDS_BYTES) != hipSuccess || per_cu < 1) fprintf(stderr, "kernel_launch: occupancy query says %d\n", per_cu);
        (void)hipGetLastError();
        grid = cus > 256 ? 256 : cus;
    }
    if (grid < 0) return;
    (void)hipMemsetAsync((char*)d_ws + WS_CTL, 0, CTL_ZERO_BYTES, stream);
    Args a{};
    for (int i = 0; i < 25; ++i) a.in[i] = (const float*)d_in[i];
    a.out = (float*)d_out; a.ws = (unsigned char*)d_ws;
    hipLaunchKernelGGL(hybrid_fwd, dim3(grid), dim3(NTHREADS), LDS_BYTES, stream, a);
}
```

```cpp
#include <hip/hip_runtime.h>
#include <cstdio>
#include <cstdint>

#define GAS __attribute__((address_space(1)))
#define LAS __attribute__((address_space(3)))
typedef unsigned short bf16_t;
typedef short bf16x8 __attribute__((ext_vector_type(8)));
typedef short s16x4 __attribute__((ext_vector_type(4)));
typedef float f32x2 __attribute__((ext_vector_type(2)));
typedef float f32x4 __attribute__((ext_vector_type(4)));
typedef float f32x16 __attribute__((ext_vector_type(16)));
typedef unsigned u32x2 __attribute__((ext_vector_type(2)));
typedef unsigned u32x4 __attribute__((ext_vector_type(4)));
typedef int i32x8 __attribute__((ext_vector_type(8)));
typedef __bf16 bf16x2_t __attribute__((ext_vector_type(2)));

constexpr int NB = 16, SEQ = 4096, DM = 1024, NTOK = NB * SEQ, DEPTH = 4;
constexpr int NHEAD = 8, HD = 64;
constexpr int NEXP = 32, EPG = 8, NGRP = 4, EFF = 512;
constexpr int MAXSLOT = 139264;
constexpr float EPS = 1e-6f;
constexpr float LOG2E = 1.4426950408889634f;
constexpr int NWAVES = 8, NTHREADS = 512;

constexpr size_t MiB = 1u << 20;
constexpr size_t WS_CTL = 0, CTL_ZERO_BYTES = 1 * MiB;
constexpr size_t WS_RSMIX = 4 * MiB;
constexpr size_t WS_RSFFN = WS_RSMIX + 256 * 1024;
constexpr size_t WS_TOKE = WS_RSFFN + 256 * 1024;
constexpr size_t WS_TOKW = WS_TOKE + 512 * 1024;
constexpr size_t WS_TOKS = WS_TOKW + 512 * 1024;
constexpr size_t WS_SLOTTOK = WS_TOKS + 512 * 1024;
constexpr size_t WS_SLOTRS = WS_SLOTTOK + 576 * 1024;
constexpr size_t WS_CNT = WS_SLOTRS + 576 * 1024;
constexpr size_t WS_RWT = WS_CNT + 64 * 1024;
constexpr size_t WS_RWG = WS_RWT + 512 * 1024;
constexpr size_t WS_SMALL_END = WS_RWG + 64 * 1024;
static_assert(WS_SMALL_END <= 16 * MiB, "small arrays");
constexpr size_t WS_WQKV = 16 * MiB;
constexpr size_t WS_WO = WS_WQKV + 12 * MiB;
constexpr size_t WS_WPC = WS_WO + 4 * MiB;
constexpr size_t WS_WPO = WS_WPC + 4 * MiB;
constexpr size_t WS_WGU = WS_WPO + 4 * MiB;
constexpr size_t WS_WDN = WS_WGU + 256 * MiB;
constexpr size_t WS_XB = WS_WDN + 128 * MiB;
constexpr size_t WS_ACT = WS_XB + 128 * MiB;
constexpr size_t WS_END = WS_ACT + 408 * MiB;
static_assert(WS_END <= 1126807104ull, "d_ws map exceeds the guaranteed workspace");
constexpr float A8_SCALE = 8.f, WN8_SCALE = 64.f;
constexpr size_t ACT_Q = 0, ACT_K = 128 * MiB, ACT_V = 256 * MiB;
constexpr size_t ACT_U = 0, ACT_P = 128 * MiB;
constexpr size_t ACT_H = 0, ACT_Y = 136 * MiB, ACT_X8 = 288 * MiB;
constexpr int CW_BAR = 4096;
constexpr int CW_TILES = 16384;

constexpr int RING_BYTES = 131072;
constexpr int LUT_OFF = RING_BYTES;
constexpr int LUT_N = 336;
constexpr int MISC_OFF = LUT_OFF + NHEAD * LUT_N * 4;
constexpr int TS_OFF = MISC_OFF + 256;
constexpr int LDS_BYTES = 147456;
static_assert(TS_OFF + 256 <= LDS_BYTES, "LDS map");

#define RLX_AGENT __ATOMIC_RELAXED, __HIP_MEMORY_SCOPE_AGENT
__device__ __forceinline__ unsigned cvtpk(float lo, float hi) { f32x2 v = {lo, hi}; bf16x2_t b = __builtin_convertvector(v, bf16x2_t); return __builtin_bit_cast(unsigned, b); }
__device__ __forceinline__ float bf2f(unsigned short h) { return __builtin_bit_cast(float, (unsigned)h << 16); }
__device__ __forceinline__ float wave_sum(float v) {
#pragma unroll
    for (int o = 1; o < 64; o <<= 1) v += __shfl_xor(v, o);
    return v;
}

__device__ __forceinline__ int opaque_tid() { int t = threadIdx.x; asm volatile("" : "+v"(t)); return t; }

#define XB_TMO      128
#define XB_XCNT(j)  (256  + 64 * (j))
#define XB_XSUB(j)  (1280 + 64 * (j))
#define XB_XGEN(j)  (2304 + 64 * (j))
#define XB_TOP      3328
#define XB_TOPGEN   3392
#define XCD_BAR_WORDS 3456
#define XB_SPIN_CAP (1u << 18)
__device__ __forceinline__ unsigned xb_ld(unsigned* p)              { return __hip_atomic_load(p, __ATOMIC_RELAXED, __HIP_MEMORY_SCOPE_AGENT); }
__device__ __forceinline__ unsigned xb_add(unsigned* p, unsigned v) { return __hip_atomic_fetch_add(p, v, __ATOMIC_RELAXED, __HIP_MEMORY_SCOPE_AGENT); }
__device__ __forceinline__ unsigned xb_xcc_id() { return (unsigned)__builtin_amdgcn_s_getreg((3 << 11) | 20) & 0xFu; }
#define XB_SPIN(cond, bar) do { unsigned _sp = 0; while (cond) { __builtin_amdgcn_s_sleep(1); \
    if ((++_sp & 255u) == 0u) { if (xb_ld(&(bar)[XB_TMO])) break; if (_sp > XB_SPIN_CAP) { atomicAdd(&(bar)[XB_TMO], 1u); break; } } } } while (0)
struct XcdBarrier { unsigned* bar; unsigned x; volatile LAS unsigned* st; };
__device__ __forceinline__ XcdBarrier xcd_barrier_post(unsigned* bar, volatile LAS unsigned* st) {
    XcdBarrier b; b.bar = bar; b.x = xb_xcc_id(); b.st = st;
    if (threadIdx.x == 0) (void)xb_add(&bar[XB_XCNT(b.x)], 1u);
    return b;
}
__device__ __forceinline__ void xcd_barrier_complete(unsigned* bar, unsigned x, unsigned& nloc, unsigned& nx) {
    const unsigned G = gridDim.x * gridDim.y * gridDim.z;
    unsigned sum, cnt, mine, sp = 0u;
    for (;;) {
        sum = 0u; cnt = 0u; mine = 0u;
#pragma unroll
        for (unsigned j = 0; j < 16; ++j) { const unsigned c = xb_ld(&bar[XB_XCNT(j)]); sum += c; cnt += (c > 0u) ? 1u : 0u; mine = (j == x) ? c : mine; }
        if (sum == G) break;
        __builtin_amdgcn_s_sleep(1);
        if ((++sp & 255u) == 0u) { if (xb_ld(&bar[XB_TMO])) break; if (sp > XB_SPIN_CAP) { atomicAdd(&bar[XB_TMO], 1u); break; } }
    }
    nloc = mine > 0u ? mine : 1u; nx = cnt > 0u ? cnt : 1u;
}
__device__ __forceinline__ void xcd_barrier(const XcdBarrier& b) {
    asm volatile("s_waitcnt vmcnt(0)" ::: "memory");
    __syncthreads();
    if (threadIdx.x == 0) {
        unsigned* bar = b.bar;
        __builtin_amdgcn_s_waitcnt(0);
        unsigned nloc = b.st[0], nx = b.st[1];
        if (nloc == 0u) { xcd_barrier_complete(bar, b.x, nloc, nx); b.st[0] = nloc; b.st[1] = nx; }
        const unsigned old = xb_add(&bar[XB_XSUB(b.x)], 1u);
        const unsigned gen = old / nloc;
        if (old + 1u == (gen + 1u) * nloc) {
            __builtin_amdgcn_fence(__ATOMIC_RELEASE, "agent");
            asm volatile("s_waitcnt vmcnt(0)" ::: "memory");
            const unsigned og = xb_add(&bar[XB_TOP], 1u);
            const unsigned tg = og / nx;
            if (og + 1u == (tg + 1u) * nx) xb_add(&bar[XB_TOPGEN], 1u);
            else XB_SPIN(xb_ld(&bar[XB_TOPGEN]) == tg, bar);
            __builtin_amdgcn_fence(__ATOMIC_ACQUIRE, "agent");
            xb_add(&bar[XB_XGEN(b.x)], 1u);
            asm volatile("s_waitcnt vmcnt(0)" ::: "memory");
        } else {
            XB_SPIN(xb_ld(&bar[XB_XGEN(b.x)]) == gen, bar);
            __builtin_amdgcn_fence(__ATOMIC_ACQUIRE, "agent");
            asm volatile("s_waitcnt vmcnt(0)" ::: "memory");
        }
    }
    __syncthreads();
}

namespace pg8 {
constexpr int BM = 256, BK = 64, HALF = 128, HTB = HALF * BK * 2, STAGE_BYTES = 8 * HTB;
__host__ __device__ __forceinline__ int lds_byte(int r, int c) { const int st = (r >> 4) * 2 + (c >> 5), rr = r & 15, cc = c & 31, ob = rr * 64 + cc * 2; return st * 1024 + (ob ^ (((ob >> 9) & 1) << 5)); }
__host__ __device__ __forceinline__ void stage_rc(int b, int& R, int& C) { const int st = b / 1024, sb = b % 1024, swz = sb ^ (((sb >> 9) & 1) << 5); R = (st >> 1) * 16 + swz / 64; C = (st & 1) * 32 + (swz % 64) / 2; }
__host__ __device__ __forceinline__ int perm32(int rho) { const int n = rho >> 4, i = rho & 15; return 8 * (i >> 2) + 4 * n + (i & 3); }
struct Unit { int pm, pn, e; };

template <class Epi, class Sched, bool ALIGN_EPI, bool FP8 = false>
__device__ __forceinline__ void gemm_phase(LAS unsigned char* lds, const int K, const Sched& S, const Epi& E) {
    const int tid = opaque_tid(), wid = __builtin_amdgcn_readfirstlane(tid >> 6), lane = tid & 63, wr = wid >> 2, wc = wid & 3, fr = lane & 15, fq = lane >> 4;
    const int nt = FP8 ? K / 128 : K / BK;
    int RA[2], CA[2]; unsigned voffB[2];
#pragma unroll
    for (int i = 0; i < 2; ++i) { int R, C; stage_rc(tid * 16 + i * 8192, R, C); RA[i] = R; CA[i] = C * 2;
        voffB[i] = (unsigned)(tid * 16 + i * 8192); }
    const size_t kstep = (size_t)(BK * 2);
    const size_t hstepB = 16384, kstepB = 32768;
    const unsigned ldsw = (unsigned)wid * 1024u;
    const int aoff = lds_byte(wr * 64 + fr, fq * 8), boff = lds_byte(wc * 32 + fr, fq * 8);
    const int aoff8 = lds_byte(wr * 64 + fr, fq * 16), boff8 = lds_byte(wc * 32 + fr, fq * 16);
#define PG8_SA(b, h) (((b) * 2 + (h)) * HTB)
#define PG8_SB(b, h) ((4 + (b) * 2 + (h)) * HTB)
#define PG8_STAGE(bufoff, gbase, v0, v1) do { const char* gb_ = (const char*)(gbase); unsigned v0_ = (v0), v1_ = (v1); asm volatile("" : "+s"(gb_), "+v"(v0_), "+v"(v1_)); \
        __builtin_amdgcn_global_load_lds((const unsigned*)(gb_ + v0_), (LAS unsigned*)(lds + (bufoff) + ldsw), 16, 0, 0); \
        __builtin_amdgcn_global_load_lds((const unsigned*)(gb_ + v1_), (LAS unsigned*)(lds + (bufoff) + ldsw + 8192), 16, 0, 0); } while (0)
#define PG8_STAGEA(bufoff, gbase, V, h) PG8_STAGE(bufoff, gbase, V[h][0], V[h][1])
#define PG8_STAGEB(bufoff, gbase) PG8_STAGE(bufoff, gbase, voffB[0], voffB[1])
#define PG8_LDA(dst, b, h) do { if constexpr (FP8) { _Pragma("unroll") for (int m = 0; m < 4; ++m) { const u32x4 l_ = *(const LAS u32x4*)(lds + PG8_SA(b, h) + aoff8 + m * 2048), h_ = *(const LAS u32x4*)(lds + PG8_SA(b, h) + aoff8 + m * 2048 + 16); \
            dst##8[m] = (i32x8){(int)l_.x, (int)l_.y, (int)l_.z, (int)l_.w, (int)h_.x, (int)h_.y, (int)h_.z, (int)h_.w}; } } \
        else { _Pragma("unroll") for (int m = 0; m < 4; ++m) _Pragma("unroll") for (int k = 0; k < 2; ++k) dst[m][k] = *(const LAS bf16x8*)(lds + PG8_SA(b, h) + aoff + m * 2048 + k * 1024); } } while (0)
#define PG8_LDB(dst, b, h) do { if constexpr (FP8) { _Pragma("unroll") for (int n = 0; n < 2; ++n) { const u32x4 l_ = *(const LAS u32x4*)(lds + PG8_SB(b, h) + boff8 + n * 2048), h_ = *(const LAS u32x4*)(lds + PG8_SB(b, h) + boff8 + n * 2048 + 16); \
            dst##8[n] = (i32x8){(int)l_.x, (int)l_.y, (int)l_.z, (int)l_.w, (int)h_.x, (int)h_.y, (int)h_.z, (int)h_.w}; } } \
        else { _Pragma("unroll") for (int n = 0; n < 2; ++n) _Pragma("unroll") for (int k = 0; k < 2; ++k) dst[n][k] = *(const LAS bf16x8*)(lds + PG8_SB(b, h) + boff + n * 2048 + k * 1024); } } while (0)
#define PG8_MMA(ai, bj, At, Bt) do { __builtin_amdgcn_s_setprio(1); \
        if constexpr (FP8) { _Pragma("unroll") for (int m = 0; m < 4; ++m) _Pragma("unroll") for (int n = 0; n < 2; ++n) \
            acc[ai][bj][m][n] = __builtin_amdgcn_mfma_scale_f32_16x16x128_f8f6f4(Bt##8[n], At##8[m], acc[ai][bj][m][n], 0, 0, 0, 0x7f7f7f7f, 0, 0x7f7f7f7f); } \
        else { _Pragma("unroll") for (int m = 0; m < 4; ++m) _Pragma("unroll") for (int n = 0; n < 2; ++n) _Pragma("unroll") for (int k = 0; k < 2; ++k) \
            acc[ai][bj][m][n] = __builtin_amdgcn_mfma_f32_16x16x32_bf16(Bt[n][k], At[m][k], acc[ai][bj][m][n], 0, 0, 0); } \
        __builtin_amdgcn_s_setprio(0); } while (0)
#define PG8_WAIT_V(n) asm volatile("s_waitcnt vmcnt(" #n ")" ::: "memory")
#define PG8_WAIT_L(n) asm volatile("s_waitcnt lgkmcnt(" #n ")" ::: "memory")
#define PG8_BAR __builtin_amdgcn_s_barrier()
#define PG8_SCHED __builtin_amdgcn_sched_barrier(0)
#define PG8_SCHED8 do { if constexpr (FP8) __builtin_amdgcn_sched_barrier(0); } while (0)
    Unit cur, nxt; int ui = 0;
    if (!S.next(0, cur)) return;
    f32x4 acc[2][2][4][2];
#pragma unroll
    for (int a = 0; a < 2; ++a)
#pragma unroll
        for (int b = 0; b < 2; ++b)
#pragma unroll
            for (int m = 0; m < 4; ++m)
#pragma unroll
                for (int n = 0; n < 2; ++n) acc[a][b][m][n] = (f32x4){0.f, 0.f, 0.f, 0.f};
    bf16x8 At[4][2], B0[2][2], B1[2][2]; i32x8 At8[4], B08[2], B18[2];
    const char* const Ab = S.a_base();
    unsigned cvA[2][2];
#pragma unroll
    for (int h = 0; h < 2; ++h)
#pragma unroll
        for (int i = 0; i < 2; ++i) cvA[h][i] = S.a_row_off(cur, h * HALF + RA[i]) + (unsigned)CA[i];
    const char* cB = S.b_base(cur);
    PG8_STAGEB(PG8_SB(0, 0), cB); PG8_STAGEB(PG8_SB(0, 1), cB + hstepB); PG8_STAGEA(PG8_SA(0, 0), Ab, cvA, 0); PG8_STAGEA(PG8_SA(0, 1), Ab, cvA, 1);
    if (wr == 1) PG8_BAR;
    PG8_WAIT_V(2); PG8_BAR;
    PG8_STAGEB(PG8_SB(1, 0), cB + kstepB); PG8_STAGEA(PG8_SA(1, 0), Ab + kstep, cvA, 0); PG8_STAGEB(PG8_SB(1, 1), cB + hstepB + kstepB);
    PG8_WAIT_V(6); PG8_BAR;
    for (;;) {
        const bool has_next = S.next(ui + 1, nxt);
        const char* nB = has_next ? S.b_base(nxt) : cB;
        for (int t = 0; t < nt; t += 2) {
            const bool last = (t == nt - 2);
            const char* a1 = Ab + (size_t)(t + 1) * kstep;
            const char* a2 = last ? Ab : Ab + (size_t)(t + 2) * kstep; const char* b2 = last ? nB : cB + (size_t)(t + 2) * kstepB;
            const char* a3 = a2 + kstep; const char* b3 = b2 + kstepB;
            PG8_LDB(B0, 0, 0); PG8_LDB(B1, 0, 1); PG8_SCHED; PG8_LDA(At, 0, 0); PG8_STAGEA(PG8_SA(1, 1), a1, cvA, 1);
            if (last && has_next) {
#pragma unroll
                for (int h = 0; h < 2; ++h)
#pragma unroll
                    for (int i = 0; i < 2; ++i) cvA[h][i] = S.a_row_off(nxt, h * HALF + RA[i]) + (unsigned)CA[i]; }
            PG8_WAIT_V(8); PG8_WAIT_L(0); PG8_BAR; PG8_SCHED8; PG8_MMA(0, 0, At, B0); PG8_MMA(0, 1, At, B1); PG8_SCHED8; PG8_BAR; PG8_SCHED;
            PG8_LDA(At, 0, 1); PG8_STAGEB(PG8_SB(0, 0), b2); PG8_STAGEB(PG8_SB(0, 1), b2 + hstepB); PG8_STAGEA(PG8_SA(0, 0), a2, cvA, 0);
            PG8_WAIT_V(8); PG8_WAIT_L(0); PG8_BAR; PG8_SCHED8; PG8_MMA(1, 0, At, B0); PG8_MMA(1, 1, At, B1); PG8_SCHED8; PG8_BAR; PG8_SCHED;
            PG8_LDB(B0, 1, 0); PG8_LDB(B1, 1, 1); PG8_SCHED; PG8_LDA(At, 1, 0); PG8_STAGEA(PG8_SA(0, 1), a2, cvA, 1);
            PG8_WAIT_V(8); PG8_WAIT_L(0); PG8_BAR; PG8_SCHED8; PG8_MMA(0, 0, At, B0); PG8_MMA(0, 1, At, B1); PG8_SCHED8; PG8_BAR; PG8_SCHED;
            PG8_LDA(At, 1, 1); PG8_STAGEB(PG8_SB(1, 0), b3); PG8_STAGEB(PG8_SB(1, 1), b3 + hstepB); PG8_STAGEA(PG8_SA(1, 0), a3, cvA, 0);
            PG8_WAIT_V(8); PG8_WAIT_L(0); PG8_BAR; PG8_SCHED8; PG8_MMA(1, 0, At, B0); PG8_MMA(1, 1, At, B1); PG8_SCHED8; PG8_BAR; PG8_SCHED;
        }
        if constexpr (ALIGN_EPI) { if (wr == 0) PG8_BAR; }
        E(acc, cur, wr, wc, fr, fq);
        if (!has_next) break;
#pragma unroll
        for (int a = 0; a < 2; ++a)
#pragma unroll
            for (int b = 0; b < 2; ++b)
#pragma unroll
                for (int m = 0; m < 4; ++m)
#pragma unroll
                    for (int n = 0; n < 2; ++n) acc[a][b][m][n] = (f32x4){0.f, 0.f, 0.f, 0.f};
        cur = nxt; cB = nB; ++ui;
        if constexpr (ALIGN_EPI) { if (wr == 1) PG8_BAR; }
    }
    PG8_WAIT_V(0);
    if constexpr (!ALIGN_EPI) { if (wr == 0) PG8_BAR; }
    PG8_BAR;
#undef PG8_SA
#undef PG8_SB
#undef PG8_STAGE
#undef PG8_STAGEA
#undef PG8_STAGEB
#undef PG8_LDA
#undef PG8_LDB
#undef PG8_MMA
#undef PG8_WAIT_V
#undef PG8_WAIT_L
#undef PG8_BAR
#undef PG8_SCHED
#undef PG8_SCHED8
}
}

struct SchedBase { int x, j, G8, NGp; __device__ __forceinline__ void init_grid() { const int G = gridDim.x, bx = blockIdx.x; if (G % 8 == 0) { NGp = 8; x = bx % 8; j = bx / 8; G8 = G / 8; } else { NGp = 1; x = 0; j = bx; G8 = G; } } };
struct PlainSched : SchedBase {
    const char* A; unsigned lda; const char* Bt; int K, nN, nrt;
    __device__ __forceinline__ bool next(int i, pg8::Unit& u) const { const int U = i * G8 + j, nrtg = (nrt - x + NGp - 1) / NGp; if (U >= nrtg * nN) return false; const int q = U / nN; u.pn = U - q * nN; u.pm = x + NGp * q; return true; }
    __device__ __forceinline__ const char* a_base() const { return A; }
    __device__ __forceinline__ unsigned a_row_off(const pg8::Unit& u, int r) const { return (unsigned)(u.pm * 256 + r) * lda; }
    __device__ __forceinline__ const char* b_base(const pg8::Unit& u) const { return Bt + (size_t)u.pn * 256 * K * 2; }
};
struct GroupSched : SchedBase {
    const char* A; unsigned lda; const int* slot_tok; const char* Bt; size_t strideE; int K; const LAS int* ts;
    __device__ __forceinline__ bool next(int i, pg8::Unit& u) const {
        const int U = i * G8 + j; int q = U >> 2; u.pn = U & 3;
        for (int e = x; e < NEXP; e += NGp) { const int t0 = __builtin_amdgcn_readfirstlane(ts[e]), n = __builtin_amdgcn_readfirstlane(ts[e + 1]) - t0; if (q < n) { u.pm = t0 + q; u.e = e; return true; } q -= n; }
        return false; }
    __device__ __forceinline__ const char* a_base() const { return A; }
    __device__ __forceinline__ unsigned a_row_off(const pg8::Unit& u, int r) const { int row = u.pm * 256 + r; if (slot_tok) row = slot_tok[row]; return (unsigned)row * lda; }
    __device__ __forceinline__ const char* b_base(const pg8::Unit& u) const { return Bt + (size_t)u.e * strideE + (size_t)u.pn * 256 * K * 2; }
};

typedef f32x4 Acc[2][2][4][2];
struct EpiQKV {
    bf16_t* Q; const float* rstd; const LAS float* gl;
    __device__ __forceinline__ void operator()(const Acc& acc, const pg8::Unit& u, int wr, int wc, int fr, int fq) const {
        const int part = u.pn >> 2, colp = (u.pn & 3) * 256 + wc * 64 + 8 * fq;
        bf16_t* base = Q + (size_t)part * NTOK * DM;
        const float qs = part == 0 ? 0.125f * LOG2E : 1.f;
#pragma unroll
        for (int ai = 0; ai < 2; ++ai)
#pragma unroll
            for (int m = 0; m < 4; ++m) {
                const int row = u.pm * 256 + ai * 128 + wr * 64 + m * 16 + fr;
                const float rs = rstd[row];
                float f = rs;
                if (part < 2) { float ss = 0.f;
#pragma unroll
                    for (int bj = 0; bj < 2; ++bj)
#pragma unroll
                        for (int n = 0; n < 2; ++n) { const f32x4 t = acc[ai][bj][m][n] * rs; const f32x4 t2 = t * t; ss += (t2[0] + t2[1]) + (t2[2] + t2[3]); }
                    ss += __shfl_xor(ss, 16); ss += __shfl_xor(ss, 32); f = rs * __builtin_amdgcn_rsqf(ss * (1.f / 64.f) + EPS) * qs; }
                const int hh = (u.pn & 3) * 2 + (wc >> 1), tl = (row & (SEQ - 1)) >> 6, rr = row & 63;
                const size_t tb = ((size_t)((row >> 12) * NHEAD + hh) * 64 + tl) * 8192;
#pragma unroll
                for (int bj = 0; bj < 2; ++bj) {
                    f32x4 g0 = {f, f, f, f}, g1 = g0;
                    if (part < 2) { const LAS f32x4* gp = (const LAS f32x4*)(gl + part * 64 + 32 * bj + 8 * fq); g0 = gp[0] * f; g1 = gp[1] * f; }
                    const f32x4 a = acc[ai][bj][m][0] * g0, b = acc[ai][bj][m][1] * g1;
                    u32x4 w; w.x = cvtpk(a[0], a[1]); w.y = cvtpk(a[2], a[3]); w.z = cvtpk(b[0], b[1]); w.w = cvtpk(b[2], b[3]);
                    if (part == 0) *(u32x4*)(base + (size_t)row * DM + colp + 32 * bj) = w;
                    else if (part == 1) *(u32x4*)(base + tb + ((wc & 1) * 8 + 4 * bj + fq) * 512 + rr * 8) = w;
                    else *(u32x4*)(base + tb + (2 * (wc & 1) + bj) * 2048 + rr * 32 + 8 * fq) = w; }
            }
    }
};
__device__ __forceinline__ int cvt8(float a, float b, int old, bool hi) {
    a = __builtin_amdgcn_fmed3f(a, -448.f, 448.f); b = __builtin_amdgcn_fmed3f(b, -448.f, 448.f);
    return hi ? __builtin_amdgcn_cvt_pk_fp8_f32(a, b, old, true) : __builtin_amdgcn_cvt_pk_fp8_f32(a, b, old, false);
}
struct EpiBf16 {
    bf16_t* O; int ldc; const float* rstd; float mul;
    __device__ __forceinline__ void operator()(const Acc& acc, const pg8::Unit& u, int wr, int wc, int fr, int fq) const {
        const int col = u.pn * 256 + wc * 64 + 8 * fq;
        float rsv[2][4];
#pragma unroll
        for (int ai = 0; ai < 2; ++ai)
#pragma unroll
            for (int m = 0; m < 4; ++m) rsv[ai][m] = (rstd ? rstd[u.pm * 256 + ai * 128 + wr * 64 + m * 16 + fr] : 1.f) * mul;
        asm volatile("" : "+v"(rsv[0][0]), "+v"(rsv[0][1]), "+v"(rsv[0][2]), "+v"(rsv[0][3]), "+v"(rsv[1][0]), "+v"(rsv[1][1]), "+v"(rsv[1][2]), "+v"(rsv[1][3]) :: "memory");
#pragma unroll
        for (int ai = 0; ai < 2; ++ai)
#pragma unroll
            for (int m = 0; m < 4; ++m) {
                const int row = u.pm * 256 + ai * 128 + wr * 64 + m * 16 + fr;
                const float rs = rsv[ai][m];
#pragma unroll
                for (int bj = 0; bj < 2; ++bj) { const f32x4 a = acc[ai][bj][m][0] * rs, b = acc[ai][bj][m][1] * rs; u32x4 w; w.x = cvtpk(a[0], a[1]); w.y = cvtpk(a[2], a[3]); w.z = cvtpk(b[0], b[1]); w.w = cvtpk(b[2], b[3]);
                    *(u32x4*)(O + (size_t)row * ldc + col + 32 * bj) = w; }
            }
    }
};
constexpr float Y8_SCALE = 16.f;
struct EpiY8 {
    static constexpr int NSTORES = 8;
    unsigned char* Y;
    __device__ __forceinline__ void operator()(const Acc& acc, const pg8::Unit& u, int wr, int wc, int fr, int fq) const {
        const int pos = u.pn * 256 + wc * 64 + 16 * fq;
        constexpr float YS = Y8_SCALE / (16.f * 64.f);
#pragma unroll
        for (int ai = 0; ai < 2; ++ai)
#pragma unroll
            for (int m = 0; m < 4; ++m) {
                const int row = u.pm * 256 + ai * 128 + wr * 64 + m * 16 + fr;
                u32x4 w;
#pragma unroll
                for (int bj = 0; bj < 2; ++bj) { const f32x4 a = acc[ai][bj][m][0] * YS, b = acc[ai][bj][m][1] * YS;
                    int lo = cvt8(a[0], a[1], 0, false); lo = cvt8(a[2], a[3], lo, true);
                    int hi = cvt8(b[0], b[1], 0, false); hi = cvt8(b[2], b[3], hi, true);
                    w[2 * bj] = (unsigned)lo; w[2 * bj + 1] = (unsigned)hi; }
                *(u32x4*)(Y + (size_t)row * DM + pos) = w;
            }
    }
};
constexpr float X8_SCALE = 4.f, WG8_SCALE = 64.f, WPC8_SCALE = 64.f;
struct EpiRes {
    bf16_t* xb; const float* scale; unsigned char* x8; float mul;
    __device__ __forceinline__ void operator()(const Acc& acc, const pg8::Unit& u, int wr, int wc, int fr, int fq) const {
        const int col = u.pn * 256 + wc * 64 + 8 * fq;
        f32x4 sc[2][2];
#pragma unroll
        for (int bj = 0; bj < 2; ++bj)
#pragma unroll
            for (int n = 0; n < 2; ++n) sc[bj][n] = (scale ? *(const f32x4*)(scale + col + 32 * bj + 4 * n) : (f32x4){1.f, 1.f, 1.f, 1.f}) * mul;
#pragma unroll
        for (int ai = 0; ai < 2; ++ai) {
            u32x4 r[2][4][2];
#pragma unroll
            for (int m = 0; m < 4; ++m)
#pragma unroll
                for (int bj = 0; bj < 2; ++bj) r[ai][m][bj] = *(const u32x4*)(xb + (size_t)(u.pm * 256 + ai * 128 + wr * 64 + m * 16 + fr) * DM + col + 32 * bj);
            asm volatile("" ::: "memory");
#pragma unroll
            for (int m = 0; m < 4; ++m) {
                const size_t off = (size_t)(u.pm * 256 + ai * 128 + wr * 64 + m * 16 + fr) * DM + col;
                u32x4 w8;
#pragma unroll
                for (int bj = 0; bj < 2; ++bj) {
                    const u32x4 q = r[ai][m][bj];
                    const f32x4 a = acc[ai][bj][m][0] * sc[bj][0], b = acc[ai][bj][m][1] * sc[bj][1];
                    const float x0 = __builtin_bit_cast(float, q.x << 16) + a[0], x1 = __builtin_bit_cast(float, q.x & 0xffff0000u) + a[1], x2 = __builtin_bit_cast(float, q.y << 16) + a[2], x3 = __builtin_bit_cast(float, q.y & 0xffff0000u) + a[3];
                    const float x4 = __builtin_bit_cast(float, q.z << 16) + b[0], x5 = __builtin_bit_cast(float, q.z & 0xffff0000u) + b[1], x6 = __builtin_bit_cast(float, q.w << 16) + b[2], x7 = __builtin_bit_cast(float, q.w & 0xffff0000u) + b[3];
                    u32x4 w; w.x = cvtpk(x0, x1); w.y = cvtpk(x2, x3); w.z = cvtpk(x4, x5); w.w = cvtpk(x6, x7);
                    *(u32x4*)(xb + off + 32 * bj) = w;
                    int lo = cvt8(x0 * X8_SCALE, x1 * X8_SCALE, 0, false); lo = cvt8(x2 * X8_SCALE, x3 * X8_SCALE, lo, true);
                    int hi = cvt8(x4 * X8_SCALE, x5 * X8_SCALE, 0, false); hi = cvt8(x6 * X8_SCALE, x7 * X8_SCALE, hi, true);
                    w8[2 * bj] = (unsigned)lo; w8[2 * bj + 1] = (unsigned)hi; }
                *(u32x4*)(x8 + (size_t)(u.pm * 256 + ai * 128 + wr * 64 + m * 16 + fr) * DM + u.pn * 256 + wc * 64 + 16 * fq) = w8;
            }
        }
    }
};
constexpr float H8_SCALE = 16.f, WD8_SCALE = 64.f;
struct EpiGateUp {
    static constexpr int NSTORES = 8;
    unsigned char* H; const float* slot_rs;
    __device__ __forceinline__ void operator()(const Acc& acc, const pg8::Unit& u, int wr, int wc, int fr, int fq) const {
#pragma unroll
        for (int ai = 0; ai < 2; ++ai) {
            float rsv[4];
#pragma unroll
            for (int m = 0; m < 4; ++m) rsv[m] = slot_rs[u.pm * 256 + ai * 128 + wr * 64 + m * 16 + fr];
            asm volatile("" : "+v"(rsv[0]), "+v"(rsv[1]), "+v"(rsv[2]), "+v"(rsv[3]) :: "memory");
            u32x2 w[4];
#pragma unroll
            for (int m = 0; m < 4; ++m) {
                const float rs = rsv[m] * (1.f / (X8_SCALE * WG8_SCALE));
                float h[8];
#pragma unroll
                for (int n = 0; n < 2; ++n)
#pragma unroll
                    for (int i = 0; i < 4; ++i) { const float g = acc[ai][0][m][n][i] * rs, up = acc[ai][1][m][n][i] * rs;
                        h[4 * n + i] = g * up * __builtin_amdgcn_rcpf(1.f + __builtin_amdgcn_exp2f(-g * LOG2E)) * H8_SCALE; }
                int lo = cvt8(h[0], h[1], 0, false); lo = cvt8(h[2], h[3], lo, true);
                int hi = cvt8(h[4], h[5], 0, false); hi = cvt8(h[6], h[7], hi, true);
                w[m].x = (unsigned)lo; w[m].y = (unsigned)hi;
            }
            const int odd = fq & 1;
#pragma unroll
            for (int mp = 0; mp < 4; mp += 2) {
                const u32x2 snd = odd ? w[mp] : w[mp + 1], own = odd ? w[mp + 1] : w[mp];
                u32x2 rcv; rcv.x = (unsigned)__shfl_xor((int)snd.x, 16); rcv.y = (unsigned)__shfl_xor((int)snd.y, 16);
                u32x4 o; o.x = odd ? rcv.x : own.x; o.y = odd ? rcv.y : own.y; o.z = odd ? own.x : rcv.x; o.w = odd ? own.y : rcv.y;
                const int row = u.pm * 256 + ai * 128 + wr * 64 + (mp + odd) * 16 + fr;
                *(u32x4*)(H + (size_t)row * EFF + u.pn * 128 + wc * 32 + 8 * (fq & 2)) = o;
            }
        }
    }
};

struct W8Item { const float* W; const float* gp; unsigned char* WT; int N, k0, n, Kd, drow, r0, r1, hasg; float fs; };
__device__ __forceinline__ void w8_load(LAS unsigned char* lds, int S, int lane, int wid, W8Item& d, f32x4 (&v)[16], float (&g)[16]);
__device__ __forceinline__ void w8_finish(const W8Item& d, const f32x4 (&v)[16], float (&g)[16], int wid);
constexpr int W8_SGU = 128 * 2 * 8 * 2, W8_SDN = 128 * 4 * 4, W8_SPO = 2 * 8 * 4, W8_PER_LAYER = 1024 + 512;
constexpr int W8_EARLY1 = 512, W8_NDEF = 3 * W8_PER_LAYER - W8_EARLY1;
__device__ __forceinline__ int w8_deferred_S(int d) { const int dd = d + W8_EARLY1, layer = 1 + dd / W8_PER_LAYER, w = dd - (layer - 1) * W8_PER_LAYER; return w < 1024 ? layer * 1024 + w : W8_SGU + layer * 512 + (w - 1024); }
namespace attn {
constexpr int SLOT = 32768, V_OFF = 16384, NSLOT = 3, X_OFF = NSLOT * SLOT, WSF_OFF = TS_OFF + 256;
static_assert(X_OFF + 4 * 8192 <= RING_BYTES && WSF_OFF + NWAVES * 256 <= LDS_BYTES, "attn LDS");
constexpr int DMAXI = 206;
__device__ __forceinline__ int crow(int r, int hi) { return (r & 3) + 8 * (r >> 2) + 4 * hi; }
__device__ __forceinline__ int rel_bucket(int n) {
    if (n < 16) return n;
    const int l = 16 + (int)(logf((float)n / 16.f) / logf(8.f) * 16.f);
    return l < 31 ? l : 31;
}
struct Params { const bf16_t* Q; const bf16_t* K; const bf16_t* V; bf16_t* O; const float* rel_bias; const float* subln; float lam; float one_minus_li; int dbase, dcount; };

__device__ __forceinline__ void build_lut(LAS unsigned char* lds, const float* rel_bias) {
    LAS float* lut = (LAS float*)(lds + LUT_OFF);
    for (int idx = opaque_tid(); idx < NHEAD * LUT_N; idx += NTHREADS) {
        const int h = idx / LUT_N, i = idx - h * LUT_N, dist = DMAXI - i;
        lut[idx] = dist < 0 ? -INFINITY : (rel_bias[rel_bucket(dist) * NHEAD + h] - rel_bias[31 * NHEAD + h]) * LOG2E;
    }
}
#define ATT_WAIT_BAR(N) asm volatile("s_waitcnt vmcnt(" #N ") lgkmcnt(0)\n\ts_barrier" ::: "memory")
#define ATT_SBAR() __builtin_amdgcn_sched_barrier(0)
#define ATT_PIN(x) asm volatile("" : "+v"(x))
#define ATT_MF(a, b, c) __builtin_amdgcn_mfma_f32_32x32x16_bf16(a, b, c, 0, 0, 0)
#define ATT_VRD8(L, H, ks) do { _Pragma("unroll") for (int d_ = 0; d_ < 4; ++d_) { \
        asm volatile("ds_read_b64_tr_b16 %0, %1 offset:%c2" : "=&v"(L[d_]) : "v"(vaddr), "i"(V_OFF + d_ * 4096 + (ks) * 1024) : "memory"); \
        asm volatile("ds_read_b64_tr_b16 %0, %1 offset:%c2" : "=&v"(H[d_]) : "v"(vaddr), "i"(V_OFF + d_ * 4096 + (ks) * 1024 + 512) : "memory"); } } while (0)
#define ATT_VWAIT(N, L, H) do { asm volatile("s_waitcnt lgkmcnt(" #N ")" : "+v"(L[0]), "+v"(L[1]), "+v"(L[2]), "+v"(L[3]), "+v"(H[0]), "+v"(H[1]), "+v"(H[2]), "+v"(H[3]) :: "memory"); ATT_SBAR(); } while (0)
#define ATT_VF(L, H, d) ((bf16x8){L[d][0], L[d][1], L[d][2], L[d][3], H[d][0], H[d][1], H[d][2], H[d][3]})
#define ATT_PK(P, B) cvtpk(P[B], P[(B) + 1])
#define ATT_GAPA(VR, MFX, A0, A1, A2, A3, W0, W1, PW) do { VR; MFX; sacc += A0; sacc += A1; sacc += A2; sacc += A3; ATT_PIN(sacc); W0; W1; ATT_PIN(PW); ATT_SBAR(); } while (0)
#define ATT_VR1(L, H, d, ks) do { \
        asm volatile("ds_read_b64_tr_b16 %0, %1 offset:%c2" : "=&v"(L[d]) : "v"(vaddr), "i"(V_OFF + (d) * 4096 + (ks) * 1024) : "memory"); \
        asm volatile("ds_read_b64_tr_b16 %0, %1 offset:%c2" : "=&v"(H[d]) : "v"(vaddr), "i"(V_OFF + (d) * 4096 + (ks) * 1024 + 512) : "memory"); } while (0)
#define ATT_GAPB(KR, MFX, X, B) do { KR; MFX; X[B] = __builtin_amdgcn_exp2f(X[B]); X[(B) + 1] = __builtin_amdgcn_exp2f(X[(B) + 1]); ATT_PIN(X); ATT_SBAR(); } while (0)
#define ATT_VRW(N, L, H, d) asm volatile("s_waitcnt lgkmcnt(" #N ")" : "+v"(L[d]), "+v"(H[d]) :: "memory")
#define ATT_GAPB2(WT, MFX, VR, KR, DM, X, B) do { WT; MFX; VR; KR; DM; X[B] = __builtin_amdgcn_exp2f(X[B]); X[(B) + 1] = __builtin_amdgcn_exp2f(X[(B) + 1]); ATT_PIN(X); ATT_SBAR(); } while (0)
#define ATT_KR(GL, j) do { if (GL) { kf[2 * (j)] = *(const LAS bf16x8*)(kp0 + sl_next + (j) * 2048); kf[2 * (j) + 1] = *(const LAS bf16x8*)(kp0 + sl_next + (j) * 2048 + 512); } } while (0)
#define ATT_NOP() do { } while (0)
#define ATT_KLOAD(kp_) do { _Pragma("unroll") for (int d0_ = 0; d0_ < 4; ++d0_) { kf[2 * d0_] = *(const LAS bf16x8*)((kp_) + d0_ * 2048); kf[2 * d0_ + 1] = *(const LAS bf16x8*)((kp_) + d0_ * 2048 + 512); } } while (0)
#define ATT_BAND(C0, C1, tt) do { const int dd_ = q0w - 64 * (tt); if (dd_ - 63 < 113) { const LAS float* lb_ = lut + (DMAXI - (dd_ + r32 - 4 * hi)); \
        _Pragma("unroll") for (int r = 0; r < 16; ++r) { C0[r] += lb_[(r & 3) + 8 * (r >> 2)]; C1[r] += lb_[32 + (r & 3) + 8 * (r >> 2)]; } } } while (0)
#define ATT_STEP(C0, C1, P0, P1, tt, ITOP, I0, I1, I2, I3, GL, WN) do { \
        ATT_WAIT_BAR(WN); \
        ITOP; \
        const unsigned vaddr = lds_u + (unsigned)sl_prev + (unsigned)vlane; \
        float sacc = 0.f; \
        ATT_GAPA(ATT_VR1(la, ha, 0, 0), C0 = ATT_MF(kf[0], qr[0], zero16), P0[0], P0[1], P0[2], P0[3],     pw0[0] = ATT_PK(P0, 0),  pw0[1] = ATT_PK(P0, 2),  pw0); \
        ATT_GAPA(ATT_VR1(la, ha, 1, 0), C1 = ATT_MF(kf[1], qr[0], zero16), P0[4], P0[5], P0[6], P0[7],     pw0[2] = ATT_PK(P0, 4),  pw0[3] = ATT_PK(P0, 6),  pw0); \
        ATT_GAPA(ATT_VR1(la, ha, 2, 0), C0 = ATT_MF(kf[2], qr[1], C0),     P0[8], P0[9], P0[10], P0[11],   pw1[0] = ATT_PK(P0, 8),  pw1[1] = ATT_PK(P0, 10), pw1); \
        ATT_GAPA(ATT_VR1(la, ha, 3, 0), C1 = ATT_MF(kf[3], qr[1], C1),     P0[12], P0[13], P0[14], P0[15], pw1[2] = ATT_PK(P0, 12), pw1[3] = ATT_PK(P0, 14), pw1); \
        ATT_GAPA(ATT_NOP(), C0 = ATT_MF(kf[4], qr[2], C0),     P1[0], P1[1], P1[2], P1[3],     pw2[0] = ATT_PK(P1, 0),  pw2[1] = ATT_PK(P1, 2),  pw2); \
        ATT_GAPA(ATT_NOP(), C1 = ATT_MF(kf[5], qr[2], C1),     P1[4], P1[5], P1[6], P1[7],     pw2[2] = ATT_PK(P1, 4),  pw2[3] = ATT_PK(P1, 6),  pw2); \
        ATT_GAPA(ATT_NOP(), C0 = ATT_MF(kf[6], qr[3], C0),     P1[8], P1[9], P1[10], P1[11],   pw3[0] = ATT_PK(P1, 8),  pw3[1] = ATT_PK(P1, 10), pw3); \
        ATT_GAPA(ATT_NOP(), C1 = ATT_MF(kf[7], qr[3], C1),     P1[12], P1[13], P1[14], P1[15], pw3[2] = ATT_PK(P1, 12), pw3[3] = ATT_PK(P1, 14), pw3); \
        lsum += sacc; \
        ATT_BAND(C0, C1, tt); \
        ATT_GAPB2(ATT_VRW(6, la, ha, 0),   o[0] = ATT_MF(__builtin_bit_cast(bf16x8, pw0), ATT_VF(la, ha, 0), o[0]),   ATT_VR1(lb2, hb2, 0, 1), ATT_NOP(),      ATT_NOP(), C0, 0); \
        ATT_GAPB2(ATT_VRW(6, la, ha, 1),   o[1] = ATT_MF(__builtin_bit_cast(bf16x8, pw0), ATT_VF(la, ha, 1), o[1]),   ATT_VR1(lb2, hb2, 1, 1), ATT_NOP(),      ATT_NOP(), C0, 2); \
        ATT_GAPB2(ATT_VRW(6, la, ha, 2),   o[2] = ATT_MF(__builtin_bit_cast(bf16x8, pw0), ATT_VF(la, ha, 2), o[2]),   ATT_VR1(lb2, hb2, 2, 1), ATT_KR(GL, 0),  ATT_NOP(), C0, 4); \
        ATT_GAPB2(ATT_VRW(6, la, ha, 3),   o[3] = ATT_MF(__builtin_bit_cast(bf16x8, pw0), ATT_VF(la, ha, 3), o[3]),   ATT_VR1(lb2, hb2, 3, 1), ATT_KR(GL, 1),  ATT_NOP(), C0, 6); \
        ATT_GAPB2(ATT_VRW(6, lb2, hb2, 0), o[0] = ATT_MF(__builtin_bit_cast(bf16x8, pw1), ATT_VF(lb2, hb2, 0), o[0]), ATT_VR1(la, ha, 0, 2),   ATT_KR(GL, 2),  ATT_NOP(), C0, 8); \
        ATT_GAPB2(ATT_VRW(6, lb2, hb2, 1), o[1] = ATT_MF(__builtin_bit_cast(bf16x8, pw1), ATT_VF(lb2, hb2, 1), o[1]), ATT_VR1(la, ha, 1, 2),   ATT_KR(GL, 3),  ATT_NOP(), C0, 10); \
        ATT_GAPB2(ATT_VRW(6, lb2, hb2, 2), o[2] = ATT_MF(__builtin_bit_cast(bf16x8, pw1), ATT_VF(lb2, hb2, 2), o[2]), ATT_VR1(la, ha, 2, 2),   ATT_NOP(),      ATT_NOP(), C0, 12); \
        ATT_GAPB2(ATT_VRW(6, lb2, hb2, 3), o[3] = ATT_MF(__builtin_bit_cast(bf16x8, pw1), ATT_VF(lb2, hb2, 3), o[3]), ATT_VR1(la, ha, 3, 2),   ATT_NOP(),      ATT_NOP(), C0, 14); \
        ATT_GAPB2(ATT_VRW(6, la, ha, 0),   o[0] = ATT_MF(__builtin_bit_cast(bf16x8, pw2), ATT_VF(la, ha, 0), o[0]),   ATT_VR1(lb2, hb2, 0, 3), ATT_NOP(),      ATT_NOP(), C1, 0); \
        ATT_GAPB2(ATT_VRW(6, la, ha, 1),   o[1] = ATT_MF(__builtin_bit_cast(bf16x8, pw2), ATT_VF(la, ha, 1), o[1]),   ATT_VR1(lb2, hb2, 1, 3), ATT_NOP(),      ATT_NOP(), C1, 2); \
        ATT_GAPB2(ATT_VRW(6, la, ha, 2),   o[2] = ATT_MF(__builtin_bit_cast(bf16x8, pw2), ATT_VF(la, ha, 2), o[2]),   ATT_VR1(lb2, hb2, 2, 3), ATT_NOP(),      ATT_NOP(), C1, 4); \
        ATT_GAPB2(ATT_VRW(6, la, ha, 3),   o[3] = ATT_MF(__builtin_bit_cast(bf16x8, pw2), ATT_VF(la, ha, 3), o[3]),   ATT_VR1(lb2, hb2, 3, 3), ATT_NOP(),      ATT_NOP(), C1, 6); \
        ATT_GAPB2(ATT_VRW(6, lb2, hb2, 0), o[0] = ATT_MF(__builtin_bit_cast(bf16x8, pw3), ATT_VF(lb2, hb2, 0), o[0]), ATT_NOP(),               ATT_NOP(),      I0,        C1, 8); \
        ATT_GAPB2(ATT_VRW(4, lb2, hb2, 1), o[1] = ATT_MF(__builtin_bit_cast(bf16x8, pw3), ATT_VF(lb2, hb2, 1), o[1]), ATT_NOP(),               ATT_NOP(),      I1,        C1, 10); \
        ATT_GAPB2(ATT_VRW(2, lb2, hb2, 2), o[2] = ATT_MF(__builtin_bit_cast(bf16x8, pw3), ATT_VF(lb2, hb2, 2), o[2]), ATT_NOP(),               ATT_NOP(),      I2,        C1, 12); \
        ATT_GAPB2(ATT_VRW(0, lb2, hb2, 3), o[3] = ATT_MF(__builtin_bit_cast(bf16x8, pw3), ATT_VF(lb2, hb2, 3), o[3]), ATT_NOP(),               ATT_NOP(),      I3,        C1, 14); \
        { const int tmp_ = sl_prev; sl_prev = sl_cur; sl_cur = sl_next; sl_next = tmp_; } \
    } while (0)

__device__ __forceinline__ void attn_unit(const Params& P, int b, int h, int qblk, int ditem, LAS unsigned char* lds) {
    const int tid = opaque_tid(), lane = tid & 63, r32 = lane & 31, hi = lane >> 5;
    const int wid = __builtin_amdgcn_readfirstlane(tid >> 6), c = wid >> 2, wq = wid & 3;
    const int q0 = qblk * 128, q0w = q0 + 32 * wq, NT = 2 * qblk + 2;
    const size_t rowbase = (size_t)b * SEQ;
    bf16x8 qr[4];
    { const bf16_t* Qw = P.Q + (rowbase + q0w + r32) * DM + h * 128 + c * 64 + hi * 8;
#pragma unroll
      for (int d0 = 0; d0 < 4; ++d0) qr[d0] = *(const bf16x8*)(Qw + d0 * 16); }
    const bf16_t* ksrc = P.K + (size_t)(b * NHEAD + h) * 64 * 8192 + wid * 512 + lane * 8;
    const bf16_t* vsrc = P.V + (size_t)(b * NHEAD + h) * 64 * 8192 + (wid >> 2) * 2048 + wq * 512 + lane * 8;
#define ATT_DMA_K0(t, slot) __builtin_amdgcn_global_load_lds((const unsigned*)(ksrc + (size_t)(t) * 8192), (LAS unsigned*)(lds + (slot) + wid * 1024), 16, 0, 0)
#define ATT_DMA_K1(t, slot) __builtin_amdgcn_global_load_lds((const unsigned*)(ksrc + (size_t)(t) * 8192 + 4096), (LAS unsigned*)(lds + (slot) + 8192 + wid * 1024), 16, 0, 0)
#define ATT_DMA_V0(t, slot) __builtin_amdgcn_global_load_lds((const unsigned*)(vsrc + (size_t)(t) * 8192), (LAS unsigned*)(lds + (slot) + V_OFF + (wid >> 2) * 4096 + wq * 1024), 16, 0, 0)
#define ATT_DMA_V1(t, slot) __builtin_amdgcn_global_load_lds((const unsigned*)(vsrc + (size_t)(t) * 8192 + 4096), (LAS unsigned*)(lds + (slot) + V_OFF + (2 + (wid >> 2)) * 4096 + wq * 1024), 16, 0, 0)
#define ATT_DMA_K(t, slot) do { ATT_DMA_K0(t, slot); ATT_DMA_K1(t, slot); } while (0)
#define ATT_DMA_V(t, slot) do { ATT_DMA_V0(t, slot); ATT_DMA_V1(t, slot); } while (0)
    ATT_DMA_K(0, 0);
    ATT_DMA_K(1, SLOT); ATT_DMA_V(0, 0);
    if (NT > 2) ATT_DMA_K(2, 2 * SLOT);
    f32x16 o[4];
#pragma unroll
    for (int d = 0; d < 4; ++d)
#pragma unroll
        for (int r = 0; r < 16; ++r) o[d][r] = 0.f;
    f32x16 zero16;
#pragma unroll
    for (int r = 0; r < 16; ++r) zero16[r] = 0.f;
    float lsum = 0.f;
    const LAS float* lut = (const LAS float*)(lds + LUT_OFF) + h * LUT_N;
    const int vlane = ((lane >> 4) & 1) * 32 + (lane & 3) * 8 + (4 * hi + ((lane & 15) >> 2)) * 64;
    const unsigned lds_u = (unsigned)(uintptr_t)lds;
    const LAS unsigned char* kp0 = lds + c * 8192 + hi * 1024 + r32 * 16;
    int sl_prev = 2 * SLOT, sl_cur = 0, sl_next = SLOT;
    bf16x8 kf[8]; s16x4 la[4], ha[4], lb2[4], hb2[4]; u32x4 pw0, pw1, pw2, pw3;
    f32x16 pA0, pA1, pB0, pB1;
    if (NT > 2) ATT_WAIT_BAR(6); else ATT_WAIT_BAR(4);
    ATT_DMA_V(1, SLOT);
    ATT_KLOAD(kp0);
    pA0 = ATT_MF(kf[0], qr[0], zero16); pA1 = ATT_MF(kf[1], qr[0], zero16);
    pA0 = ATT_MF(kf[2], qr[1], pA0); pA1 = ATT_MF(kf[3], qr[1], pA1);
    pA0 = ATT_MF(kf[4], qr[2], pA0); pA1 = ATT_MF(kf[5], qr[2], pA1);
    pA0 = ATT_MF(kf[6], qr[3], pA0); pA1 = ATT_MF(kf[7], qr[3], pA1);
    ATT_BAND(pA0, pA1, 0);
#pragma unroll
    for (int r = 0; r < 16; ++r) { pA0[r] = __builtin_amdgcn_exp2f(pA0[r]); pA1[r] = __builtin_amdgcn_exp2f(pA1[r]); }
    if (NT > 2) ATT_WAIT_BAR(6); else ATT_WAIT_BAR(4);
    ATT_KLOAD(kp0 + SLOT);
    { const int tmp_ = sl_prev; sl_prev = sl_cur; sl_cur = sl_next; sl_next = tmp_; }
    ATT_STEP(pB0, pB1, pA0, pA1, 1, { if (3 < NT) ATT_DMA_K(3, sl_prev); if (4 < NT) ATT_DMA_K(4, sl_cur); if (2 < NT) ATT_DMA_V(2, sl_next); }, ATT_NOP(), ATT_NOP(), ATT_NOP(), ATT_NOP(), (2 < NT), 2);
    if (NT > 2) {
        int t = 2;
        for (; t + 4 < NT; t += 2) {
            ATT_STEP(pA0, pA1, pB0, pB1, t,     ATT_NOP(), ATT_DMA_K0(t + 3, sl_cur), ATT_DMA_K1(t + 3, sl_cur), ATT_DMA_V0(t + 1, sl_next), ATT_DMA_V1(t + 1, sl_next), true, 4);
            ATT_STEP(pB0, pB1, pA0, pA1, t + 1, ATT_NOP(), ATT_DMA_K0(t + 4, sl_cur), ATT_DMA_K1(t + 4, sl_cur), ATT_DMA_V0(t + 2, sl_next), ATT_DMA_V1(t + 2, sl_next), true, 4);
        }
        if (NT - t == 4) {
            ATT_STEP(pA0, pA1, pB0, pB1, t,     ATT_NOP(), ATT_DMA_K0(t + 3, sl_cur), ATT_DMA_K1(t + 3, sl_cur), ATT_DMA_V0(t + 1, sl_next), ATT_DMA_V1(t + 1, sl_next), true, 4);
            ATT_STEP(pB0, pB1, pA0, pA1, t + 1, ATT_NOP(), ATT_NOP(), ATT_NOP(), ATT_DMA_V0(t + 2, sl_next), ATT_DMA_V1(t + 2, sl_next), true, 4);
            t += 2;
        }
        ATT_STEP(pA0, pA1, pB0, pB1, t,     ATT_NOP(), ATT_NOP(), ATT_NOP(), ATT_DMA_V0(t + 1, sl_next), ATT_DMA_V1(t + 1, sl_next), true, 2);
        ATT_STEP(pB0, pB1, pA0, pA1, t + 1, ATT_NOP(), ATT_NOP(), ATT_NOP(), ATT_NOP(), ATT_NOP(), false, 2);
    }
    W8Item wi; f32x4 wv[16]; float wg[16];
    { float sacc = 0.f;
#pragma unroll
      for (int r = 0; r < 16; ++r) sacc += pB0[r] + pB1[r];
      lsum += sacc;
#pragma unroll
      for (int q = 0; q < 4; ++q) { pw0[q] = ATT_PK(pB0, 2 * q); pw1[q] = ATT_PK(pB0, 8 + 2 * q); pw2[q] = ATT_PK(pB1, 2 * q); pw3[q] = ATT_PK(pB1, 8 + 2 * q); }
      ATT_WAIT_BAR(0);
      if (ditem >= 0) w8_load(lds, w8_deferred_S(ditem), lane, wid, wi, wv, wg);
      const unsigned vaddr = lds_u + (unsigned)sl_prev + (unsigned)vlane;
      ATT_VRD8(la, ha, 0); ATT_VRD8(lb2, hb2, 1);
      ATT_VWAIT(8, la, ha);
#pragma unroll
      for (int d = 0; d < 4; ++d) o[d] = ATT_MF(__builtin_bit_cast(bf16x8, pw0), ATT_VF(la, ha, d), o[d]);
      ATT_VRD8(la, ha, 2);
      ATT_VWAIT(8, lb2, hb2);
#pragma unroll
      for (int d = 0; d < 4; ++d) o[d] = ATT_MF(__builtin_bit_cast(bf16x8, pw1), ATT_VF(lb2, hb2, d), o[d]);
      ATT_VRD8(lb2, hb2, 3);
      ATT_VWAIT(8, la, ha);
#pragma unroll
      for (int d = 0; d < 4; ++d) o[d] = ATT_MF(__builtin_bit_cast(bf16x8, pw2), ATT_VF(la, ha, d), o[d]);
      ATT_VWAIT(0, lb2, hb2);
#pragma unroll
      for (int d = 0; d < 4; ++d) o[d] = ATT_MF(__builtin_bit_cast(bf16x8, pw3), ATT_VF(lb2, hb2, d), o[d]);
    }
#undef ATT_DMA_K
#undef ATT_DMA_V
#undef ATT_DMA_K0
#undef ATT_DMA_K1
#undef ATT_DMA_V0
#undef ATT_DMA_V1
    LAS float* wsf = (LAS float*)(lds + WSF_OFF) + wid * 64;
    lsum += __shfl_xor(lsum, 32);
    if (hi == 0) wsf[r32] = lsum;
    asm volatile("s_waitcnt lgkmcnt(0)" ::: "memory");
    float rl[16];
#pragma unroll
    for (int r = 0; r < 16; ++r) rl[r] = __builtin_amdgcn_rcpf(wsf[crow(r, hi)]);
    LAS unsigned short* X = (LAS unsigned short*)(lds + X_OFF) + wq * 4096;
    if (c == 1) {
#pragma unroll
        for (int d = 0; d < 4; ++d)
#pragma unroll
            for (int r = 0; r < 16; ++r) X[(d * 16 + r) * 64 + lane] = (unsigned short)(cvtpk(o[d][r] * (rl[r] * P.lam), 0.f) & 0xffffu);
    }
    asm volatile("s_waitcnt lgkmcnt(0)\n\ts_barrier" ::: "memory");
    if (c == 0) {
        float rs[16];
#pragma unroll
        for (int r = 0; r < 16; ++r) {
            float ss = 0.f;
#pragma unroll
            for (int d = 0; d < 4; ++d) { const float v = o[d][r] * rl[r] - bf2f(X[(d * 16 + r) * 64 + lane]); o[d][r] = v; ss += v * v; }
            ss += __shfl_xor(ss, 1); ss += __shfl_xor(ss, 2); ss += __shfl_xor(ss, 4); ss += __shfl_xor(ss, 8); ss += __shfl_xor(ss, 16);
            rs[r] = __builtin_amdgcn_rsqf(ss * (1.f / 128.f) + EPS) * P.one_minus_li;
        }
        asm volatile("s_waitcnt lgkmcnt(0)" ::: "memory");
        LAS unsigned short* stg = X;
#pragma unroll
        for (int d = 0; d < 4; ++d) { const float g = P.subln[32 * d + r32];
#pragma unroll
            for (int r = 0; r < 16; ++r) stg[crow(r, hi) * 128 + 32 * d + r32] = (unsigned short)(cvtpk(o[d][r] * rs[r] * g, 0.f) & 0xffffu); }
        asm volatile("s_waitcnt lgkmcnt(0)" ::: "memory");
        bf16_t* Ow = P.O + (rowbase + q0w) * DM + h * 128;
#pragma unroll
        for (int i = 0; i < 8; ++i) { const int idx = i * 64 + lane, row = idx >> 4, ch = idx & 15;
            const u32x4 v = *(const LAS u32x4*)((const LAS unsigned char*)stg + row * 256 + ch * 16);
            *(u32x4*)(Ow + (size_t)row * DM + ch * 8) = v; }
    }
    if (ditem >= 0) w8_finish(wi, wv, wg, wid);
}

__device__ __forceinline__ void attn_phase(const Params& P, LAS unsigned char* lds) {
    const int G = gridDim.x, bx = blockIdx.x;
    build_lut(lds, P.rel_bias);
    __syncthreads();
    if (G == 256) {
        const int x = bx & 7, j = bx >> 3;
        for (int r = 0; r < 16; ++r) { const int bh = x * 16 + r, dl = (r >> 1) * 256 + bx;
            attn_unit(P, bh >> 3, bh & 7, (r & 1) ? 31 - j : j, (!(r & 1) && dl < P.dcount) ? P.dbase + dl : -1, lds); }
    } else {
        for (int i = 0;; ++i) { const int p = bx + G * i; if (p >= 2048) break; const int bh = p >> 4, s2 = p & 15;
            attn_unit(P, bh >> 3, bh & 7, 31 - s2, -1, lds); attn_unit(P, bh >> 3, bh & 7, s2, -1, lds); }
    }
    __syncthreads();
}
}

#define BF_LO(u) __builtin_bit_cast(float, (u) << 16)
#define BF_HI(u) __builtin_bit_cast(float, (u) & 0xffff0000u)
template <int MODE>
__device__ __forceinline__ void row_pass(const float* xin, float* xout, bf16_t* xb, float* rstd, const unsigned char* Y, const int* tok_slot, const float* tok_w, unsigned char* x8, LAS unsigned char* lds) {
    const int tid = opaque_tid(), lane = tid & 63, wid = tid >> 6;
    const int ypos = 256 * (lane >> 5) + 64 * ((lane & 31) >> 3) + 16 * (lane & 3) + 8 * (((lane & 31) >> 2) & 1);
    LAS int* sl = (LAS int*)lds; LAS float* wl = (LAS float*)(lds + 2048);
    for (int blk = blockIdx.x; blk < NTOK / 256; blk += gridDim.x) {
        if (MODE != 0) { sl[tid] = tok_slot[blk * 512 + tid]; wl[tid] = tok_w[blk * 512 + tid]; __syncthreads(); }
        for (int it = 0; it < 8; ++it) {
            const int r0 = it * 32 + wid * 4, m0 = blk * 256 + r0;
            float v[4][2][8];
            if (MODE == 0) {
#pragma unroll
                for (int rr = 0; rr < 4; ++rr) { const f32x4* xr = (const f32x4*)(xin + (size_t)(m0 + rr) * DM + 8 * lane);
#pragma unroll
                    for (int j = 0; j < 2; ++j) { const f32x4 a = xr[128 * j], b = xr[128 * j + 1];
#pragma unroll
                        for (int i = 0; i < 4; ++i) { v[rr][j][i] = a[i]; v[rr][j][4 + i] = b[i]; } } }
            } else {
                u32x4 xq[4][2]; u32x2 ya[4][2], yb[4][2]; float w0[4], w1[4];
#pragma unroll
                for (int rr = 0; rr < 4; ++rr) { const int s0 = sl[2 * (r0 + rr)], s1 = sl[2 * (r0 + rr) + 1]; w0[rr] = wl[2 * (r0 + rr)] * (1.f / Y8_SCALE); w1[rr] = wl[2 * (r0 + rr) + 1] * (1.f / Y8_SCALE);
                    const bf16_t* xr = xb + (size_t)(m0 + rr) * DM + 8 * lane;
                    const unsigned char* y0 = Y + (size_t)s0 * DM + ypos; const unsigned char* y1 = Y + (size_t)s1 * DM + ypos;
#pragma unroll
                    for (int j = 0; j < 2; ++j) { xq[rr][j] = *(const u32x4*)(xr + 512 * j); ya[rr][j] = *(const u32x2*)(y0 + 512 * j); yb[rr][j] = *(const u32x2*)(y1 + 512 * j); } }
#pragma unroll
                for (int rr = 0; rr < 4; ++rr)
#pragma unroll
                    for (int j = 0; j < 2; ++j) { const u32x4 x = xq[rr][j];
#pragma unroll
                        for (int q = 0; q < 2; ++q) { const unsigned xa = q ? x.z : x.x, xc = q ? x.w : x.y; const int yaq = (int)(q ? ya[rr][j].y : ya[rr][j].x), ybq = (int)(q ? yb[rr][j].y : yb[rr][j].x);
                            const f32x2 a0 = __builtin_amdgcn_cvt_pk_f32_fp8(yaq, false), a1 = __builtin_amdgcn_cvt_pk_f32_fp8(yaq, true);
                            const f32x2 b0 = __builtin_amdgcn_cvt_pk_f32_fp8(ybq, false), b1 = __builtin_amdgcn_cvt_pk_f32_fp8(ybq, true);
                            v[rr][j][4 * q + 0] = BF_LO(xa) + w0[rr] * a0.x + w1[rr] * b0.x;
                            v[rr][j][4 * q + 1] = BF_HI(xa) + w0[rr] * a0.y + w1[rr] * b0.y;
                            v[rr][j][4 * q + 2] = BF_LO(xc) + w0[rr] * a1.x + w1[rr] * b1.x;
                            v[rr][j][4 * q + 3] = BF_HI(xc) + w0[rr] * a1.y + w1[rr] * b1.y; } }
            }
            if (MODE == 2) {
#pragma unroll
                for (int rr = 0; rr < 4; ++rr) { f32x4* xo = (f32x4*)(xout + (size_t)(m0 + rr) * DM + 8 * lane);
#pragma unroll
                    for (int j = 0; j < 2; ++j) { xo[128 * j] = (f32x4){v[rr][j][0], v[rr][j][1], v[rr][j][2], v[rr][j][3]}; xo[128 * j + 1] = (f32x4){v[rr][j][4], v[rr][j][5], v[rr][j][6], v[rr][j][7]}; } }
            } else {
#pragma unroll
                for (int rr = 0; rr < 4; ++rr) {
                    float ss = 0.f;
                    bf16_t* o8 = xb + (size_t)(m0 + rr) * DM + 8 * lane;
#pragma unroll
                    for (int j = 0; j < 2; ++j) {
#pragma unroll
                        for (int i = 0; i < 8; i += 2) ss += v[rr][j][i] * v[rr][j][i] + v[rr][j][i + 1] * v[rr][j][i + 1];
                        u32x4 w; w.x = cvtpk(v[rr][j][0], v[rr][j][1]); w.y = cvtpk(v[rr][j][2], v[rr][j][3]); w.z = cvtpk(v[rr][j][4], v[rr][j][5]); w.w = cvtpk(v[rr][j][6], v[rr][j][7]);
                        *(u32x4*)(o8 + 512 * j) = w;
                        if (MODE == 1 && x8) {
                            int lo = cvt8(v[rr][j][0] * X8_SCALE, v[rr][j][1] * X8_SCALE, 0, false); lo = cvt8(v[rr][j][2] * X8_SCALE, v[rr][j][3] * X8_SCALE, lo, true);
                            int h8 = cvt8(v[rr][j][4] * X8_SCALE, v[rr][j][5] * X8_SCALE, 0, false); h8 = cvt8(v[rr][j][6] * X8_SCALE, v[rr][j][7] * X8_SCALE, h8, true);
                            *(u32x2*)(x8 + (size_t)(m0 + rr) * DM + 512 * j + ypos) = (u32x2){(unsigned)lo, (unsigned)h8}; } }
                    ss = wave_sum(ss);
                    if (lane == 0) rstd[m0 + rr] = __builtin_amdgcn_rsqf(ss * (1.f / DM) + EPS);
                }
            }
        }
        if (MODE != 0) __syncthreads();
    }
}

__device__ __forceinline__ void router_pass(const bf16_t* x, const bf16_t* wt, const float* wg  , const float* bg, const float* be,
                                            float* rstd_out, int* tok_e, float* tok_w, int* cnt, LAS unsigned char* lds) {
    const int tid = opaque_tid(), lane = tid & 63, wid = tid >> 6, r32 = lane & 31, hi = lane >> 5;
    LAS f32x4* wgl = (LAS f32x4*)lds;
    LAS int* cntl = (LAS int*)(lds + 16384);
    for (int i = tid; i < 1024; i += NTHREADS) wgl[i] = *(const f32x4*)(wg + 4 * i);
    for (int blk = blockIdx.x; blk < NTOK / 256; blk += gridDim.x) {
        if (tid < NEXP) cntl[tid] = 0;
        __syncthreads();
        const int tok = blk * 256 + wid * 32 + r32;
        const u32x4* xp = (const u32x4*)(x + (size_t)tok * DM + 8 * hi);
        const u32x4* wph = (const u32x4*)wt + lane; const u32x4* wpl = wph + 64 * 64;
        const LAS f32x4* gp_ = wgl + 8 * hi;
        f32x16 D;
#pragma unroll
        for (int r = 0; r < 16; ++r) D[r] = 0.f;
        float ss = 0.f; f32x4 gl = {0.f, 0.f, 0.f, 0.f};
#pragma unroll 4
        for (int s = 0; s < 64; ++s) {
            const u32x4 xq_ = xp[2 * s], wh = wph[64 * s], wl = wpl[64 * s];
            D = __builtin_amdgcn_mfma_f32_32x32x16_bf16(__builtin_bit_cast(bf16x8, wh), __builtin_bit_cast(bf16x8, xq_), D, 0, 0, 0);
            D = __builtin_amdgcn_mfma_f32_32x32x16_bf16(__builtin_bit_cast(bf16x8, wl), __builtin_bit_cast(bf16x8, xq_), D, 0, 0, 0);
            const float xa[8] = {BF_LO(xq_.x), BF_HI(xq_.x), BF_LO(xq_.y), BF_HI(xq_.y), BF_LO(xq_.z), BF_HI(xq_.z), BF_LO(xq_.w), BF_HI(xq_.w)};
#pragma unroll
            for (int j = 0; j < 8; ++j) { gl += gp_[16 * s + j] * xa[j]; ss += xa[j] * xa[j]; }
        }
        ss += __shfl_xor(ss, 32);
#pragma unroll
        for (int g = 0; g < 4; ++g) gl[g] += __shfl_xor(gl[g], 32);
        const float rs = __builtin_amdgcn_rsqf(ss * (1.f / DM) + EPS);
        float glg[4]; float gmax = -INFINITY; int gidx = 0;
#pragma unroll
        for (int g = 0; g < 4; ++g) { glg[g] = gl[g] * rs + bg[g]; if (glg[g] > gmax) { gmax = glg[g]; gidx = g; } }
        float gsum = 0.f;
#pragma unroll
        for (int g = 0; g < 4; ++g) gsum += __expf(glg[g] - gmax);
        const float gprob = 1.f / gsum;
        float own[4], oth[4], v[8];
#pragma unroll
        for (int i = 0; i < 4; ++i) { const float d = gidx == 0 ? D[i] : gidx == 1 ? D[4 + i] : gidx == 2 ? D[8 + i] : D[12 + i];
            own[i] = d * rs + be[8 * gidx + 4 * hi + i]; oth[i] = __shfl_xor(own[i], 32); }
#pragma unroll
        for (int i = 0; i < 4; ++i) { v[i] = hi ? oth[i] : own[i]; v[4 + i] = hi ? own[i] : oth[i]; }
        int i1 = 0; float v1 = v[0];
#pragma unroll
        for (int i = 1; i < 8; ++i) if (v[i] > v1) { v1 = v[i]; i1 = i; }
        int i2 = -1; float v2 = -INFINITY;
#pragma unroll
        for (int i = 0; i < 8; ++i) if (i != i1 && v[i] > v2) { v2 = v[i]; i2 = i; }
        const float w1 = gprob / (1.f + __expf(v2 - v1)), w2 = gprob - w1;
        if (hi == 0) {
            const int e1 = 8 * gidx + i1, e2 = 8 * gidx + i2;
            tok_e[2 * tok] = e1; tok_e[2 * tok + 1] = e2; tok_w[2 * tok] = w1; tok_w[2 * tok + 1] = w2; rstd_out[tok] = rs;
            atomicAdd((int*)&cntl[e1], 1); atomicAdd((int*)&cntl[e2], 1);
        }
        __syncthreads();
        if (tid < NEXP) cnt[blk * NEXP + tid] = cntl[tid];
        __syncthreads();
    }
}

__device__ __forceinline__ void assign_pass(const int* cnt, const int* tok_e, const float* rstd_ffn, int* tok_slot, int* slot_tok, float* slot_rs, LAS unsigned char* lds) {
    const int tid = opaque_tid(), lane = tid & 63, wid = tid >> 6;
    LAS int* pall = (LAS int*)lds;
    LAS int* plt = pall + 512;
    LAS int* total = plt + 512;
    LAS int* mybase = total + 32;
    LAS int* wcnt = mybase + 32;
    LAS int* ts = (LAS int*)(lds + TS_OFF);
    { const int e = tid & 31, p = tid >> 5; int a = 0;
      for (int b = 16 * p; b < 16 * p + 16; ++b) a += cnt[b * NEXP + e];
      pall[p * 32 + e] = a; }
    __syncthreads();
    if (tid < NEXP) { int a = 0; for (int p = 0; p < 16; ++p) a += pall[p * 32 + tid]; total[tid] = a; }
    __syncthreads();
    if (tid == 0) { int acc = 0; for (int e = 0; e < NEXP; ++e) { ts[e] = acc; acc += (total[e] + 255) >> 8; } ts[NEXP] = acc; }
    __syncthreads();
    for (int blk = blockIdx.x; blk < NTOK / 256; blk += gridDim.x) {
        { const int e = tid & 31, p = tid >> 5; int l = 0;
          for (int b = 16 * p; b < 16 * p + 16; ++b) { const int c = cnt[b * NEXP + e]; if (b < blk) l += c; }
          plt[p * 32 + e] = l; }
        int e0 = -1, e1 = -1, r0 = 0, r1 = 0; float rs = 0.f;
        if (tid < 256) { const int tok = blk * 256 + tid; e0 = tok_e[2 * tok]; e1 = tok_e[2 * tok + 1]; rs = rstd_ffn[tok]; }
        if (wid < 4) {
            const unsigned long long lt = (1ull << lane) - 1ull;
#pragma unroll 4
            for (int e = 0; e < NEXP; ++e) {
                const unsigned long long m = __ballot(e0 == e || e1 == e);
                const int r = __popcll(m & lt);
                if (e0 == e) r0 = r;
                if (e1 == e) r1 = r;
                if (lane == 0) wcnt[e * 4 + wid] = __popcll(m);
            }
        }
        __syncthreads();
        if (tid < NEXP) { int l = 0; for (int p = 0; p < 16; ++p) l += plt[p * 32 + tid]; mybase[tid] = l; }
        __syncthreads();
        if (tid < 256) {
            const int tok = blk * 256 + tid;
            int p0 = ts[e0] * 256 + mybase[e0] + r0, p1 = ts[e1] * 256 + mybase[e1] + r1;
            for (int w = 0; w < wid; ++w) { p0 += wcnt[e0 * 4 + w]; p1 += wcnt[e1 * 4 + w]; }
            tok_slot[2 * tok] = p0; tok_slot[2 * tok + 1] = p1;
            slot_tok[p0] = tok; slot_tok[p1] = tok; slot_rs[p0] = rs; slot_rs[p1] = rs;
        }
        if (blk == 0) {
            for (int e = 0; e < NEXP; ++e) for (int p = ts[e] * 256 + total[e] + tid; p < ts[e + 1] * 256; p += NTHREADS) { slot_tok[p] = 0; slot_rs[p] = 0.f; }
        }
        __syncthreads();
    }
}

__device__ __forceinline__ void pool_pass(const bf16_t* U, unsigned char* Pq) {
    const int tid = opaque_tid(), lane = tid & 63, wid = tid >> 6;
    for (int task = blockIdx.x * NWAVES + wid; task < (NTOK / 64) * 2; task += gridDim.x * NWAVES) {
        const int rb = task >> 1, half = task & 1, T0 = rb * 64, col = half * 512 + lane * 8, w = 2 << (half * 2 + (lane >> 5)), tp0 = T0 & (SEQ - 1);
        float S[8];
#pragma unroll
        for (int k = 0; k < 8; ++k) S[k] = 0.f;
#define PL_LD(dst, row) do { const u32x4 q_ = *(const u32x4*)(U + (size_t)(row) * DM + col); \
        dst[0] = __builtin_bit_cast(float, q_.x << 16); dst[1] = __builtin_bit_cast(float, q_.x & 0xffff0000u); dst[2] = __builtin_bit_cast(float, q_.y << 16); dst[3] = __builtin_bit_cast(float, q_.y & 0xffff0000u); \
        dst[4] = __builtin_bit_cast(float, q_.z << 16); dst[5] = __builtin_bit_cast(float, q_.z & 0xffff0000u); dst[6] = __builtin_bit_cast(float, q_.w << 16); dst[7] = __builtin_bit_cast(float, q_.w & 0xffff0000u); } while (0)
        for (int jj = 1; jj < 16; ++jj) if (jj < w && tp0 - jj >= 0) { float a[8]; PL_LD(a, T0 - jj);
#pragma unroll
            for (int k = 0; k < 8; ++k) S[k] += a[k]; }
#define PL_UNP(dst, q_) do { dst[0] = __builtin_bit_cast(float, q_.x << 16); dst[1] = __builtin_bit_cast(float, q_.x & 0xffff0000u); dst[2] = __builtin_bit_cast(float, q_.y << 16); dst[3] = __builtin_bit_cast(float, q_.y & 0xffff0000u); \
        dst[4] = __builtin_bit_cast(float, q_.z << 16); dst[5] = __builtin_bit_cast(float, q_.z & 0xffff0000u); dst[6] = __builtin_bit_cast(float, q_.w << 16); dst[7] = __builtin_bit_cast(float, q_.w & 0xffff0000u); } while (0)
        for (int i0 = 0; i0 < 64; i0 += 8) {
            u32x4 cq[8], aq[8];
#pragma unroll
            for (int i = 0; i < 8; ++i) { const int t = T0 + i0 + i, tp = tp0 + i0 + i;
                cq[i] = *(const u32x4*)(U + (size_t)t * DM + col);
                aq[i] = (tp - (w - 1) >= 0) ? *(const u32x4*)(U + (size_t)(t - (w - 1)) * DM + col) : (u32x4){0u, 0u, 0u, 0u}; }
#pragma unroll
            for (int i = 0; i < 8; ++i) { const int t = T0 + i0 + i, tp = tp0 + i0 + i; float c[8], a[8]; PL_UNP(c, cq[i]); PL_UNP(a, aq[i]);
                const int n = tp + 1 < w ? tp + 1 : w; const float inv = 1.f / (float)n;
                float o[8];
#pragma unroll
                for (int k = 0; k < 8; ++k) { S[k] += c[k]; o[k] = S[k] * inv - c[k]; S[k] -= a[k]; }
                int lo = cvt8(o[0] * A8_SCALE, o[1] * A8_SCALE, 0, false); lo = cvt8(o[2] * A8_SCALE, o[3] * A8_SCALE, lo, true);
                int hi = cvt8(o[4] * A8_SCALE, o[5] * A8_SCALE, 0, false); hi = cvt8(o[6] * A8_SCALE, o[7] * A8_SCALE, hi, true);
                *(u32x2*)(Pq + (size_t)t * DM + col) = (u32x2){(unsigned)lo, (unsigned)hi}; }
        }
#undef PL_UNP
#undef PL_LD
    }
}

constexpr int ARG_OFF = attn::WSF_OFF + NWAVES * 256;
static_assert(ARG_OFF + 27 * 8 <= LDS_BYTES, "LDS map (args)");
__device__ __forceinline__ const void* arg_ptr(LAS unsigned char* lds, int i) {
    const unsigned long long v = ((const LAS unsigned long long*)(lds + ARG_OFF))[i];
    const unsigned lo = __builtin_amdgcn_readfirstlane((unsigned)v), hi = __builtin_amdgcn_readfirstlane((unsigned)(v >> 32));
    return (const void*)(const __attribute__((address_space(1))) char*)(((unsigned long long)hi << 32) | lo);
}
#define INP(i) ((const float*)arg_ptr(lds, (i)))
#define OUTP() ((float*)arg_ptr(lds, 25))
#define WSP() ((unsigned char*)arg_ptr(lds, 26))


__device__ __forceinline__ size_t wt_image_off(int n, int k, int Kd) {
    const int pn = n >> 8, nr = n & 255, wc = nr >> 6, bj = (nr >> 5) & 1, x = nr & 31, rho = 16 * ((x >> 2) & 1) + 4 * (x >> 3) + (x & 3);
    const int kt = k >> 6, kk = k & 63;
    return ((size_t)((pn * (Kd >> 6) + kt) * 2 + bj) * 16384 + pg8::lds_byte(wc * 32 + rho, kk)) >> 1;
}
__device__ __forceinline__ size_t wt_image_off8(int n, int k, int Kd) {
    const int pn = n >> 8, nr = n & 255, wc = nr >> 6, bj = (nr >> 5) & 1, x = nr & 31, rho = 16 * ((x >> 2) & 1) + 4 * (x >> 3) + (x & 3);
    const int kt = k >> 7, kb = k & 127;
    return (size_t)((pn * (Kd >> 7) + kt) * 2 + bj) * 16384 + pg8::lds_byte(wc * 32 + rho, kb >> 1);
}
struct TrDesc { const float* W; const float* gain; bf16_t* WT; int N, k0, n0, Kd, drow0; int f8; float f8s; };
__device__ __forceinline__ void tr_load(const TrDesc& d, f32x4 (&v)[8], float (&g)[8], int lane) {
    const int kr = lane >> 3, n4 = (lane & 7) * 4;
#pragma unroll
    for (int i = 0; i < 8; ++i) { v[i] = *(const f32x4*)(d.W + (size_t)(d.k0 + 8 * i + kr) * d.N + d.n0 + n4); g[i] = d.gain ? d.gain[d.k0 + 8 * i + kr] : 1.f; }
}
__device__ __forceinline__ void tr_finish(const TrDesc& d, const f32x4 (&v)[8], const float (&g)[8], LAS float* scr, int lane) {
    const int kr = lane >> 3, n4 = (lane & 7) * 4;
#pragma unroll
    for (int i = 0; i < 8; ++i) { LAS float* q = scr + (8 * i + kr) * 33 + n4; q[0] = v[i][0] * g[i]; q[1] = v[i][1] * g[i]; q[2] = v[i][2] * g[i]; q[3] = v[i][3] * g[i]; }
    asm volatile("s_waitcnt lgkmcnt(0)" ::: "memory");
    if (d.f8) {
#pragma unroll
        for (int j = 0; j < 2; ++j) { const int pc = lane * 2 + j, n = pc >> 2, kg = pc & 3; const float fs = d.f8s;
            u32x4 o;
#pragma unroll
            for (int q = 0; q < 4; ++q) { const int kb = d.f8 == 2 ? (q >> 1) * 32 + 8 * kg + 4 * (q & 1) : 16 * kg + 4 * q; const LAS float* t = scr + kb * 33 + n;
                int r = cvt8(t[0] * fs, t[33] * fs, 0, false);
                r = cvt8(t[66] * fs, t[99] * fs, r, true); o[q] = (unsigned)r; }
            *(u32x4*)((unsigned char*)d.WT + wt_image_off8(d.drow0 + n, d.k0 + 16 * kg, d.Kd)) = o; }
        asm volatile("s_waitcnt lgkmcnt(0)" ::: "memory");
        return;
    }
    const int c = lane & 7;
#pragma unroll
    for (int j = 0; j < 4; ++j) { const int n = (lane >> 3) + 8 * j; const LAS float* t = scr + (8 * c) * 33 + n;
        u32x4 o; o.x = cvtpk(t[0 * 33], t[1 * 33]); o.y = cvtpk(t[2 * 33], t[3 * 33]); o.z = cvtpk(t[4 * 33], t[5 * 33]); o.w = cvtpk(t[6 * 33], t[7 * 33]);
        *(u32x4*)(d.WT + wt_image_off(d.drow0 + n, d.k0 + 8 * c, d.Kd)) = o; }
    asm volatile("s_waitcnt lgkmcnt(0)" ::: "memory");
}
struct Args { const float* in[25]; float* out; unsigned char* ws; };
enum { I_X = 0, I_RELB, I_ANORM, I_WQKV, I_QG, I_KG, I_LQ1, I_LK1, I_LQ2, I_LK2, I_SUBLN, I_WO, I_PNORM, I_PWIN, I_PWG, I_PWOUT, I_PSCALE, I_FNORM, I_RGW, I_RGB, I_REW, I_REB, I_WGATE, I_WUP, I_WDOWN };

__device__ __forceinline__ TrDesc tr_decode(LAS unsigned char* lds, unsigned char* ws, int it) {
    constexpr int N_QKV = 2 * 16 * 96;
    TrDesc d; d.f8 = 0; d.f8s = 1.f;
    if (it < N_QKV) { const int l = it / 1536, r = it - l * 1536, kb = r / 96, nb = r - kb * 96;
        d.W = INP(I_WQKV) + (size_t)l * 1024 * 3072; d.N = 3072; d.k0 = 64 * kb; d.n0 = 32 * nb; d.WT = (bf16_t*)(ws + WS_WQKV) + (size_t)l * 3072 * 1024; d.Kd = 1024; d.drow0 = 32 * nb; d.gain = INP(I_ANORM) + l * 1024; return d; }
    it -= N_QKV;
    { const int l = it >> 9, r = it & 511, kb = r >> 5, nb = r & 31;
      d.W = INP(I_WO) + (size_t)l * 1024 * 1024; d.N = 1024; d.k0 = 64 * kb; d.n0 = 32 * nb; d.WT = (bf16_t*)(ws + WS_WO) + (size_t)l * 1024 * 1024; d.Kd = 1024; d.drow0 = 32 * nb; d.gain = nullptr; }
    return d;
}
__device__ __forceinline__ void w8_load(LAS unsigned char* lds, int S0, int lane, int wid, W8Item& d, f32x4 (&v)[16], float (&g)[16]) {
    constexpr int S_GU = W8_SGU, S_DN = W8_SDN;
    unsigned char* ws = WSP();
    const int S = __builtin_amdgcn_readfirstlane(S0);
    const float* gain; bool perm;
    if (S < S_GU) { const int le = S >> 5, r = S & 31, isup = r >> 4, kt = (r >> 1) & 7, nh = r & 1;
        d.W = (isup ? INP(I_WUP) : INP(I_WGATE)) + (size_t)le * 1024 * 512; d.N = 512; d.k0 = 128 * kt; d.n = 256 * nh + 4 * lane; d.WT = ws + WS_WGU + (size_t)le * 1024 * 1024; d.Kd = 1024;
        d.drow = 256 * (d.n >> 7) + 64 * ((d.n >> 5) & 3) + 32 * isup + (d.n & 31); gain = INP(I_FNORM) + (le >> 5) * 1024; perm = true; d.fs = WG8_SCALE; }
    else if (S < S_GU + S_DN) { const int i2 = S - S_GU, le = i2 >> 4, r = i2 & 15, kt = r >> 2, nq = r & 3;
        d.W = INP(I_WDOWN) + (size_t)le * 512 * 1024; d.N = 1024; d.k0 = 128 * kt; d.n = 256 * nq + 4 * lane; d.WT = ws + WS_WDN + (size_t)le * 1024 * 512; d.Kd = 512; d.drow = d.n; gain = nullptr; perm = false; d.fs = WD8_SCALE; }
    else { const int i3 = S - S_GU - S_DN, l = i3 >> 5, r = i3 & 31, kt = r >> 2, nq = r & 3;
        d.W = INP(I_PWOUT) + (size_t)l * 1024 * 1024; d.N = 1024; d.k0 = 128 * kt; d.n = 256 * nq + 4 * lane; d.WT = ws + WS_WPO + (size_t)l * 1024 * 1024; d.Kd = 1024; d.drow = d.n; gain = nullptr; perm = false; d.fs = WN8_SCALE; }
    d.r0 = perm ? 64 * (wid >> 2) + 8 * (wid & 3) : 16 * wid; d.r1 = perm ? d.r0 + 32 : d.r0 + 8;
    d.hasg = gain ? 1 : 0;
    d.gp = gain ? gain : d.W;
#pragma unroll
    for (int j = 0; j < 8; ++j) { v[j] = *(const f32x4*)(d.W + (size_t)(d.k0 + d.r0 + j) * d.N + d.n); v[8 + j] = *(const f32x4*)(d.W + (size_t)(d.k0 + d.r1 + j) * d.N + d.n);
        g[j] = d.gp[d.k0 + d.r0 + j]; g[8 + j] = d.gp[d.k0 + d.r1 + j]; }
}
__device__ __forceinline__ void w8_finish(const W8Item& d, const f32x4 (&v)[16], float (&g)[16], int wid) {
#pragma unroll
    for (int j = 0; j < 16; ++j) g[j] = d.hasg ? g[j] * d.fs : d.fs;
#pragma unroll
    for (int c = 0; c < 4; ++c) {
        u32x4 o;
#pragma unroll
        for (int q = 0; q < 4; ++q) { int r = cvt8(v[4 * q][c] * g[4 * q], v[4 * q + 1][c] * g[4 * q + 1], 0, false); r = cvt8(v[4 * q + 2][c] * g[4 * q + 2], v[4 * q + 3][c] * g[4 * q + 3], r, true); o[q] = (unsigned)r; }
        *(u32x4*)(d.WT + wt_image_off8(d.drow + c, d.k0 + 16 * wid, d.Kd)) = o;
    }
}
__device__ __forceinline__ void w8_items(LAS unsigned char* lds, int lane, int wid) {
    const bool defer = gridDim.x == 256;
    const int NP = defer ? W8_PER_LAYER + W8_EARLY1 + W8_SPO : W8_SGU + W8_SDN + W8_SPO;
    for (int p = blockIdx.x; p < NP; p += gridDim.x) {
        const int S = !defer ? p : p < 1024 ? p : p < W8_PER_LAYER ? W8_SGU + (p - 1024) : p < W8_PER_LAYER + W8_EARLY1 ? 1024 + (p - W8_PER_LAYER) : W8_SGU + W8_SDN + (p - W8_PER_LAYER - W8_EARLY1);
        W8Item d; f32x4 v[16]; float g[16];
        w8_load(lds, S, lane, wid, d, v, g);
        w8_finish(d, v, g, wid);
    }
}
__device__ __forceinline__ void prologue(LAS unsigned char* lds) {
    const int tid = opaque_tid(), lane = tid & 63, wid = tid >> 6;
    LAS float* scr = (LAS float*)(lds + wid * 16384);
    const int gw = blockIdx.x * NWAVES + wid, NGW = gridDim.x * NWAVES;
    unsigned char* ws = WSP();
    constexpr int N_QKV = 2 * 16 * 96, N_WO = 2 * 16 * 32, N_PC = 2 * 64 * 16;
    constexpr int NTR = N_QKV + N_WO;
    w8_items(lds, lane, __builtin_amdgcn_readfirstlane(wid));
    if (gw < NTR) {
        TrDesc dA = tr_decode(lds, ws, gw), dB; f32x4 va[8], vb[8]; float ga[8], gb[8];
        tr_load(dA, va, ga, lane);
        for (int itA = gw;;) {
            const int itB = itA + NGW; const bool hasB = itB < NTR;
            if (hasB) { dB = tr_decode(lds, ws, itB); tr_load(dB, vb, gb, lane); }
            tr_finish(dA, va, ga, scr, lane);
            if (!hasB) break;
            itA = itB + NGW; const bool hasA = itA < NTR;
            if (hasA) { dA = tr_decode(lds, ws, itA); tr_load(dA, va, ga, lane); }
            tr_finish(dB, vb, gb, scr, lane);
            if (!hasA) break;
        }
    }
    for (int it = gw; it < N_PC; it += NGW) {
        {
            const int l = it >> 10, r = it & 1023, kt = r >> 7, p = (r >> 4) & 7, kb0 = 128 * kt + 64 * (p >> 2) + 8 * (p & 3), n0 = (r & 15) * 64, g = n0 >> 8, e = (n0 & 255) + lane;
            const float* win = INP(I_PWIN) + (size_t)l * 1024 * 1024 + g * 256;
            const float* wgp = INP(I_PWG) + (size_t)l * 4 * 256 * 256 + (size_t)g * 256 * 256 + e;
            float acc[16];
#pragma unroll
            for (int kk = 0; kk < 16; ++kk) acc[kk] = 0.f;
            {
                f32x4 wv[16];
#pragma unroll
                for (int kk = 0; kk < 16; ++kk) wv[kk] = *(const f32x4*)(win + (size_t)(kb0 + (kk & 7) + 32 * (kk >> 3)) * 1024 + 4 * lane);
#pragma unroll
                for (int kk = 0; kk < 16; ++kk) *(LAS f32x4*)(scr + kk * 256 + 4 * lane) = wv[kk];
                asm volatile("s_waitcnt lgkmcnt(0)" ::: "memory"); }
#pragma unroll 8
            for (int c4 = 0; c4 < 64; ++c4) {
                float b[4];
#pragma unroll
                for (int cc = 0; cc < 4; ++cc) b[cc] = wgp[(size_t)(4 * c4 + cc) * 256];
#pragma unroll
                for (int kk = 0; kk < 16; ++kk) { const f32x4 av = *(const LAS f32x4*)(scr + kk * 256 + 4 * c4); acc[kk] += (av[0] * b[0] + av[1] * b[1]) + (av[2] * b[2] + av[3] * b[3]); }
            }
            const float* pn = INP(I_PNORM) + l * 1024 + kb0;
            u32x4 o;
#pragma unroll
            for (int q = 0; q < 4; ++q) { const int j0 = 4 * q, kq = (j0 & 7) + 32 * (j0 >> 3);
                int rr = cvt8(acc[j0] * pn[kq] * WPC8_SCALE, acc[j0 + 1] * pn[kq + 1] * WPC8_SCALE, 0, false);
                rr = cvt8(acc[j0 + 2] * pn[kq + 2] * WPC8_SCALE, acc[j0 + 3] * pn[kq + 3] * WPC8_SCALE, rr, true); o[q] = (unsigned)rr; }
            *(u32x4*)(ws + WS_WPC + (size_t)l * 1024 * 1024 + wt_image_off8(n0 + lane, 128 * kt + 16 * p, 1024)) = o;
            asm volatile("s_waitcnt lgkmcnt(0)" ::: "memory");
        }
    }
    float* rwt = (float*)(ws + WS_RWT); float* rwg = (float*)(ws + WS_RWG);
    { bf16_t* rwb = (bf16_t*)rwt;
      for (int i = blockIdx.x * NTHREADS + tid; i < DEPTH * NEXP * DM; i += gridDim.x * NTHREADS) { const int l = i >> 15, r = i & 32767, sx = r >> 9, ln = (r >> 3) & 63, jj = r & 7, k = 16 * sx + 8 * (ln >> 5) + jj, e = ln & 31;
        const float v = INP(I_FNORM)[l * 1024 + k] * INP(I_REW)[(size_t)l * 1024 * 32 + k * 32 + e];
        const unsigned hb = cvtpk(v, 0.f) & 0xffffu; const float vh = __builtin_bit_cast(float, hb << 16);
        rwb[(size_t)l * 65536 + r] = (bf16_t)hb; rwb[(size_t)l * 65536 + 32768 + r] = (bf16_t)(cvtpk(v - vh, 0.f) & 0xffffu); } }
    for (int i = blockIdx.x * NTHREADS + tid; i < DEPTH * DM * NGRP; i += gridDim.x * NTHREADS) { const int l = i >> 12, k = (i >> 2) & 1023;
        rwg[i] = INP(I_FNORM)[l * 1024 + k] * INP(I_RGW)[i]; }
}

__device__ __forceinline__ void moe_layer(LAS unsigned char* lds, const XcdBarrier& bar, const int L, const bool fin) {
    const LAS int* ts = (const LAS int*)(lds + TS_OFF);
    {   unsigned char* ws = WSP();
        router_pass((const bf16_t*)(ws + WS_XB), (const bf16_t*)(ws + WS_RWT) + (size_t)L * 65536, (const float*)(ws + WS_RWG) + (size_t)L * DM * NGRP, INP(I_RGB) + L * NGRP, INP(I_REB) + L * NEXP,
                    (float*)(ws + WS_RSFFN), (int*)(ws + WS_TOKE), (float*)(ws + WS_TOKW), (int*)(ws + WS_CNT), lds); }
    xcd_barrier(bar);
    {   unsigned char* ws = WSP();
        assign_pass((const int*)(ws + WS_CNT), (const int*)(ws + WS_TOKE), (const float*)(ws + WS_RSFFN), (int*)(ws + WS_TOKS), (int*)(ws + WS_SLOTTOK), (float*)(ws + WS_SLOTRS), lds); }
    xcd_barrier(bar);
    {   unsigned char* ws = WSP();
        GroupSched S; S.init_grid(); S.A = (const char*)(ws + WS_ACT + ACT_X8); S.lda = DM; S.slot_tok = (const int*)(ws + WS_SLOTTOK); S.Bt = (const char*)(ws + WS_WGU) + (size_t)L * NEXP * 1024 * 1024; S.strideE = (size_t)1024 * 1024; S.K = DM / 2; S.ts = ts;
        EpiGateUp E{ws + WS_ACT + ACT_H, (const float*)(ws + WS_SLOTRS)};
        int kx = DM; asm volatile("" : "+s"(kx));
        pg8::gemm_phase<EpiGateUp, GroupSched, true, true>(lds, kx, S, E); }
    xcd_barrier(bar);
    {   unsigned char* ws = WSP();
        GroupSched S; S.init_grid(); S.A = (const char*)(ws + WS_ACT + ACT_H); S.lda = EFF; S.slot_tok = nullptr; S.Bt = (const char*)(ws + WS_WDN) + (size_t)L * NEXP * 1024 * 512; S.strideE = (size_t)1024 * 512; S.K = EFF / 2; S.ts = ts;
        EpiY8 E{ws + WS_ACT + ACT_Y};
        int kx = EFF; asm volatile("" : "+s"(kx));
        pg8::gemm_phase<EpiY8, GroupSched, true, true>(lds, kx, S, E); }
    xcd_barrier(bar);
    {   unsigned char* ws = WSP(); float* xo = OUTP();
        if (fin) row_pass<2>(nullptr, xo, (bf16_t*)(ws + WS_XB), nullptr, (const unsigned char*)(ws + WS_ACT + ACT_Y), (const int*)(ws + WS_TOKS), (const float*)(ws + WS_TOKW), nullptr, lds);
        else { row_pass<1>(nullptr, nullptr, (bf16_t*)(ws + WS_XB), (float*)(ws + WS_RSMIX), (const unsigned char*)(ws + WS_ACT + ACT_Y), (const int*)(ws + WS_TOKS), (const float*)(ws + WS_TOKW), (L & 1) ? nullptr : ws + WS_ACT + ACT_X8, lds); } }
    if (!fin) xcd_barrier(bar);
}

__global__ void __launch_bounds__(NTHREADS, 2) hybrid_fwd(Args a) {
    extern __shared__ __attribute__((aligned(16))) unsigned char lds_raw[];
    LAS unsigned char* lds = (LAS unsigned char*)lds_raw;
    volatile LAS unsigned* MISC = (volatile LAS unsigned*)(lds + MISC_OFF);
    const int tid = threadIdx.x;
    if (tid < 64) MISC[tid] = 0u;
    if (tid < 27) ((LAS unsigned long long*)(lds + ARG_OFF))[tid] = ((const __attribute__((address_space(4))) unsigned long long*)__builtin_amdgcn_kernarg_segment_ptr())[tid];
    __syncthreads();
    XcdBarrier bar = xcd_barrier_post((unsigned*)(a.ws + WS_CTL) + CW_BAR, MISC + 8);

    prologue(lds);
    {   unsigned char* ws = WSP();
        row_pass<0>(INP(I_X), nullptr, (bf16_t*)(ws + WS_XB), (float*)(ws + WS_RSMIX), nullptr, nullptr, nullptr, nullptr, lds); }
    xcd_barrier(bar);

    for (int lp = 0; lp < 2; ++lp) {
        {   unsigned char* ws = WSP();
            PlainSched S; S.init_grid(); S.A = (const char*)(ws + WS_XB); S.lda = DM * 2; S.Bt = (const char*)(ws + WS_WQKV) + (size_t)lp * 3072 * 1024 * 2; S.K = DM; S.nN = 12; S.nrt = NTOK / 256;
            LAS float* gl = (LAS float*)(lds + attn::WSF_OFF);
            { const int t_ = opaque_tid(); if (t_ < 128) gl[t_] = t_ < 64 ? INP(I_QG)[lp * HD + t_] : INP(I_KG)[lp * HD + t_ - 64]; }
            __syncthreads();
            EpiQKV E{(bf16_t*)(ws + WS_ACT + ACT_Q), (const float*)(ws + WS_RSMIX), gl};
            pg8::gemm_phase<EpiQKV, PlainSched, true>(lds, DM, S, E); }
        xcd_barrier(bar);
        {   unsigned char* ws = WSP();
            const float* lq1 = INP(I_LQ1) + lp * HD; const float* lk1 = INP(I_LK1) + lp * HD; const float* lq2 = INP(I_LQ2) + lp * HD; const float* lk2 = INP(I_LK2) + lp * HD;
            float d1 = 0.f, d2 = 0.f;
            for (int i = 0; i < HD; ++i) { d1 += lq1[i] * lk1[i]; d2 += lq2[i] * lk2[i]; }
            const float li = 0.8f - 0.6f * expf(-0.3f * (float)(2 * lp));
            bf16_t* Qb = (bf16_t*)(ws + WS_ACT + ACT_Q);
            attn::Params P{Qb, Qb + (size_t)NTOK * DM, Qb + (size_t)2 * NTOK * DM, Qb, INP(I_RELB), INP(I_SUBLN) + lp * 128, expf(d1) - expf(d2) + li, 1.f - li, lp == 0 ? 0 : 2048, 2048};
            attn::attn_phase(P, lds); }
        xcd_barrier(bar);
        {   unsigned char* ws = WSP(); float* xo = OUTP();
            PlainSched S; S.init_grid(); S.A = (const char*)(ws + WS_ACT + ACT_Q); S.lda = DM * 2; S.Bt = (const char*)(ws + WS_WO) + (size_t)lp * 1024 * 1024 * 2; S.K = DM; S.nN = 4; S.nrt = NTOK / 256;
            EpiRes E{(bf16_t*)(ws + WS_XB), nullptr, ws + WS_ACT + ACT_X8, 1.f};
            pg8::gemm_phase<EpiRes, PlainSched, true>(lds, DM, S, E); }
        xcd_barrier(bar);
        moe_layer(lds, bar, 2 * lp, false);
        {   unsigned char* ws = WSP();
            PlainSched S; S.init_grid(); S.A = (const char*)(ws + WS_ACT + ACT_X8); S.lda = DM; S.Bt = (const char*)(ws + WS_WPC) + (size_t)lp * 1024 * 1024; S.K = DM / 2; S.nN = 4; S.nrt = NTOK / 256;
            EpiBf16 E{(bf16_t*)(ws + WS_ACT + ACT_U), DM, (const float*)(ws + WS_RSMIX), 1.f / (X8_SCALE * WPC8_SCALE)};
            int kx = DM; asm volatile("" : "+s"(kx));
            pg8::gemm_phase<EpiBf16, PlainSched, true, true>(lds, kx, S, E); }
        xcd_barrier(bar);
        {   unsigned char* ws = WSP(); pool_pass((const bf16_t*)(ws + WS_ACT + ACT_U), ws + WS_ACT + ACT_P); }
        xcd_barrier(bar);
        {   unsigned char* ws = WSP(); float* xo = OUTP();
            PlainSched S; S.init_grid(); S.A = (const char*)(ws + WS_ACT + ACT_P); S.lda = DM; S.Bt = (const char*)(ws + WS_WPO) + (size_t)lp * 1024 * 1024; S.K = DM / 2; S.nN = 4; S.nrt = NTOK / 256;
            EpiRes E{(bf16_t*)(ws + WS_XB), INP(I_PSCALE) + lp * DM, ws + WS_ACT + ACT_X8, 1.f / (A8_SCALE * WN8_SCALE)};
            int kx = DM; asm volatile("" : "+s"(kx));
            pg8::gemm_phase<EpiRes, PlainSched, true, true>(lds, kx, S, E); }
        xcd_barrier(bar);
        moe_layer(lds, bar, 2 * lp + 1, lp == 1);
    }
}

extern "C" void kernel_launch(void* const* d_in, const int* in_sizes, int n_in, void* d_out, int out_size, void* d_ws, size_t ws_size, hipStream_t stream) {
    static int grid = 0;
    if (grid == 0) {
        if (n_in != 25 || out_size != NTOK * DM || ws_size < WS_END) { fprintf(stderr, "kernel_launch: unexpected problem (n_in %d, out %d, ws %zu)\n", n_in, out_size, ws_size); grid = -1; return; }
        int dev = 0, cus = 0;
        if (hipGetDevice(&dev) != hipSuccess || hipDeviceGetAttribute(&cus, hipDeviceAttributeMultiprocessorCount, dev) != hipSuccess) { grid = -1; return; }
        if (hipFuncSetAttribute((const void*)hybrid_fwd, hipFuncAttributeMaxDynamicSharedMemorySize, LDS_BYTES) != hipSuccess) { fprintf(stderr, "kernel_launch: hipFuncSetAttribute failed\n"); grid = -1; return; }
        int per_cu = 0;
        if (hipOccupancyMaxActiveBlocksPerMultiprocessor(&per_cu, (const void*)hybrid_fwd, NTHREADS, LDS_BYTES) != hipSuccess || per_cu < 1) fprintf(stderr, "kernel_launch: occupancy query says %d\n", per_cu);
        (void)hipGetLastError();
        grid = cus > 256 ? 256 : cus;
    }
    if (grid < 0) return;
    (void)hipMemsetAsync((char*)d_ws + WS_CTL, 0, CTL_ZERO_BYTES, stream);
    Args a{};
    for (int i = 0; i < 25; ++i) a.in[i] = (const float*)d_in[i];
    a.out = (float*)d_out; a.ws = (unsigned char*)d_ws;
    hipLaunchKernelGGL(hybrid_fwd, dim3(grid), dim3(NTHREADS), LDS_BYTES, stream, a);
}
```

```cpp
#include <hip/hip_runtime.h>
#include <cstdio>
#include <cstdint>

#define GAS __attribute__((address_space(1)))
#define LAS __attribute__((address_space(3)))
typedef unsigned short bf16_t;
typedef short bf16x8 __attribute__((ext_vector_type(8)));
typedef short s16x4 __attribute__((ext_vector_type(4)));
typedef float f32x2 __attribute__((ext_vector_type(2)));
typedef float f32x4 __attribute__((ext_vector_type(4)));
typedef float f32x16 __attribute__((ext_vector_type(16)));
typedef unsigned u32x2 __attribute__((ext_vector_type(2)));
typedef unsigned u32x4 __attribute__((ext_vector_type(4)));
typedef int i32x8 __attribute__((ext_vector_type(8)));
typedef __bf16 bf16x2_t __attribute__((ext_vector_type(2)));

constexpr int NB = 16, SEQ = 4096, DM = 1024, NTOK = NB * SEQ, DEPTH = 4;
constexpr int NHEAD = 8, HD = 64;
constexpr int NEXP = 32, EPG = 8, NGRP = 4, EFF = 512;
constexpr int MAXSLOT = 139264;
constexpr float EPS = 1e-6f;
constexpr float LOG2E = 1.4426950408889634f;
constexpr int NWAVES = 8, NTHREADS = 512;

constexpr size_t MiB = 1u << 20;
constexpr size_t WS_CTL = 0, CTL_ZERO_BYTES = 1 * MiB;
constexpr size_t WS_RSMIX = 4 * MiB;
constexpr size_t WS_RSFFN = WS_RSMIX + 256 * 1024;
constexpr size_t WS_TOKE = WS_RSFFN + 256 * 1024;
constexpr size_t WS_TOKW = WS_TOKE + 512 * 1024;
constexpr size_t WS_TOKS = WS_TOKW + 512 * 1024;
constexpr size_t WS_SLOTTOK = WS_TOKS + 512 * 1024;
constexpr size_t WS_SLOTRS = WS_SLOTTOK + 576 * 1024;
constexpr size_t WS_CNT = WS_SLOTRS + 576 * 1024;
constexpr size_t WS_RWT = WS_CNT + 64 * 1024;
constexpr size_t WS_RWG = WS_RWT + 512 * 1024;
constexpr size_t WS_SMALL_END = WS_RWG + 64 * 1024;
static_assert(WS_SMALL_END <= 16 * MiB, "small arrays");
constexpr size_t WS_WQKV = 16 * MiB;
constexpr size_t WS_WO = WS_WQKV + 12 * MiB;
constexpr size_t WS_WPC = WS_WO + 4 * MiB;
constexpr size_t WS_WPO = WS_WPC + 4 * MiB;
constexpr size_t WS_WGU = WS_WPO + 4 * MiB;
constexpr size_t WS_WDN = WS_WGU + 256 * MiB;
constexpr size_t WS_XB = WS_WDN + 128 * MiB;
constexpr size_t WS_ACT = WS_XB + 128 * MiB;
constexpr size_t WS_END = WS_ACT + 408 * MiB;
static_assert(WS_END <= 1126807104ull, "d_ws map exceeds the guaranteed workspace");
constexpr float A8_SCALE = 8.f, WN8_SCALE = 64.f;
constexpr size_t ACT_Q = 0, ACT_K = 128 * MiB, ACT_V = 256 * MiB;
constexpr size_t ACT_U = 0, ACT_P = 128 * MiB;
constexpr size_t ACT_H = 0, ACT_Y = 136 * MiB, ACT_X8 = 288 * MiB;
constexpr int CW_BAR = 4096;
constexpr int CW_TILES = 16384;

constexpr int RING_BYTES = 131072;
constexpr int LUT_OFF = RING_BYTES;
constexpr int LUT_N = 336;
constexpr int MISC_OFF = LUT_OFF + NHEAD * LUT_N * 4;
constexpr int TS_OFF = MISC_OFF + 256;
constexpr int LDS_BYTES = 147456;
static_assert(TS_OFF + 256 <= LDS_BYTES, "LDS map");

#define RLX_AGENT __ATOMIC_RELAXED, __HIP_MEMORY_SCOPE_AGENT
__device__ __forceinline__ unsigned cvtpk(float lo, float hi) { f32x2 v = {lo, hi}; bf16x2_t b = __builtin_convertvector(v, bf16x2_t); return __builtin_bit_cast(unsigned, b); }
__device__ __forceinline__ float bf2f(unsigned short h) { return __builtin_bit_cast(float, (unsigned)h << 16); }
__device__ __forceinline__ float wave_sum(float v) {
#pragma unroll
    for (int o = 1; o < 64; o <<= 1) v += __shfl_xor(v, o);
    return v;
}

__device__ __forceinline__ int opaque_tid() { int t = threadIdx.x; asm volatile("" : "+v"(t)); return t; }

#define XB_TMO      128
#define XB_XCNT(j)  (256  + 64 * (j))
#define XB_XSUB(j)  (1280 + 64 * (j))
#define XB_XGEN(j)  (2304 + 64 * (j))
#define XB_TOP      3328
#define XB_TOPGEN   3392
#define XCD_BAR_WORDS 3456
#define XB_SPIN_CAP (1u << 18)
__device__ __forceinline__ unsigned xb_ld(unsigned* p)              { return __hip_atomic_load(p, __ATOMIC_RELAXED, __HIP_MEMORY_SCOPE_AGENT); }
__device__ __forceinline__ unsigned xb_add(unsigned* p, unsigned v) { return __hip_atomic_fetch_add(p, v, __ATOMIC_RELAXED, __HIP_MEMORY_SCOPE_AGENT); }
__device__ __forceinline__ unsigned xb_xcc_id() { return (unsigned)__builtin_amdgcn_s_getreg((3 << 11) | 20) & 0xFu; }
#define XB_SPIN(cond, bar) do { unsigned _sp = 0; while (cond) { __builtin_amdgcn_s_sleep(1); \
    if ((++_sp & 255u) == 0u) { if (xb_ld(&(bar)[XB_TMO])) break; if (_sp > XB_SPIN_CAP) { atomicAdd(&(bar)[XB_TMO], 1u); break; } } } } while (0)
struct XcdBarrier { unsigned* bar; unsigned x; volatile LAS unsigned* st; };
__device__ __forceinline__ XcdBarrier xcd_barrier_post(unsigned* bar, volatile LAS unsigned* st) {
    XcdBarrier b; b.bar = bar; b.x = xb_xcc_id(); b.st = st;
    if (threadIdx.x == 0) (void)xb_add(&bar[XB_XCNT(b.x)], 1u);
    return b;
}
__device__ __forceinline__ void xcd_barrier_complete(unsigned* bar, unsigned x, unsigned& nloc, unsigned& nx) {
    const unsigned G = gridDim.x * gridDim.y * gridDim.z;
    unsigned sum, cnt, mine, sp = 0u;
    for (;;) {
        sum = 0u; cnt = 0u; mine = 0u;
#pragma unroll
        for (unsigned j = 0; j < 16; ++j) { const unsigned c = xb_ld(&bar[XB_XCNT(j)]); sum += c; cnt += (c > 0u) ? 1u : 0u; mine = (j == x) ? c : mine; }
        if (sum == G) break;
        __builtin_amdgcn_s_sleep(1);
        if ((++sp & 255u) == 0u) { if (xb_ld(&bar[XB_TMO])) break; if (sp > XB_SPIN_CAP) { atomicAdd(&bar[XB_TMO], 1u); break; } }
    }
    nloc = mine > 0u ? mine : 1u; nx = cnt > 0u ? cnt : 1u;
}
__device__ __forceinline__ void xcd_barrier(const XcdBarrier& b) {
    asm volatile("s_waitcnt vmcnt(0)" ::: "memory");
    __syncthreads();
    if (threadIdx.x == 0) {
        unsigned* bar = b.bar;
        __builtin_amdgcn_s_waitcnt(0);
        unsigned nloc = b.st[0], nx = b.st[1];
        if (nloc == 0u) { xcd_barrier_complete(bar, b.x, nloc, nx); b.st[0] = nloc; b.st[1] = nx; }
        const unsigned old = xb_add(&bar[XB_XSUB(b.x)], 1u);
        const unsigned gen = old / nloc;
        if (old + 1u == (gen + 1u) * nloc) {
            __builtin_amdgcn_fence(__ATOMIC_RELEASE, "agent");
            asm volatile("s_waitcnt vmcnt(0)" ::: "memory");
            const unsigned og = xb_add(&bar[XB_TOP], 1u);
            const unsigned tg = og / nx;
            if (og + 1u == (tg + 1u) * nx) xb_add(&bar[XB_TOPGEN], 1u);
            else XB_SPIN(xb_ld(&bar[XB_TOPGEN]) == tg, bar);
            __builtin_amdgcn_fence(__ATOMIC_ACQUIRE, "agent");
            xb_add(&bar[XB_XGEN(b.x)], 1u);
            asm volatile("s_waitcnt vmcnt(0)" ::: "memory");
        } else {
            XB_SPIN(xb_ld(&bar[XB_XGEN(b.x)]) == gen, bar);
            __builtin_amdgcn_fence(__ATOMIC_ACQUIRE, "agent");
            asm volatile("s_waitcnt vmcnt(0)" ::: "memory");
        }
    }
    __syncthreads();
}

namespace pg8 {
constexpr int BM = 256, BK = 64, HALF = 128, HTB = HALF * BK * 2, STAGE_BYTES = 8 * HTB;
__host__ __device__ __forceinline__ int lds_byte(int r, int c) { const int st = (r >> 4) * 2 + (c >> 5), rr = r & 15, cc = c & 31, ob = rr * 64 + cc * 2; return st * 1024 + (ob ^ (((ob >> 9) & 1) << 5)); }
__host__ __device__ __forceinline__ void stage_rc(int b, int& R, int& C) { const int st = b / 1024, sb = b % 1024, swz = sb ^ (((sb >> 9) & 1) << 5); R = (st >> 1) * 16 + swz / 64; C = (st & 1) * 32 + (swz % 64) / 2; }
__host__ __device__ __forceinline__ int perm32(int rho) { const int n = rho >> 4, i = rho & 15; return 8 * (i >> 2) + 4 * n + (i & 3); }
struct Unit { int pm, pn, e; };

template <class Epi, class Sched, bool ALIGN_EPI, bool FP8 = false>
__device__ __forceinline__ void gemm_phase(LAS unsigned char* lds, const int K, const Sched& S, const Epi& E) {
    const int tid = opaque_tid(), wid = __builtin_amdgcn_readfirstlane(tid >> 6), lane = tid & 63, wr = wid >> 2, wc = wid & 3, fr = lane & 15, fq = lane >> 4;
    const int nt = FP8 ? K / 128 : K / BK;
    int RA[2], CA[2]; unsigned voffB[2];
#pragma unroll
    for (int i = 0; i < 2; ++i) { int R, C; stage_rc(tid * 16 + i * 8192, R, C); RA[i] = R; CA[i] = C * 2;
        voffB[i] = (unsigned)(tid * 16 + i * 8192); }
    const size_t kstep = (size_t)(BK * 2);
    const size_t hstepB = 16384, kstepB = 32768;
    const unsigned ldsw = (unsigned)wid * 1024u;
    const int aoff = lds_byte(wr * 64 + fr, fq * 8), boff = lds_byte(wc * 32 + fr, fq * 8);
    const int aoff8 = lds_byte(wr * 64 + fr, fq * 16), boff8 = lds_byte(wc * 32 + fr, fq * 16);
#define PG8_SA(b, h) (((b) * 2 + (h)) * HTB)
#define PG8_SB(b, h) ((4 + (b) * 2 + (h)) * HTB)
#define PG8_STAGE(bufoff, gbase, v0, v1) do { const char* gb_ = (const char*)(gbase); unsigned v0_ = (v0), v1_ = (v1); asm volatile("" : "+s"(gb_), "+v"(v0_), "+v"(v1_)); \
        __builtin_amdgcn_global_load_lds((const unsigned*)(gb_ + v0_), (LAS unsigned*)(lds + (bufoff) + ldsw), 16, 0, 0); \
        __builtin_amdgcn_global_load_lds((const unsigned*)(gb_ + v1_), (LAS unsigned*)(lds + (bufoff) + ldsw + 8192), 16, 0, 0); } while (0)
#define PG8_STAGEA(bufoff, gbase, V, h) PG8_STAGE(bufoff, gbase, V[h][0], V[h][1])
#define PG8_STAGEB(bufoff, gbase) PG8_STAGE(bufoff, gbase, voffB[0], voffB[1])
#define PG8_LDA(dst, b, h) do { if constexpr (FP8) { _Pragma("unroll") for (int m = 0; m < 4; ++m) { const u32x4 l_ = *(const LAS u32x4*)(lds + PG8_SA(b, h) + aoff8 + m * 2048), h_ = *(const LAS u32x4*)(lds + PG8_SA(b, h) + aoff8 + m * 2048 + 16); \
            dst##8[m] = (i32x8){(int)l_.x, (int)l_.y, (int)l_.z, (int)l_.w, (int)h_.x, (int)h_.y, (int)h_.z, (int)h_.w}; } } \
        else { _Pragma("unroll") for (int m = 0; m < 4; ++m) _Pragma("unroll") for (int k = 0; k < 2; ++k) dst[m][k] = *(const LAS bf16x8*)(lds + PG8_SA(b, h) + aoff + m * 2048 + k * 1024); } } while (0)
#define PG8_LDB(dst, b, h) do { if constexpr (FP8) { _Pragma("unroll") for (int n = 0; n < 2; ++n) { const u32x4 l_ = *(const LAS u32x4*)(lds + PG8_SB(b, h) + boff8 + n * 2048), h_ = *(const LAS u32x4*)(lds + PG8_SB(b, h) + boff8 + n * 2048 + 16); \
            dst##8[n] = (i32x8){(int)l_.x, (int)l_.y, (int)l_.z, (int)l_.w, (int)h_.x, (int)h_.y, (int)h_.z, (int)h_.w}; } } \
        else { _Pragma("unroll") for (int n = 0; n < 2; ++n) _Pragma("unroll") for (int k = 0; k < 2; ++k) dst[n][k] = *(const LAS bf16x8*)(lds + PG8_SB(b, h) + boff + n * 2048 + k * 1024); } } while (0)
#define PG8_MMA(ai, bj, At, Bt) do { __builtin_amdgcn_s_setprio(1); \
        if constexpr (FP8) { _Pragma("unroll") for (int m = 0; m < 4; ++m) _Pragma("unroll") for (int n = 0; n < 2; ++n) \
            acc[ai][bj][m][n] = __builtin_amdgcn_mfma_scale_f32_16x16x128_f8f6f4(Bt##8[n], At##8[m], acc[ai][bj][m][n], 0, 0, 0, 0x7f7f7f7f, 0, 0x7f7f7f7f); } \
        else { _Pragma("unroll") for (int m = 0; m < 4; ++m) _Pragma("unroll") for (int n = 0; n < 2; ++n) _Pragma("unroll") for (int k = 0; k < 2; ++k) \
            acc[ai][bj][m][n] = __builtin_amdgcn_mfma_f32_16x16x32_bf16(Bt[n][k], At[m][k], acc[ai][bj][m][n], 0, 0, 0); } \
        __builtin_amdgcn_s_setprio(0); } while (0)
#define PG8_WAIT_V(n) asm volatile("s_waitcnt vmcnt(" #n ")" ::: "memory")
#define PG8_WAIT_L(n) asm volatile("s_waitcnt lgkmcnt(" #n ")" ::: "memory")
#define PG8_BAR __builtin_amdgcn_s_barrier()
#define PG8_SCHED __builtin_amdgcn_sched_barrier(0)
#define PG8_SCHED8 do { if constexpr (FP8) __builtin_amdgcn_sched_barrier(0); } while (0)
    Unit cur, nxt; int ui = 0;
    if (!S.next(0, cur)) return;
    f32x4 acc[2][2][4][2];
#pragma unroll
    for (int a = 0; a < 2; ++a)
#pragma unroll
        for (int b = 0; b < 2; ++b)
#pragma unroll
            for (int m = 0; m < 4; ++m)
#pragma unroll
                for (int n = 0; n < 2; ++n) acc[a][b][m][n] = (f32x4){0.f, 0.f, 0.f, 0.f};
    bf16x8 At[4][2], B0[2][2], B1[2][2]; i32x8 At8[4], B08[2], B18[2];
    const char* const Ab = S.a_base();
    unsigned cvA[2][2];
#pragma unroll
    for (int h = 0; h < 2; ++h)
#pragma unroll
        for (int i = 0; i < 2; ++i) cvA[h][i] = S.a_row_off(cur, h * HALF + RA[i]) + (unsigned)CA[i];
    const char* cB = S.b_base(cur);
    PG8_STAGEB(PG8_SB(0, 0), cB); PG8_STAGEB(PG8_SB(0, 1), cB + hstepB); PG8_STAGEA(PG8_SA(0, 0), Ab, cvA, 0); PG8_STAGEA(PG8_SA(0, 1), Ab, cvA, 1);
    if (wr == 1) PG8_BAR;
    PG8_WAIT_V(2); PG8_BAR;
    PG8_STAGEB(PG8_SB(1, 0), cB + kstepB); PG8_STAGEA(PG8_SA(1, 0), Ab + kstep, cvA, 0); PG8_STAGEB(PG8_SB(1, 1), cB + hstepB + kstepB);
    PG8_WAIT_V(6); PG8_BAR;
    for (;;) {
        const bool has_next = S.next(ui + 1, nxt);
        const char* nB = has_next ? S.b_base(nxt) : cB;
        for (int t = 0; t < nt; t += 2) {
            const bool last = (t == nt - 2);
            const char* a1 = Ab + (size_t)(t + 1) * kstep;
            const char* a2 = last ? Ab : Ab + (size_t)(t + 2) * kstep; const char* b2 = last ? nB : cB + (size_t)(t + 2) * kstepB;
            const char* a3 = a2 + kstep; const char* b3 = b2 + kstepB;
            PG8_LDB(B0, 0, 0); PG8_LDB(B1, 0, 1); PG8_SCHED; PG8_LDA(At, 0, 0); PG8_STAGEA(PG8_SA(1, 1), a1, cvA, 1);
            if (last && has_next) {
#pragma unroll
                for (int h = 0; h < 2; ++h)
#pragma unroll
                    for (int i = 0; i < 2; ++i) cvA[h][i] = S.a_row_off(nxt, h * HALF + RA[i]) + (unsigned)CA[i]; }
            PG8_WAIT_V(8); PG8_WAIT_L(0); PG8_BAR; PG8_SCHED8; PG8_MMA(0, 0, At, B0); PG8_MMA(0, 1, At, B1); PG8_SCHED8; PG8_BAR; PG8_SCHED;
            PG8_LDA(At, 0, 1); PG8_STAGEB(PG8_SB(0, 0), b2); PG8_STAGEB(PG8_SB(0, 1), b2 + hstepB); PG8_STAGEA(PG8_SA(0, 0), a2, cvA, 0);
            PG8_WAIT_V(8); PG8_WAIT_L(0); PG8_BAR; PG8_SCHED8; PG8_MMA(1, 0, At, B0); PG8_MMA(1, 1, At, B1); PG8_SCHED8; PG8_BAR; PG8_SCHED;
            PG8_LDB(B0, 1, 0); PG8_LDB(B1, 1, 1); PG8_SCHED; PG8_LDA(At, 1, 0); PG8_STAGEA(PG8_SA(0, 1), a2, cvA, 1);
            PG8_WAIT_V(8); PG8_WAIT_L(0); PG8_BAR; PG8_SCHED8; PG8_MMA(0, 0, At, B0); PG8_MMA(0, 1, At, B1); PG8_SCHED8; PG8_BAR; PG8_SCHED;
            PG8_LDA(At, 1, 1); PG8_STAGEB(PG8_SB(1, 0), b3); PG8_STAGEB(PG8_SB(1, 1), b3 + hstepB); PG8_STAGEA(PG8_SA(1, 0), a3, cvA, 0);
            PG8_WAIT_V(8); PG8_WAIT_L(0); PG8_BAR; PG8_SCHED8; PG8_MMA(1, 0, At, B0); PG8_MMA(1, 1, At, B1); PG8_SCHED8; PG8_BAR; PG8_SCHED;
        }
        if constexpr (ALIGN_EPI) { if (wr == 0) PG8_BAR; }
        E(acc, cur, wr, wc, fr, fq);
        if (!has_next) break;
#pragma unroll
        for (int a = 0; a < 2; ++a)
#pragma unroll
            for (int b = 0; b < 2; ++b)
#pragma unroll
                for (int m = 0; m < 4; ++m)
#pragma unroll
                    for (int n = 0; n < 2; ++n) acc[a][b][m][n] = (f32x4){0.f, 0.f, 0.f, 0.f};
        cur = nxt; cB = nB; ++ui;
        if constexpr (ALIGN_EPI) { if (wr == 1) PG8_BAR; }
    }
    PG8_WAIT_V(0);
    if constexpr (!ALIGN_EPI) { if (wr == 0) PG8_BAR; }
    PG8_BAR;
#undef PG8_SA
#undef PG8_SB
#undef PG8_STAGE
#undef PG8_STAGEA
#undef PG8_STAGEB
#undef PG8_LDA
#undef PG8_LDB
#undef PG8_MMA
#undef PG8_WAIT_V
#undef PG8_WAIT_L
#undef PG8_BAR
#undef PG8_SCHED
#undef PG8_SCHED8
}
}

struct SchedBase { int x, j, G8, NGp; __device__ __forceinline__ void init_grid() { const int G = gridDim.x, bx = blockIdx.x; if (G % 8 == 0) { NGp = 8; x = bx % 8; j = bx / 8; G8 = G / 8; } else { NGp = 1; x = 0; j = bx; G8 = G; } } };
struct PlainSched : SchedBase {
    const char* A; unsigned lda; const char* Bt; int K, nN, nrt;
    __device__ __forceinline__ bool next(int i, pg8::Unit& u) const { const int U = i * G8 + j, nrtg = (nrt - x + NGp - 1) / NGp; if (U >= nrtg * nN) return false; const int q = U / nN; u.pn = U - q * nN; u.pm = x + NGp * q; return true; }
    __device__ __forceinline__ const char* a_base() const { return A; }
    __device__ __forceinline__ unsigned a_row_off(const pg8::Unit& u, int r) const { return (unsigned)(u.pm * 256 + r) * lda; }
    __device__ __forceinline__ const char* b_base(const pg8::Unit& u) const { return Bt + (size_t)u.pn * 256 * K * 2; }
};
struct GroupSched : SchedBase {
    const char* A; unsigned lda; const int* slot_tok; const char* Bt; size_t strideE; int K; const LAS int* ts;
    __device__ __forceinline__ bool next(int i, pg8::Unit& u) const {
        const int U = i * G8 + j; int q = U >> 2; u.pn = U & 3;
        for (int e = x; e < NEXP; e += NGp) { const int t0 = __builtin_amdgcn_readfirstlane(ts[e]), n = __builtin_amdgcn_readfirstlane(ts[e + 1]) - t0; if (q < n) { u.pm = t0 + q; u.e = e; return true; } q -= n; }
        return false; }
    __device__ __forceinline__ const char* a_base() const { return A; }
    __device__ __forceinline__ unsigned a_row_off(const pg8::Unit& u, int r) const { int row = u.pm * 256 + r; if (slot_tok) row = slot_tok[row]; return (unsigned)row * lda; }
    __device__ __forceinline__ const char* b_base(const pg8::Unit& u) const { return Bt + (size_t)u.e * strideE + (size_t)u.pn * 256 * K * 2; }
};

typedef f32x4 Acc[2][2][4][2];
struct EpiQKV {
    bf16_t* Q; const float* rstd; const LAS float* gl;
    __device__ __forceinline__ void operator()(const Acc& acc, const pg8::Unit& u, int wr, int wc, int fr, int fq) const {
        const int part = u.pn >> 2, colp = (u.pn & 3) * 256 + wc * 64 + 8 * fq;
        bf16_t* base = Q + (size_t)part * NTOK * DM;
        const float qs = part == 0 ? 0.125f * LOG2E : 1.f;
#pragma unroll
        for (int ai = 0; ai < 2; ++ai)
#pragma unroll
            for (int m = 0; m < 4; ++m) {
                const int row = u.pm * 256 + ai * 128 + wr * 64 + m * 16 + fr;
                const float rs = rstd[row];
                float f = rs;
                if (part < 2) { float ss = 0.f;
#pragma unroll
                    for (int bj = 0; bj < 2; ++bj)
#pragma unroll
                        for (int n = 0; n < 2; ++n) { const f32x4 t = acc[ai][bj][m][n] * rs; const f32x4 t2 = t * t; ss += (t2[0] + t2[1]) + (t2[2] + t2[3]); }
                    ss += __shfl_xor(ss, 16); ss += __shfl_xor(ss, 32); f = rs * __builtin_amdgcn_rsqf(ss * (1.f / 64.f) + EPS) * qs; }
                const int hh = (u.pn & 3) * 2 + (wc >> 1), tl = (row & (SEQ - 1)) >> 6, rr = row & 63;
                const size_t tb = ((size_t)((row >> 12) * NHEAD + hh) * 64 + tl) * 8192;
#pragma unroll
                for (int bj = 0; bj < 2; ++bj) {
                    f32x4 g0 = {f, f, f, f}, g1 = g0;
                    if (part < 2) { const LAS f32x4* gp = (const LAS f32x4*)(gl + part * 64 + 32 * bj + 8 * fq); g0 = gp[0] * f; g1 = gp[1] * f; }
                    const f32x4 a = acc[ai][bj][m][0] * g0, b = acc[ai][bj][m][1] * g1;
                    u32x4 w; w.x = cvtpk(a[0], a[1]); w.y = cvtpk(a[2], a[3]); w.z = cvtpk(b[0], b[1]); w.w = cvtpk(b[2], b[3]);
                    if (part == 0) *(u32x4*)(base + (size_t)row * DM + colp + 32 * bj) = w;
                    else if (part == 1) *(u32x4*)(base + tb + ((wc & 1) * 8 + 4 * bj + fq) * 512 + rr * 8) = w;
                    else *(u32x4*)(base + tb + (2 * (wc & 1) + bj) * 2048 + rr * 32 + 8 * fq) = w; }
            }
    }
};
__device__ __forceinline__ int cvt8(float a, float b, int old, bool hi) {
    a = __builtin_amdgcn_fmed3f(a, -448.f, 448.f); b = __builtin_amdgcn_fmed3f(b, -448.f, 448.f);
    return hi ? __builtin_amdgcn_cvt_pk_fp8_f32(a, b, old, true) : __builtin_amdgcn_cvt_pk_fp8_f32(a, b, old, false);
}
struct EpiBf16 {
    bf16_t* O; int ldc; const float* rstd; float mul;
    __device__ __forceinline__ void operator()(const Acc& acc, const pg8::Unit& u, int wr, int wc, int fr, int fq) const {
        const int col = u.pn * 256 + wc * 64 + 8 * fq;
        float rsv[2][4];
#pragma unroll
        for (int ai = 0; ai < 2; ++ai)
#pragma unroll
            for (int m = 0; m < 4; ++m) rsv[ai][m] = (rstd ? rstd[u.pm * 256 + ai * 128 + wr * 64 + m * 16 + fr] : 1.f) * mul;
        asm volatile("" : "+v"(rsv[0][0]), "+v"(rsv[0][1]), "+v"(rsv[0][2]), "+v"(rsv[0][3]), "+v"(rsv[1][0]), "+v"(rsv[1][1]), "+v"(rsv[1][2]), "+v"(rsv[1][3]) :: "memory");
#pragma unroll
        for (int ai = 0; ai < 2; ++ai)
#pragma unroll
            for (int m = 0; m < 4; ++m) {
                const int row = u.pm * 256 + ai * 128 + wr * 64 + m * 16 + fr;
                const float rs = rsv[ai][m];
#pragma unroll
                for (int bj = 0; bj < 2; ++bj) { const f32x4 a = acc[ai][bj][m][0] * rs, b = acc[ai][bj][m][1] * rs; u32x4 w; w.x = cvtpk(a[0], a[1]); w.y = cvtpk(a[2], a[3]); w.z = cvtpk(b[0], b[1]); w.w = cvtpk(b[2], b[3]);
                    *(u32x4*)(O + (size_t)row * ldc + col + 32 * bj) = w; }
            }
    }
};
constexpr float Y8_SCALE = 16.f;
struct EpiY8 {
    static constexpr int NSTORES = 8;
    unsigned char* Y;
    __device__ __forceinline__ void operator()(const Acc& acc, const pg8::Unit& u, int wr, int wc, int fr, int fq) const {
        const int pos = u.pn * 256 + wc * 64 + 16 * fq;
        constexpr float YS = Y8_SCALE / (16.f * 64.f);
#pragma unroll
        for (int ai = 0; ai < 2; ++ai)
#pragma unroll
            for (int m = 0; m < 4; ++m) {
                const int row = u.pm * 256 + ai * 128 + wr * 64 + m * 16 + fr;
                u32x4 w;
#pragma unroll
                for (int bj = 0; bj < 2; ++bj) { const f32x4 a = acc[ai][bj][m][0] * YS, b = acc[ai][bj][m][1] * YS;
                    int lo = cvt8(a[0], a[1], 0, false); lo = cvt8(a[2], a[3], lo, true);
                    int hi = cvt8(b[0], b[1], 0, false); hi = cvt8(b[2], b[3], hi, true);
                    w[2 * bj] = (unsigned)lo; w[2 * bj + 1] = (unsigned)hi; }
                *(u32x4*)(Y + (size_t)row * DM + pos) = w;
            }
    }
};
constexpr float X8_SCALE = 4.f, WG8_SCALE = 64.f, WPC8_SCALE = 64.f;
struct EpiRes {
    bf16_t* xb; const float* scale; unsigned char* x8; float mul;
    __device__ __forceinline__ void operator()(const Acc& acc, const pg8::Unit& u, int wr, int wc, int fr, int fq) const {
        const int col = u.pn * 256 + wc * 64 + 8 * fq;
        f32x4 sc[2][2];
#pragma unroll
        for (int bj = 0; bj < 2; ++bj)
#pragma unroll
            for (int n = 0; n < 2; ++n) sc[bj][n] = (scale ? *(const f32x4*)(scale + col + 32 * bj + 4 * n) : (f32x4){1.f, 1.f, 1.f, 1.f}) * mul;
#pragma unroll
        for (int ai = 0; ai < 2; ++ai) {
            u32x4 r[2][4][2];
#pragma unroll
            for (int m = 0; m < 4; ++m)
#pragma unroll
                for (int bj = 0; bj < 2; ++bj) r[ai][m][bj] = *(const u32x4*)(xb + (size_t)(u.pm * 256 + ai * 128 + wr * 64 + m * 16 + fr) * DM + col + 32 * bj);
            asm volatile("" ::: "memory");
#pragma unroll
            for (int m = 0; m < 4; ++m) {
                const size_t off = (size_t)(u.pm * 256 + ai * 128 + wr * 64 + m * 16 + fr) * DM + col;
                u32x4 w8;
#pragma unroll
                for (int bj = 0; bj < 2; ++bj) {
                    const u32x4 q = r[ai][m][bj];
                    const f32x4 a = acc[ai][bj][m][0] * sc[bj][0], b = acc[ai][bj][m][1] * sc[bj][1];
                    const float x0 = __builtin_bit_cast(float, q.x << 16) + a[0], x1 = __builtin_bit_cast(float, q.x & 0xffff0000u) + a[1], x2 = __builtin_bit_cast(float, q.y << 16) + a[2], x3 = __builtin_bit_cast(float, q.y & 0xffff0000u) + a[3];
                    const float x4 = __builtin_bit_cast(float, q.z << 16) + b[0], x5 = __builtin_bit_cast(float, q.z & 0xffff0000u) + b[1], x6 = __builtin_bit_cast(float, q.w << 16) + b[2], x7 = __builtin_bit_cast(float, q.w & 0xffff0000u) + b[3];
                    u32x4 w; w.x = cvtpk(x0, x1); w.y = cvtpk(x2, x3); w.z = cvtpk(x4, x5); w.w = cvtpk(x6, x7);
                    *(u32x4*)(xb + off + 32 * bj) = w;
                    int lo = cvt8(x0 * X8_SCALE, x1 * X8_SCALE, 0, false); lo = cvt8(x2 * X8_SCALE, x3 * X8_SCALE, lo, true);
                    int hi = cvt8(x4 * X8_SCALE, x5 * X8_SCALE, 0, false); hi = cvt8(x6 * X8_SCALE, x7 * X8_SCALE, hi, true);
                    w8[2 * bj] = (unsigned)lo; w8[2 * bj + 1] = (unsigned)hi; }
                *(u32x4*)(x8 + (size_t)(u.pm * 256 + ai * 128 + wr * 64 + m * 16 + fr) * DM + u.pn * 256 + wc * 64 + 16 * fq) = w8;
            }
        }
    }
};
constexpr float H8_SCALE = 16.f, WD8_SCALE = 64.f;
struct EpiGateUp {
    static constexpr int NSTORES = 8;
    unsigned char* H; const float* slot_rs;
    __device__ __forceinline__ void operator()(const Acc& acc, const pg8::Unit& u, int wr, int wc, int fr, int fq) const {
#pragma unroll
        for (int ai = 0; ai < 2; ++ai) {
            float rsv[4];
#pragma unroll
            for (int m = 0; m < 4; ++m) rsv[m] = slot_rs[u.pm * 256 + ai * 128 + wr * 64 + m * 16 + fr];
            asm volatile("" : "+v"(rsv[0]), "+v"(rsv[1]), "+v"(rsv[2]), "+v"(rsv[3]) :: "memory");
            u32x2 w[4];
#pragma unroll
            for (int m = 0; m < 4; ++m) {
                const float rs = rsv[m] * (1.f / (X8_SCALE * WG8_SCALE));
                float h[8];
#pragma unroll
                for (int n = 0; n < 2; ++n)
#pragma unroll
                    for (int i = 0; i < 4; ++i) { const float g = acc[ai][0][m][n][i] * rs, up = acc[ai][1][m][n][i] * rs;
                        h[4 * n + i] = g * up * __builtin_amdgcn_rcpf(1.f + __builtin_amdgcn_exp2f(-g * LOG2E)) * H8_SCALE; }
                int lo = cvt8(h[0], h[1], 0, false); lo = cvt8(h[2], h[3], lo, true);
                int hi = cvt8(h[4], h[5], 0, false); hi = cvt8(h[6], h[7], hi, true);
                w[m].x = (unsigned)lo; w[m].y = (unsigned)hi;
            }
            const int odd = fq & 1;
#pragma unroll
            for (int mp = 0; mp < 4; mp += 2) {
                const u32x2 snd = odd ? w[mp] : w[mp + 1], own = odd ? w[mp + 1] : w[mp];
                u32x2 rcv; rcv.x = (unsigned)__shfl_xor((int)snd.x, 16); rcv.y = (unsigned)__shfl_xor((int)snd.y, 16);
                u32x4 o; o.x = odd ? rcv.x : own.x; o.y = odd ? rcv.y : own.y; o.z = odd ? own.x : rcv.x; o.w = odd ? own.y : rcv.y;
                const int row = u.pm * 256 + ai * 128 + wr * 64 + (mp + odd) * 16 + fr;
                *(u32x4*)(H + (size_t)row * EFF + u.pn * 128 + wc * 32 + 8 * (fq & 2)) = o;
            }
        }
    }
};

struct W8Item { const float* W; const float* gp; unsigned char* WT; int N, k0, n, Kd, drow, r0, r1, hasg; float fs; };
__device__ __forceinline__ void w8_load(LAS unsigned char* lds, int S, int lane, int wid, W8Item& d, f32x4 (&v)[16], float (&g)[16]);
__device__ __forceinline__ void w8_finish(const W8Item& d, const f32x4 (&v)[16], float (&g)[16], int wid, bool dostore = true);
constexpr int W8_SGU = 128 * 2 * 8 * 2, W8_SDN = 128 * 4 * 4, W8_SPO = 2 * 8 * 4, W8_PER_LAYER = 1024 + 512;
constexpr int W8_EARLY1 = 512, W8_NDEF = 3 * W8_PER_LAYER - W8_EARLY1;
__device__ __forceinline__ int w8_deferred_S(int d) { const int dd = d + W8_EARLY1, layer = 1 + dd / W8_PER_LAYER, w = dd - (layer - 1) * W8_PER_LAYER; return w < 1024 ? layer * 1024 + w : W8_SGU + layer * 512 + (w - 1024); }
namespace attn {
constexpr int SLOT = 32768, V_OFF = 16384, NSLOT = 3, X_OFF = NSLOT * SLOT, WSF_OFF = TS_OFF + 256;
static_assert(X_OFF + 4 * 8192 <= RING_BYTES && WSF_OFF + NWAVES * 256 <= LDS_BYTES, "attn LDS");
constexpr int DMAXI = 206;
__device__ __forceinline__ int crow(int r, int hi) { return (r & 3) + 8 * (r >> 2) + 4 * hi; }
__device__ __forceinline__ int rel_bucket(int n) {
    if (n < 16) return n;
    const int l = 16 + (int)(logf((float)n / 16.f) / logf(8.f) * 16.f);
    return l < 31 ? l : 31;
}
struct Params { const bf16_t* Q; const bf16_t* K; const bf16_t* V; bf16_t* O; const float* rel_bias; const float* subln; float lam; float one_minus_li; int dbase, dcount; };

__device__ __forceinline__ void build_lut(LAS unsigned char* lds, const float* rel_bias) {
    LAS float* lut = (LAS float*)(lds + LUT_OFF);
    for (int idx = opaque_tid(); idx < NHEAD * LUT_N; idx += NTHREADS) {
        const int h = idx / LUT_N, i = idx - h * LUT_N, dist = DMAXI - i;
        lut[idx] = dist < 0 ? -INFINITY : (rel_bias[rel_bucket(dist) * NHEAD + h] - rel_bias[31 * NHEAD + h]) * LOG2E;
    }
}
#define ATT_WAIT_BAR(N) asm volatile("s_waitcnt vmcnt(" #N ") lgkmcnt(0)\n\ts_barrier" ::: "memory")
#define ATT_SBAR() __builtin_amdgcn_sched_barrier(0)
#define ATT_PIN(x) asm volatile("" : "+v"(x))
#define ATT_MF(a, b, c) __builtin_amdgcn_mfma_f32_32x32x16_bf16(a, b, c, 0, 0, 0)
#define ATT_VRD8(L, H, ks) do { _Pragma("unroll") for (int d_ = 0; d_ < 4; ++d_) { \
        asm volatile("ds_read_b64_tr_b16 %0, %1 offset:%c2" : "=&v"(L[d_]) : "v"(vaddr), "i"(V_OFF + d_ * 4096 + (ks) * 1024) : "memory"); \
        asm volatile("ds_read_b64_tr_b16 %0, %1 offset:%c2" : "=&v"(H[d_]) : "v"(vaddr), "i"(V_OFF + d_ * 4096 + (ks) * 1024 + 512) : "memory"); } } while (0)
#define ATT_VWAIT(N, L, H) do { asm volatile("s_waitcnt lgkmcnt(" #N ")" : "+v"(L[0]), "+v"(L[1]), "+v"(L[2]), "+v"(L[3]), "+v"(H[0]), "+v"(H[1]), "+v"(H[2]), "+v"(H[3]) :: "memory"); ATT_SBAR(); } while (0)
#define ATT_VF(L, H, d) ((bf16x8){L[d][0], L[d][1], L[d][2], L[d][3], H[d][0], H[d][1], H[d][2], H[d][3]})
#define ATT_PK(P, B) cvtpk(P[B], P[(B) + 1])
#define ATT_GAPA(VR, MFX, A0, A1, A2, A3, W0, W1, PW) do { VR; MFX; sacc += A0; sacc += A1; sacc += A2; sacc += A3; ATT_PIN(sacc); W0; W1; ATT_PIN(PW); ATT_SBAR(); } while (0)
#define ATT_VR1(L, H, d, ks) do { \
        asm volatile("ds_read_b64_tr_b16 %0, %1 offset:%c2" : "=&v"(L[d]) : "v"(vaddr), "i"(V_OFF + (d) * 4096 + (ks) * 1024) : "memory"); \
        asm volatile("ds_read_b64_tr_b16 %0, %1 offset:%c2" : "=&v"(H[d]) : "v"(vaddr), "i"(V_OFF + (d) * 4096 + (ks) * 1024 + 512) : "memory"); } while (0)
#define ATT_GAPB(KR, MFX, X, B) do { KR; MFX; X[B] = __builtin_amdgcn_exp2f(X[B]); X[(B) + 1] = __builtin_amdgcn_exp2f(X[(B) + 1]); ATT_PIN(X); ATT_SBAR(); } while (0)
#define ATT_VRW(N, L, H, d) asm volatile("s_waitcnt lgkmcnt(" #N ")" : "+v"(L[d]), "+v"(H[d]) :: "memory")
#define ATT_GAPB2(WT, MFX, VR, KR, DM, X, B) do { WT; MFX; VR; KR; DM; X[B] = __builtin_amdgcn_exp2f(X[B]); X[(B) + 1] = __builtin_amdgcn_exp2f(X[(B) + 1]); ATT_PIN(X); ATT_SBAR(); } while (0)
#define ATT_KR(GL, j) do { if (GL) { kf[2 * (j)] = *(const LAS bf16x8*)(kp0 + sl_next + (j) * 2048); kf[2 * (j) + 1] = *(const LAS bf16x8*)(kp0 + sl_next + (j) * 2048 + 512); } } while (0)
#define ATT_NOP() do { } while (0)
#define ATT_KLOAD(kp_) do { _Pragma("unroll") for (int d0_ = 0; d0_ < 4; ++d0_) { kf[2 * d0_] = *(const LAS bf16x8*)((kp_) + d0_ * 2048); kf[2 * d0_ + 1] = *(const LAS bf16x8*)((kp_) + d0_ * 2048 + 512); } } while (0)
#define ATT_BAND(C0, C1, tt) do { const int dd_ = q0w - 64 * (tt); if (dd_ - 63 < 113) { const LAS float* lb_ = lut + (DMAXI - (dd_ + r32 - 4 * hi)); \
        _Pragma("unroll") for (int r = 0; r < 16; ++r) { C0[r] += lb_[(r & 3) + 8 * (r >> 2)]; C1[r] += lb_[32 + (r & 3) + 8 * (r >> 2)]; } } } while (0)
#define ATT_STEP(C0, C1, P0, P1, tt, ITOP, I0, I1, I2, I3, GL, WN) do { \
        ATT_WAIT_BAR(WN); \
        ITOP; \
        const unsigned vaddr = lds_u + (unsigned)sl_prev + (unsigned)vlane; \
        float sacc = 0.f; \
        ATT_GAPA(ATT_VR1(la, ha, 0, 0), C0 = ATT_MF(kf[0], qr[0], zero16), P0[0], P0[1], P0[2], P0[3],     pw0[0] = ATT_PK(P0, 0),  pw0[1] = ATT_PK(P0, 2),  pw0); \
        ATT_GAPA(ATT_VR1(la, ha, 1, 0), C1 = ATT_MF(kf[1], qr[0], zero16), P0[4], P0[5], P0[6], P0[7],     pw0[2] = ATT_PK(P0, 4),  pw0[3] = ATT_PK(P0, 6),  pw0); \
        ATT_GAPA(ATT_VR1(la, ha, 2, 0), C0 = ATT_MF(kf[2], qr[1], C0),     P0[8], P0[9], P0[10], P0[11],   pw1[0] = ATT_PK(P0, 8),  pw1[1] = ATT_PK(P0, 10), pw1); \
        ATT_GAPA(ATT_VR1(la, ha, 3, 0), C1 = ATT_MF(kf[3], qr[1], C1),     P0[12], P0[13], P0[14], P0[15], pw1[2] = ATT_PK(P0, 12), pw1[3] = ATT_PK(P0, 14), pw1); \
        ATT_GAPA(ATT_NOP(), C0 = ATT_MF(kf[4], qr[2], C0),     P1[0], P1[1], P1[2], P1[3],     pw2[0] = ATT_PK(P1, 0),  pw2[1] = ATT_PK(P1, 2),  pw2); \
        ATT_GAPA(ATT_NOP(), C1 = ATT_MF(kf[5], qr[2], C1),     P1[4], P1[5], P1[6], P1[7],     pw2[2] = ATT_PK(P1, 4),  pw2[3] = ATT_PK(P1, 6),  pw2); \
        ATT_GAPA(ATT_NOP(), C0 = ATT_MF(kf[6], qr[3], C0),     P1[8], P1[9], P1[10], P1[11],   pw3[0] = ATT_PK(P1, 8),  pw3[1] = ATT_PK(P1, 10), pw3); \
        ATT_GAPA(ATT_NOP(), C1 = ATT_MF(kf[7], qr[3], C1),     P1[12], P1[13], P1[14], P1[15], pw3[2] = ATT_PK(P1, 12), pw3[3] = ATT_PK(P1, 14), pw3); \
        lsum += sacc; \
        ATT_BAND(C0, C1, tt); \
        ATT_GAPB2(ATT_VRW(6, la, ha, 0),   o[0] = ATT_MF(__builtin_bit_cast(bf16x8, pw0), ATT_VF(la, ha, 0), o[0]),   ATT_VR1(lb2, hb2, 0, 1), ATT_NOP(),      ATT_NOP(), C0, 0); \
        ATT_GAPB2(ATT_VRW(6, la, ha, 1),   o[1] = ATT_MF(__builtin_bit_cast(bf16x8, pw0), ATT_VF(la, ha, 1), o[1]),   ATT_VR1(lb2, hb2, 1, 1), ATT_NOP(),      ATT_NOP(), C0, 2); \
        ATT_GAPB2(ATT_VRW(6, la, ha, 2),   o[2] = ATT_MF(__builtin_bit_cast(bf16x8, pw0), ATT_VF(la, ha, 2), o[2]),   ATT_VR1(lb2, hb2, 2, 1), ATT_KR(GL, 0),  ATT_NOP(), C0, 4); \
        ATT_GAPB2(ATT_VRW(6, la, ha, 3),   o[3] = ATT_MF(__builtin_bit_cast(bf16x8, pw0), ATT_VF(la, ha, 3), o[3]),   ATT_VR1(lb2, hb2, 3, 1), ATT_KR(GL, 1),  ATT_NOP(), C0, 6); \
        ATT_GAPB2(ATT_VRW(6, lb2, hb2, 0), o[0] = ATT_MF(__builtin_bit_cast(bf16x8, pw1), ATT_VF(lb2, hb2, 0), o[0]), ATT_VR1(la, ha, 0, 2),   ATT_KR(GL, 2),  ATT_NOP(), C0, 8); \
        ATT_GAPB2(ATT_VRW(6, lb2, hb2, 1), o[1] = ATT_MF(__builtin_bit_cast(bf16x8, pw1), ATT_VF(lb2, hb2, 1), o[1]), ATT_VR1(la, ha, 1, 2),   ATT_KR(GL, 3),  ATT_NOP(), C0, 10); \
        ATT_GAPB2(ATT_VRW(6, lb2, hb2, 2), o[2] = ATT_MF(__builtin_bit_cast(bf16x8, pw1), ATT_VF(lb2, hb2, 2), o[2]), ATT_VR1(la, ha, 2, 2),   ATT_NOP(),      ATT_NOP(), C0, 12); \
        ATT_GAPB2(ATT_VRW(6, lb2, hb2, 3), o[3] = ATT_MF(__builtin_bit_cast(bf16x8, pw1), ATT_VF(lb2, hb2, 3), o[3]), ATT_VR1(la, ha, 3, 2),   ATT_NOP(),      ATT_NOP(), C0, 14); \
        ATT_GAPB2(ATT_VRW(6, la, ha, 0),   o[0] = ATT_MF(__builtin_bit_cast(bf16x8, pw2), ATT_VF(la, ha, 0), o[0]),   ATT_VR1(lb2, hb2, 0, 3), ATT_NOP(),      ATT_NOP(), C1, 0); \
        ATT_GAPB2(ATT_VRW(6, la, ha, 1),   o[1] = ATT_MF(__builtin_bit_cast(bf16x8, pw2), ATT_VF(la, ha, 1), o[1]),   ATT_VR1(lb2, hb2, 1, 3), ATT_NOP(),      ATT_NOP(), C1, 2); \
        ATT_GAPB2(ATT_VRW(6, la, ha, 2),   o[2] = ATT_MF(__builtin_bit_cast(bf16x8, pw2), ATT_VF(la, ha, 2), o[2]),   ATT_VR1(lb2, hb2, 2, 3), ATT_NOP(),      ATT_NOP(), C1, 4); \
        ATT_GAPB2(ATT_VRW(6, la, ha, 3),   o[3] = ATT_MF(__builtin_bit_cast(bf16x8, pw2), ATT_VF(la, ha, 3), o[3]),   ATT_VR1(lb2, hb2, 3, 3), ATT_NOP(),      ATT_NOP(), C1, 6); \
        ATT_GAPB2(ATT_VRW(6, lb2, hb2, 0), o[0] = ATT_MF(__builtin_bit_cast(bf16x8, pw3), ATT_VF(lb2, hb2, 0), o[0]), ATT_NOP(),               ATT_NOP(),      I0,        C1, 8); \
        ATT_GAPB2(ATT_VRW(4, lb2, hb2, 1), o[1] = ATT_MF(__builtin_bit_cast(bf16x8, pw3), ATT_VF(lb2, hb2, 1), o[1]), ATT_NOP(),               ATT_NOP(),      I1,        C1, 10); \
        ATT_GAPB2(ATT_VRW(2, lb2, hb2, 2), o[2] = ATT_MF(__builtin_bit_cast(bf16x8, pw3), ATT_VF(lb2, hb2, 2), o[2]), ATT_NOP(),               ATT_NOP(),      I2,        C1, 12); \
        ATT_GAPB2(ATT_VRW(0, lb2, hb2, 3), o[3] = ATT_MF(__builtin_bit_cast(bf16x8, pw3), ATT_VF(lb2, hb2, 3), o[3]), ATT_NOP(),               ATT_NOP(),      I3,        C1, 14); \
        { const int tmp_ = sl_prev; sl_prev = sl_cur; sl_cur = sl_next; sl_next = tmp_; } \
    } while (0)

__device__ __forceinline__ void attn_unit(const Params& P, int b, int h, int qblk, int ditem, W8Item& wi, f32x4 (&wv)[16], float (&wg)[16], int& whas, LAS unsigned char* lds) {
    const int tid = opaque_tid(), lane = tid & 63, r32 = lane & 31, hi = lane >> 5;
    const int wid = __builtin_amdgcn_readfirstlane(tid >> 6), c = wid >> 2, wq = wid & 3;
    const int q0 = qblk * 128, q0w = q0 + 32 * wq, NT = 2 * qblk + 2;
    const size_t rowbase = (size_t)b * SEQ;
    const bf16_t* ksrc = P.K + (size_t)(b * NHEAD + h) * 64 * 8192 + wid * 512 + lane * 8;
    const bf16_t* vsrc = P.V + (size_t)(b * NHEAD + h) * 64 * 8192 + (wid >> 2) * 2048 + wq * 512 + lane * 8;
#define ATT_DMA_K0(t, slot) __builtin_amdgcn_global_load_lds((const unsigned*)(ksrc + (size_t)(t) * 8192), (LAS unsigned*)(lds + (slot) + wid * 1024), 16, 0, 0)
#define ATT_DMA_K1(t, slot) __builtin_amdgcn_global_load_lds((const unsigned*)(ksrc + (size_t)(t) * 8192 + 4096), (LAS unsigned*)(lds + (slot) + 8192 + wid * 1024), 16, 0, 0)
#define ATT_DMA_V0(t, slot) __builtin_amdgcn_global_load_lds((const unsigned*)(vsrc + (size_t)(t) * 8192), (LAS unsigned*)(lds + (slot) + V_OFF + (wid >> 2) * 4096 + wq * 1024), 16, 0, 0)
#define ATT_DMA_V1(t, slot) __builtin_amdgcn_global_load_lds((const unsigned*)(vsrc + (size_t)(t) * 8192 + 4096), (LAS unsigned*)(lds + (slot) + V_OFF + (2 + (wid >> 2)) * 4096 + wq * 1024), 16, 0, 0)
#define ATT_DMA_K(t, slot) do { ATT_DMA_K0(t, slot); ATT_DMA_K1(t, slot); } while (0)
#define ATT_DMA_V(t, slot) do { ATT_DMA_V0(t, slot); ATT_DMA_V1(t, slot); } while (0)
    ATT_DMA_K(0, 0);
    ATT_DMA_K(1, SLOT); ATT_DMA_V(0, 0);
    if (NT > 2) ATT_DMA_K(2, 2 * SLOT);
    bf16x8 qr[4];
    { const bf16_t* Qw = P.Q + (rowbase + q0w + r32) * DM + h * 128 + c * 64 + hi * 8;
#pragma unroll
      for (int d0 = 0; d0 < 4; ++d0) qr[d0] = *(const bf16x8*)(Qw + d0 * 16); }
    const bool pend = whas != 0;
    w8_finish(wi, wv, wg, wid, pend); whas = 0;
    f32x16 o[4];
#pragma unroll
    for (int d = 0; d < 4; ++d)
#pragma unroll
        for (int r = 0; r < 16; ++r) o[d][r] = 0.f;
    f32x16 zero16;
#pragma unroll
    for (int r = 0; r < 16; ++r) zero16[r] = 0.f;
    float lsum = 0.f;
    const LAS float* lut = (const LAS float*)(lds + LUT_OFF) + h * LUT_N;
    const int vlane = ((lane >> 4) & 1) * 32 + (lane & 3) * 8 + (4 * hi + ((lane & 15) >> 2)) * 64;
    const unsigned lds_u = (unsigned)(uintptr_t)lds;
    const LAS unsigned char* kp0 = lds + c * 8192 + hi * 1024 + r32 * 16;
    int sl_prev = 2 * SLOT, sl_cur = 0, sl_next = SLOT;
    bf16x8 kf[8]; s16x4 la[4], ha[4], lb2[4], hb2[4]; u32x4 pw0, pw1, pw2, pw3;
    f32x16 pA0, pA1, pB0, pB1;
    if (pend) { if (NT > 2) ATT_WAIT_BAR(14); else ATT_WAIT_BAR(12); }
    else { if (NT > 2) ATT_WAIT_BAR(10); else ATT_WAIT_BAR(8); }
    ATT_DMA_V(1, SLOT);
    ATT_KLOAD(kp0);
    pA0 = ATT_MF(kf[0], qr[0], zero16); pA1 = ATT_MF(kf[1], qr[0], zero16);
    pA0 = ATT_MF(kf[2], qr[1], pA0); pA1 = ATT_MF(kf[3], qr[1], pA1);
    pA0 = ATT_MF(kf[4], qr[2], pA0); pA1 = ATT_MF(kf[5], qr[2], pA1);
    pA0 = ATT_MF(kf[6], qr[3], pA0); pA1 = ATT_MF(kf[7], qr[3], pA1);
    ATT_BAND(pA0, pA1, 0);
#pragma unroll
    for (int r = 0; r < 16; ++r) { pA0[r] = __builtin_amdgcn_exp2f(pA0[r]); pA1[r] = __builtin_amdgcn_exp2f(pA1[r]); }
    if (NT > 2) ATT_WAIT_BAR(6); else ATT_WAIT_BAR(4);
    ATT_KLOAD(kp0 + SLOT);
    { const int tmp_ = sl_prev; sl_prev = sl_cur; sl_cur = sl_next; sl_next = tmp_; }
    ATT_STEP(pB0, pB1, pA0, pA1, 1, { if (3 < NT) ATT_DMA_K(3, sl_prev); if (4 < NT) ATT_DMA_K(4, sl_cur); if (2 < NT) ATT_DMA_V(2, sl_next); }, ATT_NOP(), ATT_NOP(), ATT_NOP(), ATT_NOP(), (2 < NT), 2);
    if (NT > 2) {
        int t = 2;
        for (; t + 4 < NT; t += 2) {
            ATT_STEP(pA0, pA1, pB0, pB1, t,     ATT_NOP(), ATT_DMA_K0(t + 3, sl_cur), ATT_DMA_K1(t + 3, sl_cur), ATT_DMA_V0(t + 1, sl_next), ATT_DMA_V1(t + 1, sl_next), true, 4);
            ATT_STEP(pB0, pB1, pA0, pA1, t + 1, ATT_NOP(), ATT_DMA_K0(t + 4, sl_cur), ATT_DMA_K1(t + 4, sl_cur), ATT_DMA_V0(t + 2, sl_next), ATT_DMA_V1(t + 2, sl_next), true, 4);
        }
        if (NT - t == 4) {
            ATT_STEP(pA0, pA1, pB0, pB1, t,     ATT_NOP(), ATT_DMA_K0(t + 3, sl_cur), ATT_DMA_K1(t + 3, sl_cur), ATT_DMA_V0(t + 1, sl_next), ATT_DMA_V1(t + 1, sl_next), true, 4);
            ATT_STEP(pB0, pB1, pA0, pA1, t + 1, ATT_NOP(), ATT_NOP(), ATT_NOP(), ATT_DMA_V0(t + 2, sl_next), ATT_DMA_V1(t + 2, sl_next), true, 4);
            t += 2;
        }
        ATT_STEP(pA0, pA1, pB0, pB1, t,     ATT_NOP(), ATT_NOP(), ATT_NOP(), ATT_DMA_V0(t + 1, sl_next), ATT_DMA_V1(t + 1, sl_next), true, 2);
        ATT_STEP(pB0, pB1, pA0, pA1, t + 1, ATT_NOP(), ATT_NOP(), ATT_NOP(), ATT_NOP(), ATT_NOP(), false, 2);
    }
    { float sacc = 0.f;
#pragma unroll
      for (int r = 0; r < 16; ++r) sacc += pB0[r] + pB1[r];
      lsum += sacc;
#pragma unroll
      for (int q = 0; q < 4; ++q) { pw0[q] = ATT_PK(pB0, 2 * q); pw1[q] = ATT_PK(pB0, 8 + 2 * q); pw2[q] = ATT_PK(pB1, 2 * q); pw3[q] = ATT_PK(pB1, 8 + 2 * q); }
      ATT_WAIT_BAR(0);
      const unsigned vaddr = lds_u + (unsigned)sl_prev + (unsigned)vlane;
      ATT_VRD8(la, ha, 0); ATT_VRD8(lb2, hb2, 1);
      ATT_VWAIT(8, la, ha);
#pragma unroll
      for (int d = 0; d < 4; ++d) o[d] = ATT_MF(__builtin_bit_cast(bf16x8, pw0), ATT_VF(la, ha, d), o[d]);
      ATT_VRD8(la, ha, 2);
      ATT_VWAIT(8, lb2, hb2);
#pragma unroll
      for (int d = 0; d < 4; ++d) o[d] = ATT_MF(__builtin_bit_cast(bf16x8, pw1), ATT_VF(lb2, hb2, d), o[d]);
      ATT_VRD8(lb2, hb2, 3);
      ATT_VWAIT(8, la, ha);
#pragma unroll
      for (int d = 0; d < 4; ++d) o[d] = ATT_MF(__builtin_bit_cast(bf16x8, pw2), ATT_VF(la, ha, d), o[d]);
      ATT_VWAIT(0, lb2, hb2);
#pragma unroll
      for (int d = 0; d < 4; ++d) o[d] = ATT_MF(__builtin_bit_cast(bf16x8, pw3), ATT_VF(lb2, hb2, d), o[d]);
    }
#undef ATT_DMA_K
#undef ATT_DMA_V
#undef ATT_DMA_K0
#undef ATT_DMA_K1
#undef ATT_DMA_V0
#undef ATT_DMA_V1
    if (ditem >= 0) { w8_load(lds, w8_deferred_S(ditem), lane, wid, wi, wv, wg); whas = 1; }
    else {
#pragma unroll
        for (int i_ = 0; i_ < 16; ++i_) { wv[i_] = (f32x4){0.f, 0.f, 0.f, 0.f}; wg[i_] = 0.f; }
        wi.W = nullptr; wi.gp = nullptr; wi.WT = nullptr; wi.N = wi.k0 = wi.n = wi.Kd = wi.drow = wi.r0 = wi.r1 = wi.hasg = 0; wi.fs = 0.f; }
    LAS float* wsf = (LAS float*)(lds + WSF_OFF) + wid * 64;
    lsum += __shfl_xor(lsum, 32);
    if (hi == 0) wsf[r32] = lsum;
    asm volatile("s_waitcnt lgkmcnt(0)" ::: "memory");
    float rl[16];
#pragma unroll
    for (int r = 0; r < 16; ++r) rl[r] = __builtin_amdgcn_rcpf(wsf[crow(r, hi)]);
    LAS unsigned short* X = (LAS unsigned short*)(lds + X_OFF) + wq * 4096;
    if (c == 1) {
#pragma unroll
        for (int d = 0; d < 4; ++d)
#pragma unroll
            for (int r = 0; r < 16; ++r) X[(d * 16 + r) * 64 + lane] = (unsigned short)(cvtpk(o[d][r] * (rl[r] * P.lam), 0.f) & 0xffffu);
    }
    asm volatile("s_waitcnt lgkmcnt(0)\n\ts_barrier" ::: "memory");
    if (c == 0) {
        float rs[16];
#pragma unroll
        for (int r = 0; r < 16; ++r) {
            float ss = 0.f;
#pragma unroll
            for (int d = 0; d < 4; ++d) { const float v = o[d][r] * rl[r] - bf2f(X[(d * 16 + r) * 64 + lane]); o[d][r] = v; ss += v * v; }
            ss += __shfl_xor(ss, 1); ss += __shfl_xor(ss, 2); ss += __shfl_xor(ss, 4); ss += __shfl_xor(ss, 8); ss += __shfl_xor(ss, 16);
            rs[r] = __builtin_amdgcn_rsqf(ss * (1.f / 128.f) + EPS) * P.one_minus_li;
        }
        asm volatile("s_waitcnt lgkmcnt(0)" ::: "memory");
        LAS unsigned short* stg = X;
#pragma unroll
        for (int d = 0; d < 4; ++d) { const float g = P.subln[32 * d + r32];
#pragma unroll
            for (int r = 0; r < 16; ++r) stg[crow(r, hi) * 128 + 32 * d + r32] = (unsigned short)(cvtpk(o[d][r] * rs[r] * g, 0.f) & 0xffffu); }
        asm volatile("s_waitcnt lgkmcnt(0)" ::: "memory");
        bf16_t* Ow = P.O + (rowbase + q0w) * DM + h * 128;
#pragma unroll
        for (int i = 0; i < 8; ++i) { const int idx = i * 64 + lane, row = idx >> 4, ch = idx & 15;
            const u32x4 v = *(const LAS u32x4*)((const LAS unsigned char*)stg + row * 256 + ch * 16);
            *(u32x4*)(Ow + (size_t)row * DM + ch * 8) = v; }
    }
}

__device__ __forceinline__ void attn_phase(const Params& P, LAS unsigned char* lds) {
    const int G = gridDim.x, bx = blockIdx.x;
    build_lut(lds, P.rel_bias);
    __syncthreads();
    if (G == 256) {
        const int x = bx & 7, j = bx >> 3;
        W8Item wi; f32x4 wv[16]; float wg[16]; int whas = 0;
        for (int r = 0; r < 16; ++r) { const int bh = x * 16 + r, dl = (r >> 1) * 256 + bx;
            attn_unit(P, bh >> 3, bh & 7, (r & 1) ? 31 - j : j, (!(r & 1) && dl < P.dcount) ? P.dbase + dl : -1, wi, wv, wg, whas, lds); }
        if (whas) w8_finish(wi, wv, wg, __builtin_amdgcn_readfirstlane(opaque_tid() >> 6));
    } else {
        for (int i = 0;; ++i) { const int p = bx + G * i; if (p >= 2048) break; const int bh = p >> 4, s2 = p & 15;
            W8Item wi; f32x4 wv[16]; float wg[16]; int whas = 0;
            attn_unit(P, bh >> 3, bh & 7, 31 - s2, -1, wi, wv, wg, whas, lds); attn_unit(P, bh >> 3, bh & 7, s2, -1, wi, wv, wg, whas, lds); }
    }
    __syncthreads();
}
}

#define BF_LO(u) __builtin_bit_cast(float, (u) << 16)
#define BF_HI(u) __builtin_bit_cast(float, (u) & 0xffff0000u)
template <int MODE>
__device__ __forceinline__ void row_pass(const float* xin, float* xout, bf16_t* xb, float* rstd, const unsigned char* Y, const int* tok_slot, const float* tok_w, unsigned char* x8, LAS unsigned char* lds) {
    const int tid = opaque_tid(), lane = tid & 63, wid = tid >> 6;
    const int ypos = 256 * (lane >> 5) + 64 * ((lane & 31) >> 3) + 16 * (lane & 3) + 8 * (((lane & 31) >> 2) & 1);
    LAS int* sl = (LAS int*)lds; LAS float* wl = (LAS float*)(lds + 2048);
    for (int blk = blockIdx.x; blk < NTOK / 256; blk += gridDim.x) {
        if (MODE != 0) { sl[tid] = tok_slot[blk * 512 + tid]; wl[tid] = tok_w[blk * 512 + tid]; __syncthreads(); }
        for (int it = 0; it < 8; ++it) {
            const int r0 = it * 32 + wid * 4, m0 = blk * 256 + r0;
            float v[4][2][8];
            if (MODE == 0) {
#pragma unroll
                for (int rr = 0; rr < 4; ++rr) { const f32x4* xr = (const f32x4*)(xin + (size_t)(m0 + rr) * DM + 8 * lane);
#pragma unroll
                    for (int j = 0; j < 2; ++j) { const f32x4 a = xr[128 * j], b = xr[128 * j + 1];
#pragma unroll
                        for (int i = 0; i < 4; ++i) { v[rr][j][i] = a[i]; v[rr][j][4 + i] = b[i]; } } }
            } else {
                u32x4 xq[4][2]; u32x2 ya[4][2], yb[4][2]; float w0[4], w1[4];
#pragma unroll
                for (int rr = 0; rr < 4; ++rr) { const int s0 = sl[2 * (r0 + rr)], s1 = sl[2 * (r0 + rr) + 1]; w0[rr] = wl[2 * (r0 + rr)] * (1.f / Y8_SCALE); w1[rr] = wl[2 * (r0 + rr) + 1] * (1.f / Y8_SCALE);
                    const bf16_t* xr = xb + (size_t)(m0 + rr) * DM + 8 * lane;
                    const unsigned char* y0 = Y + (size_t)s0 * DM + ypos; const unsigned char* y1 = Y + (size_t)s1 * DM + ypos;
#pragma unroll
                    for (int j = 0; j < 2; ++j) { xq[rr][j] = *(const u32x4*)(xr + 512 * j); ya[rr][j] = *(const u32x2*)(y0 + 512 * j); yb[rr][j] = *(const u32x2*)(y1 + 512 * j); } }
#pragma unroll
                for (int rr = 0; rr < 4; ++rr)
#pragma unroll
                    for (int j = 0; j < 2; ++j) { const u32x4 x = xq[rr][j];
#pragma unroll
                        for (int q = 0; q < 2; ++q) { const unsigned xa = q ? x.z : x.x, xc = q ? x.w : x.y; const int yaq = (int)(q ? ya[rr][j].y : ya[rr][j].x), ybq = (int)(q ? yb[rr][j].y : yb[rr][j].x);
                            const f32x2 a0 = __builtin_amdgcn_cvt_pk_f32_fp8(yaq, false), a1 = __builtin_amdgcn_cvt_pk_f32_fp8(yaq, true);
                            const f32x2 b0 = __builtin_amdgcn_cvt_pk_f32_fp8(ybq, false), b1 = __builtin_amdgcn_cvt_pk_f32_fp8(ybq, true);
                            v[rr][j][4 * q + 0] = BF_LO(xa) + w0[rr] * a0.x + w1[rr] * b0.x;
                            v[rr][j][4 * q + 1] = BF_HI(xa) + w0[rr] * a0.y + w1[rr] * b0.y;
                            v[rr][j][4 * q + 2] = BF_LO(xc) + w0[rr] * a1.x + w1[rr] * b1.x;
                            v[rr][j][4 * q + 3] = BF_HI(xc) + w0[rr] * a1.y + w1[rr] * b1.y; } }
            }
            if (MODE == 2) {
#pragma unroll
                for (int rr = 0; rr < 4; ++rr) { f32x4* xo = (f32x4*)(xout + (size_t)(m0 + rr) * DM + 8 * lane);
#pragma unroll
                    for (int j = 0; j < 2; ++j) { xo[128 * j] = (f32x4){v[rr][j][0], v[rr][j][1], v[rr][j][2], v[rr][j][3]}; xo[128 * j + 1] = (f32x4){v[rr][j][4], v[rr][j][5], v[rr][j][6], v[rr][j][7]}; } }
            } else {
#pragma unroll
                for (int rr = 0; rr < 4; ++rr) {
                    float ss = 0.f;
                    bf16_t* o8 = xb + (size_t)(m0 + rr) * DM + 8 * lane;
#pragma unroll
                    for (int j = 0; j < 2; ++j) {
#pragma unroll
                        for (int i = 0; i < 8; i += 2) ss += v[rr][j][i] * v[rr][j][i] + v[rr][j][i + 1] * v[rr][j][i + 1];
                        u32x4 w; w.x = cvtpk(v[rr][j][0], v[rr][j][1]); w.y = cvtpk(v[rr][j][2], v[rr][j][3]); w.z = cvtpk(v[rr][j][4], v[rr][j][5]); w.w = cvtpk(v[rr][j][6], v[rr][j][7]);
                        *(u32x4*)(o8 + 512 * j) = w;
                        if (MODE == 1 && x8) {
                            int lo = cvt8(v[rr][j][0] * X8_SCALE, v[rr][j][1] * X8_SCALE, 0, false); lo = cvt8(v[rr][j][2] * X8_SCALE, v[rr][j][3] * X8_SCALE, lo, true);
                            int h8 = cvt8(v[rr][j][4] * X8_SCALE, v[rr][j][5] * X8_SCALE, 0, false); h8 = cvt8(v[rr][j][6] * X8_SCALE, v[rr][j][7] * X8_SCALE, h8, true);
                            *(u32x2*)(x8 + (size_t)(m0 + rr) * DM + 512 * j + ypos) = (u32x2){(unsigned)lo, (unsigned)h8}; } }
                    ss = wave_sum(ss);
                    if (lane == 0) rstd[m0 + rr] = __builtin_amdgcn_rsqf(ss * (1.f / DM) + EPS);
                }
            }
        }
        if (MODE != 0) __syncthreads();
    }
}

__device__ __forceinline__ void router_pass(const bf16_t* x, const bf16_t* wt, const float* wg  , const float* bg, const float* be,
                                            float* rstd_out, int* tok_e, float* tok_w, int* cnt, LAS unsigned char* lds) {
    const int tid = opaque_tid(), lane = tid & 63, wid = tid >> 6, r32 = lane & 31, hi = lane >> 5;
    LAS f32x4* wgl = (LAS f32x4*)lds;
    LAS int* cntl = (LAS int*)(lds + 16384);
    for (int i = tid; i < 1024; i += NTHREADS) wgl[i] = *(const f32x4*)(wg + 4 * i);
    for (int blk = blockIdx.x; blk < NTOK / 256; blk += gridDim.x) {
        if (tid < NEXP) cntl[tid] = 0;
        __syncthreads();
        const int tok = blk * 256 + wid * 32 + r32;
        const u32x4* xp = (const u32x4*)(x + (size_t)tok * DM + 8 * hi);
        const u32x4* wph = (const u32x4*)wt + lane; const u32x4* wpl = wph + 64 * 64;
        const LAS f32x4* gp_ = wgl + 8 * hi;
        f32x16 D;
#pragma unroll
        for (int r = 0; r < 16; ++r) D[r] = 0.f;
        float ss = 0.f; f32x4 gl = {0.f, 0.f, 0.f, 0.f};
#pragma unroll 4
        for (int s = 0; s < 64; ++s) {
            const u32x4 xq_ = xp[2 * s], wh = wph[64 * s], wl = wpl[64 * s];
            D = __builtin_amdgcn_mfma_f32_32x32x16_bf16(__builtin_bit_cast(bf16x8, wh), __builtin_bit_cast(bf16x8, xq_), D, 0, 0, 0);
            D = __builtin_amdgcn_mfma_f32_32x32x16_bf16(__builtin_bit_cast(bf16x8, wl), __builtin_bit_cast(bf16x8, xq_), D, 0, 0, 0);
            const float xa[8] = {BF_LO(xq_.x), BF_HI(xq_.x), BF_LO(xq_.y), BF_HI(xq_.y), BF_LO(xq_.z), BF_HI(xq_.z), BF_LO(xq_.w), BF_HI(xq_.w)};
#pragma unroll
            for (int j = 0; j < 8; ++j) { gl += gp_[16 * s + j] * xa[j]; ss += xa[j] * xa[j]; }
        }
        ss += __shfl_xor(ss, 32);
#pragma unroll
        for (int g = 0; g < 4; ++g) gl[g] += __shfl_xor(gl[g], 32);
        const float rs = __builtin_amdgcn_rsqf(ss * (1.f / DM) + EPS);
        float glg[4]; float gmax = -INFINITY; int gidx = 0;
#pragma unroll
        for (int g = 0; g < 4; ++g) { glg[g] = gl[g] * rs + bg[g]; if (glg[g] > gmax) { gmax = glg[g]; gidx = g; } }
        float gsum = 0.f;
#pragma unroll
        for (int g = 0; g < 4; ++g) gsum += __expf(glg[g] - gmax);
        const float gprob = 1.f / gsum;
        float own[4], oth[4], v[8];
#pragma unroll
        for (int i = 0; i < 4; ++i) { const float d = gidx == 0 ? D[i] : gidx == 1 ? D[4 + i] : gidx == 2 ? D[8 + i] : D[12 + i];
            own[i] = d * rs + be[8 * gidx + 4 * hi + i]; oth[i] = __shfl_xor(own[i], 32); }
#pragma unroll
        for (int i = 0; i < 4; ++i) { v[i] = hi ? oth[i] : own[i]; v[4 + i] = hi ? own[i] : oth[i]; }
        int i1 = 0; float v1 = v[0];
#pragma unroll
        for (int i = 1; i < 8; ++i) if (v[i] > v1) { v1 = v[i]; i1 = i; }
        int i2 = -1; float v2 = -INFINITY;
#pragma unroll
        for (int i = 0; i < 8; ++i) if (i != i1 && v[i] > v2) { v2 = v[i]; i2 = i; }
        const float w1 = gprob / (1.f + __expf(v2 - v1)), w2 = gprob - w1;
        if (hi == 0) {
            const int e1 = 8 * gidx + i1, e2 = 8 * gidx + i2;
            tok_e[2 * tok] = e1; tok_e[2 * tok + 1] = e2; tok_w[2 * tok] = w1; tok_w[2 * tok + 1] = w2; rstd_out[tok] = rs;
            atomicAdd((int*)&cntl[e1], 1); atomicAdd((int*)&cntl[e2], 1);
        }
        __syncthreads();
        if (tid < NEXP) cnt[blk * NEXP + tid] = cntl[tid];
        __syncthreads();
    }
}

__device__ __forceinline__ void assign_pass(const int* cnt, const int* tok_e, const float* rstd_ffn, int* tok_slot, int* slot_tok, float* slot_rs, LAS unsigned char* lds) {
    const int tid = opaque_tid(), lane = tid & 63, wid = tid >> 6;
    LAS int* pall = (LAS int*)lds;
    LAS int* plt = pall + 512;
    LAS int* total = plt + 512;
    LAS int* mybase = total + 32;
    LAS int* wcnt = mybase + 32;
    LAS int* ts = (LAS int*)(lds + TS_OFF);
    { const int e = tid & 31, p = tid >> 5; int a = 0;
      for (int b = 16 * p; b < 16 * p + 16; ++b) a += cnt[b * NEXP + e];
      pall[p * 32 + e] = a; }
    __syncthreads();
    if (tid < NEXP) { int a = 0; for (int p = 0; p < 16; ++p) a += pall[p * 32 + tid]; total[tid] = a; }
    __syncthreads();
    if (tid == 0) { int acc = 0; for (int e = 0; e < NEXP; ++e) { ts[e] = acc; acc += (total[e] + 255) >> 8; } ts[NEXP] = acc; }
    __syncthreads();
    for (int blk = blockIdx.x; blk < NTOK / 256; blk += gridDim.x) {
        { const int e = tid & 31, p = tid >> 5; int l = 0;
          for (int b = 16 * p; b < 16 * p + 16; ++b) { const int c = cnt[b * NEXP + e]; if (b < blk) l += c; }
          plt[p * 32 + e] = l; }
        int e0 = -1, e1 = -1, r0 = 0, r1 = 0; float rs = 0.f;
        if (tid < 256) { const int tok = blk * 256 + tid; e0 = tok_e[2 * tok]; e1 = tok_e[2 * tok + 1]; rs = rstd_ffn[tok]; }
        if (wid < 4) {
            const unsigned long long lt = (1ull << lane) - 1ull;
#pragma unroll 4
            for (int e = 0; e < NEXP; ++e) {
                const unsigned long long m = __ballot(e0 == e || e1 == e);
                const int r = __popcll(m & lt);
                if (e0 == e) r0 = r;
                if (e1 == e) r1 = r;
                if (lane == 0) wcnt[e * 4 + wid] = __popcll(m);
            }
        }
        __syncthreads();
        if (tid < NEXP) { int l = 0; for (int p = 0; p < 16; ++p) l += plt[p * 32 + tid]; mybase[tid] = l; }
        __syncthreads();
        if (tid < 256) {
            const int tok = blk * 256 + tid;
            int p0 = ts[e0] * 256 + mybase[e0] + r0, p1 = ts[e1] * 256 + mybase[e1] + r1;
            for (int w = 0; w < wid; ++w) { p0 += wcnt[e0 * 4 + w]; p1 += wcnt[e1 * 4 + w]; }
            tok_slot[2 * tok] = p0; tok_slot[2 * tok + 1] = p1;
            slot_tok[p0] = tok; slot_tok[p1] = tok; slot_rs[p0] = rs; slot_rs[p1] = rs;
        }
        if (blk == 0) {
            for (int e = 0; e < NEXP; ++e) for (int p = ts[e] * 256 + total[e] + tid; p < ts[e + 1] * 256; p += NTHREADS) { slot_tok[p] = 0; slot_rs[p] = 0.f; }
        }
        __syncthreads();
    }
}

__device__ __forceinline__ void pool_pass(const bf16_t* U, unsigned char* Pq) {
    const int tid = opaque_tid(), lane = tid & 63, wid = tid >> 6;
    for (int task = blockIdx.x * NWAVES + wid; task < (NTOK / 64) * 2; task += gridDim.x * NWAVES) {
        const int rb = task >> 1, half = task & 1, T0 = rb * 64, col = half * 512 + lane * 8, w = 2 << (half * 2 + (lane >> 5)), tp0 = T0 & (SEQ - 1);
        float S[8];
#pragma unroll
        for (int k = 0; k < 8; ++k) S[k] = 0.f;
#define PL_LD(dst, row) do { const u32x4 q_ = *(const u32x4*)(U + (size_t)(row) * DM + col); \
        dst[0] = __builtin_bit_cast(float, q_.x << 16); dst[1] = __builtin_bit_cast(float, q_.x & 0xffff0000u); dst[2] = __builtin_bit_cast(float, q_.y << 16); dst[3] = __builtin_bit_cast(float, q_.y & 0xffff0000u); \
        dst[4] = __builtin_bit_cast(float, q_.z << 16); dst[5] = __builtin_bit_cast(float, q_.z & 0xffff0000u); dst[6] = __builtin_bit_cast(float, q_.w << 16); dst[7] = __builtin_bit_cast(float, q_.w & 0xffff0000u); } while (0)
        for (int jj = 1; jj < 16; ++jj) if (jj < w && tp0 - jj >= 0) { float a[8]; PL_LD(a, T0 - jj);
#pragma unroll
            for (int k = 0; k < 8; ++k) S[k] += a[k]; }
#define PL_UNP(dst, q_) do { dst[0] = __builtin_bit_cast(float, q_.x << 16); dst[1] = __builtin_bit_cast(float, q_.x & 0xffff0000u); dst[2] = __builtin_bit_cast(float, q_.y << 16); dst[3] = __builtin_bit_cast(float, q_.y & 0xffff0000u); \
        dst[4] = __builtin_bit_cast(float, q_.z << 16); dst[5] = __builtin_bit_cast(float, q_.z & 0xffff0000u); dst[6] = __builtin_bit_cast(float, q_.w << 16); dst[7] = __builtin_bit_cast(float, q_.w & 0xffff0000u); } while (0)
        for (int i0 = 0; i0 < 64; i0 += 8) {
            u32x4 cq[8], aq[8];
#pragma unroll
            for (int i = 0; i < 8; ++i) { const int t = T0 + i0 + i, tp = tp0 + i0 + i;
                cq[i] = *(const u32x4*)(U + (size_t)t * DM + col);
                aq[i] = (tp - (w - 1) >= 0) ? *(const u32x4*)(U + (size_t)(t - (w - 1)) * DM + col) : (u32x4){0u, 0u, 0u, 0u}; }
#pragma unroll
            for (int i = 0; i < 8; ++i) { const int t = T0 + i0 + i, tp = tp0 + i0 + i; float c[8], a[8]; PL_UNP(c, cq[i]); PL_UNP(a, aq[i]);
                const int n = tp + 1 < w ? tp + 1 : w; const float inv = 1.f / (float)n;
                float o[8];
#pragma unroll
                for (int k = 0; k < 8; ++k) { S[k] += c[k]; o[k] = S[k] * inv - c[k]; S[k] -= a[k]; }
                int lo = cvt8(o[0] * A8_SCALE, o[1] * A8_SCALE, 0, false); lo = cvt8(o[2] * A8_SCALE, o[3] * A8_SCALE, lo, true);
                int hi = cvt8(o[4] * A8_SCALE, o[5] * A8_SCALE, 0, false); hi = cvt8(o[6] * A8_SCALE, o[7] * A8_SCALE, hi, true);
                *(u32x2*)(Pq + (size_t)t * DM + col) = (u32x2){(unsigned)lo, (unsigned)hi}; }
        }
#undef PL_UNP
#undef PL_LD
    }
}

constexpr int ARG_OFF = attn::WSF_OFF + NWAVES * 256;
static_assert(ARG_OFF + 27 * 8 <= LDS_BYTES, "LDS map (args)");
__device__ __forceinline__ const void* arg_ptr(LAS unsigned char* lds, int i) {
    const unsigned long long v = ((const LAS unsigned long long*)(lds + ARG_OFF))[i];
    const unsigned lo = __builtin_amdgcn_readfirstlane((unsigned)v), hi = __builtin_amdgcn_readfirstlane((unsigned)(v >> 32));
    return (const void*)(const __attribute__((address_space(1))) char*)(((unsigned long long)hi << 32) | lo);
}
#define INP(i) ((const float*)arg_ptr(lds, (i)))
#define OUTP() ((float*)arg_ptr(lds, 25))
#define WSP() ((unsigned char*)arg_ptr(lds, 26))


__device__ __forceinline__ size_t wt_image_off(int n, int k, int Kd) {
    const int pn = n >> 8, nr = n & 255, wc = nr >> 6, bj = (nr >> 5) & 1, x = nr & 31, rho = 16 * ((x >> 2) & 1) + 4 * (x >> 3) + (x & 3);
    const int kt = k >> 6, kk = k & 63;
    return ((size_t)((pn * (Kd >> 6) + kt) * 2 + bj) * 16384 + pg8::lds_byte(wc * 32 + rho, kk)) >> 1;
}
__device__ __forceinline__ size_t wt_image_off8(int n, int k, int Kd) {
    const int pn = n >> 8, nr = n & 255, wc = nr >> 6, bj = (nr >> 5) & 1, x = nr & 31, rho = 16 * ((x >> 2) & 1) + 4 * (x >> 3) + (x & 3);
    const int kt = k >> 7, kb = k & 127;
    return (size_t)((pn * (Kd >> 7) + kt) * 2 + bj) * 16384 + pg8::lds_byte(wc * 32 + rho, kb >> 1);
}
struct TrDesc { const float* W; const float* gain; bf16_t* WT; int N, k0, n0, Kd, drow0; int f8; float f8s; };
__device__ __forceinline__ void tr_load(const TrDesc& d, f32x4 (&v)[8], float (&g)[8], int lane) {
    const int kr = lane >> 3, n4 = (lane & 7) * 4;
#pragma unroll
    for (int i = 0; i < 8; ++i) { v[i] = *(const f32x4*)(d.W + (size_t)(d.k0 + 8 * i + kr) * d.N + d.n0 + n4); g[i] = d.gain ? d.gain[d.k0 + 8 * i + kr] : 1.f; }
}
__device__ __forceinline__ void tr_finish(const TrDesc& d, const f32x4 (&v)[8], const float (&g)[8], LAS float* scr, int lane) {
    const int kr = lane >> 3, n4 = (lane & 7) * 4;
#pragma unroll
    for (int i = 0; i < 8; ++i) { LAS float* q = scr + (8 * i + kr) * 33 + n4; q[0] = v[i][0] * g[i]; q[1] = v[i][1] * g[i]; q[2] = v[i][2] * g[i]; q[3] = v[i][3] * g[i]; }
    asm volatile("s_waitcnt lgkmcnt(0)" ::: "memory");
    if (d.f8) {
#pragma unroll
        for (int j = 0; j < 2; ++j) { const int pc = lane * 2 + j, n = pc >> 2, kg = pc & 3; const float fs = d.f8s;
            u32x4 o;
#pragma unroll
            for (int q = 0; q < 4; ++q) { const int kb = d.f8 == 2 ? (q >> 1) * 32 + 8 * kg + 4 * (q & 1) : 16 * kg + 4 * q; const LAS float* t = scr + kb * 33 + n;
                int r = cvt8(t[0] * fs, t[33] * fs, 0, false);
                r = cvt8(t[66] * fs, t[99] * fs, r, true); o[q] = (unsigned)r; }
            *(u32x4*)((unsigned char*)d.WT + wt_image_off8(d.drow0 + n, d.k0 + 16 * kg, d.Kd)) = o; }
        asm volatile("s_waitcnt lgkmcnt(0)" ::: "memory");
        return;
    }
    const int c = lane & 7;
#pragma unroll
    for (int j = 0; j < 4; ++j) { const int n = (lane >> 3) + 8 * j; const LAS float* t = scr + (8 * c) * 33 + n;
        u32x4 o; o.x = cvtpk(t[0 * 33], t[1 * 33]); o.y = cvtpk(t[2 * 33], t[3 * 33]); o.z = cvtpk(t[4 * 33], t[5 * 33]); o.w = cvtpk(t[6 * 33], t[7 * 33]);
        *(u32x4*)(d.WT + wt_image_off(d.drow0 + n, d.k0 + 8 * c, d.Kd)) = o; }
    asm volatile("s_waitcnt lgkmcnt(0)" ::: "memory");
}
struct Args { const float* in[25]; float* out; unsigned char* ws; };
enum { I_X = 0, I_RELB, I_ANORM, I_WQKV, I_QG, I_KG, I_LQ1, I_LK1, I_LQ2, I_LK2, I_SUBLN, I_WO, I_PNORM, I_PWIN, I_PWG, I_PWOUT, I_PSCALE, I_FNORM, I_RGW, I_RGB, I_REW, I_REB, I_WGATE, I_WUP, I_WDOWN };

__device__ __forceinline__ TrDesc tr_decode(LAS unsigned char* lds, unsigned char* ws, int it) {
    constexpr int N_QKV = 2 * 16 * 96;
    TrDesc d; d.f8 = 0; d.f8s = 1.f;
    if (it < N_QKV) { const int l = it / 1536, r = it - l * 1536, kb = r / 96, nb = r - kb * 96;
        d.W = INP(I_WQKV) + (size_t)l * 1024 * 3072; d.N = 3072; d.k0 = 64 * kb; d.n0 = 32 * nb; d.WT = (bf16_t*)(ws + WS_WQKV) + (size_t)l * 3072 * 1024; d.Kd = 1024; d.drow0 = 32 * nb; d.gain = INP(I_ANORM) + l * 1024; return d; }
    it -= N_QKV;
    { const int l = it >> 9, r = it & 511, kb = r >> 5, nb = r & 31;
      d.W = INP(I_WO) + (size_t)l * 1024 * 1024; d.N = 1024; d.k0 = 64 * kb; d.n0 = 32 * nb; d.WT = (bf16_t*)(ws + WS_WO) + (size_t)l * 1024 * 1024; d.Kd = 1024; d.drow0 = 32 * nb; d.gain = nullptr; }
    return d;
}
__device__ __forceinline__ void w8_load(LAS unsigned char* lds, int S0, int lane, int wid, W8Item& d, f32x4 (&v)[16], float (&g)[16]) {
    constexpr int S_GU = W8_SGU, S_DN = W8_SDN;
    unsigned char* ws = WSP();
    const int S = __builtin_amdgcn_readfirstlane(S0);
    const float* gain; bool perm;
    if (S < S_GU) { const int le = S >> 5, r = S & 31, isup = r >> 4, kt = (r >> 1) & 7, nh = r & 1;
        d.W = (isup ? INP(I_WUP) : INP(I_WGATE)) + (size_t)le * 1024 * 512; d.N = 512; d.k0 = 128 * kt; d.n = 256 * nh + 4 * lane; d.WT = ws + WS_WGU + (size_t)le * 1024 * 1024; d.Kd = 1024;
        d.drow = 256 * (d.n >> 7) + 64 * ((d.n >> 5) & 3) + 32 * isup + (d.n & 31); gain = INP(I_FNORM) + (le >> 5) * 1024; perm = true; d.fs = WG8_SCALE; }
    else if (S < S_GU + S_DN) { const int i2 = S - S_GU, le = i2 >> 4, r = i2 & 15, kt = r >> 2, nq = r & 3;
        d.W = INP(I_WDOWN) + (size_t)le * 512 * 1024; d.N = 1024; d.k0 = 128 * kt; d.n = 256 * nq + 4 * lane; d.WT = ws + WS_WDN + (size_t)le * 1024 * 512; d.Kd = 512; d.drow = d.n; gain = nullptr; perm = false; d.fs = WD8_SCALE; }
    else { const int i3 = S - S_GU - S_DN, l = i3 >> 5, r = i3 & 31, kt = r >> 2, nq = r & 3;
        d.W = INP(I_PWOUT) + (size_t)l * 1024 * 1024; d.N = 1024; d.k0 = 128 * kt; d.n = 256 * nq + 4 * lane; d.WT = ws + WS_WPO + (size_t)l * 1024 * 1024; d.Kd = 1024; d.drow = d.n; gain = nullptr; perm = false; d.fs = WN8_SCALE; }
    d.r0 = perm ? 64 * (wid >> 2) + 8 * (wid & 3) : 16 * wid; d.r1 = perm ? d.r0 + 32 : d.r0 + 8;
    d.hasg = gain ? 1 : 0;
    d.gp = gain ? gain : d.W;
#pragma unroll
    for (int j = 0; j < 8; ++j) { v[j] = *(const f32x4*)(d.W + (size_t)(d.k0 + d.r0 + j) * d.N + d.n); v[8 + j] = *(const f32x4*)(d.W + (size_t)(d.k0 + d.r1 + j) * d.N + d.n);
        g[j] = d.gp[d.k0 + d.r0 + j]; g[8 + j] = d.gp[d.k0 + d.r1 + j]; }
}
__device__ __forceinline__ void w8_finish(const W8Item& d, const f32x4 (&v)[16], float (&g)[16], int wid, bool dostore) {
#pragma unroll
    for (int j = 0; j < 16; ++j) g[j] = d.hasg ? g[j] * d.fs : d.fs;
    u32x4 o[4];
#pragma unroll
    for (int c = 0; c < 4; ++c) {
#pragma unroll
        for (int q = 0; q < 4; ++q) { int r = cvt8(v[4 * q][c] * g[4 * q], v[4 * q + 1][c] * g[4 * q + 1], 0, false); r = cvt8(v[4 * q + 2][c] * g[4 * q + 2], v[4 * q + 3][c] * g[4 * q + 3], r, true); o[c][q] = (unsigned)r; }
    }
    asm volatile("" : "+v"(o[0]), "+v"(o[1]), "+v"(o[2]), "+v"(o[3]));
    if (dostore) {
#pragma unroll
        for (int c = 0; c < 4; ++c) *(u32x4*)(d.WT + wt_image_off8(d.drow + c, d.k0 + 16 * wid, d.Kd)) = o[c];
    }
}
__device__ __forceinline__ void w8_items(LAS unsigned char* lds, int lane, int wid) {
    const bool defer = gridDim.x == 256;
    const int NP = defer ? W8_PER_LAYER + W8_EARLY1 + W8_SPO : W8_SGU + W8_SDN + W8_SPO;
    for (int p = blockIdx.x; p < NP; p += gridDim.x) {
        const int S = !defer ? p : p < 1024 ? p : p < W8_PER_LAYER ? W8_SGU + (p - 1024) : p < W8_PER_LAYER + W8_EARLY1 ? 1024 + (p - W8_PER_LAYER) : W8_SGU + W8_SDN + (p - W8_PER_LAYER - W8_EARLY1);
        W8Item d; f32x4 v[16]; float g[16];
        w8_load(lds, S, lane, wid, d, v, g);
        w8_finish(d, v, g, wid);
    }
}
__device__ __forceinline__ void prologue(LAS unsigned char* lds) {
    const int tid = opaque_tid(), lane = tid & 63, wid = tid >> 6;
    LAS float* scr = (LAS float*)(lds + wid * 16384);
    const int gw = blockIdx.x * NWAVES + wid, NGW = gridDim.x * NWAVES;
    unsigned char* ws = WSP();
    constexpr int N_QKV = 2 * 16 * 96, N_WO = 2 * 16 * 32, N_PC = 2 * 64 * 16;
    constexpr int NTR = N_QKV + N_WO;
    w8_items(lds, lane, __builtin_amdgcn_readfirstlane(wid));
    if (gw < NTR) {
        TrDesc dA = tr_decode(lds, ws, gw), dB; f32x4 va[8], vb[8]; float ga[8], gb[8];
        tr_load(dA, va, ga, lane);
        for (int itA = gw;;) {
            const int itB = itA + NGW; const bool hasB = itB < NTR;
            if (hasB) { dB = tr_decode(lds, ws, itB); tr_load(dB, vb, gb, lane); }
            tr_finish(dA, va, ga, scr, lane);
            if (!hasB) break;
            itA = itB + NGW; const bool hasA = itA < NTR;
            if (hasA) { dA = tr_decode(lds, ws, itA); tr_load(dA, va, ga, lane); }
            tr_finish(dB, vb, gb, scr, lane);
            if (!hasA) break;
        }
    }
    for (int it = gw; it < N_PC; it += NGW) {
        {
            const int l = it >> 10, r = it & 1023, kt = r >> 7, p = (r >> 4) & 7, kb0 = 128 * kt + 64 * (p >> 2) + 8 * (p & 3), n0 = (r & 15) * 64, g = n0 >> 8, e = (n0 & 255) + lane;
            const float* win = INP(I_PWIN) + (size_t)l * 1024 * 1024 + g * 256;
            const float* wgp = INP(I_PWG) + (size_t)l * 4 * 256 * 256 + (size_t)g * 256 * 256 + e;
            float acc[16];
#pragma unroll
            for (int kk = 0; kk < 16; ++kk) acc[kk] = 0.f;
            {
                f32x4 wv[16];
#pragma unroll
                for (int kk = 0; kk < 16; ++kk) wv[kk] = *(const f32x4*)(win + (size_t)(kb0 + (kk & 7) + 32 * (kk >> 3)) * 1024 + 4 * lane);
#pragma unroll
                for (int kk = 0; kk < 16; ++kk) *(LAS f32x4*)(scr + kk * 256 + 4 * lane) = wv[kk];
                asm volatile("s_waitcnt lgkmcnt(0)" ::: "memory"); }
#pragma unroll 8
            for (int c4 = 0; c4 < 64; ++c4) {
                float b[4];
#pragma unroll
                for (int cc = 0; cc < 4; ++cc) b[cc] = wgp[(size_t)(4 * c4 + cc) * 256];
#pragma unroll
                for (int kk = 0; kk < 16; ++kk) { const f32x4 av = *(const LAS f32x4*)(scr + kk * 256 + 4 * c4); acc[kk] += (av[0] * b[0] + av[1] * b[1]) + (av[2] * b[2] + av[3] * b[3]); }
            }
            const float* pn = INP(I_PNORM) + l * 1024 + kb0;
            u32x4 o;
#pragma unroll
            for (int q = 0; q < 4; ++q) { const int j0 = 4 * q, kq = (j0 & 7) + 32 * (j0 >> 3);
                int rr = cvt8(acc[j0] * pn[kq] * WPC8_SCALE, acc[j0 + 1] * pn[kq + 1] * WPC8_SCALE, 0, false);
                rr = cvt8(acc[j0 + 2] * pn[kq + 2] * WPC8_SCALE, acc[j0 + 3] * pn[kq + 3] * WPC8_SCALE, rr, true); o[q] = (unsigned)rr; }
            *(u32x4*)(ws + WS_WPC + (size_t)l * 1024 * 1024 + wt_image_off8(n0 + lane, 128 * kt + 16 * p, 1024)) = o;
            asm volatile("s_waitcnt lgkmcnt(0)" ::: "memory");
        }
    }
    float* rwt = (float*)(ws + WS_RWT); float* rwg = (float*)(ws + WS_RWG);
    { bf16_t* rwb = (bf16_t*)rwt;
      for (int i = blockIdx.x * NTHREADS + tid; i < DEPTH * NEXP * DM; i += gridDim.x * NTHREADS) { const int l = i >> 15, r = i & 32767, sx = r >> 9, ln = (r >> 3) & 63, jj = r & 7, k = 16 * sx + 8 * (ln >> 5) + jj, e = ln & 31;
        const float v = INP(I_FNORM)[l * 1024 + k] * INP(I_REW)[(size_t)l * 1024 * 32 + k * 32 + e];
        const unsigned hb = cvtpk(v, 0.f) & 0xffffu; const float vh = __builtin_bit_cast(float, hb << 16);
        rwb[(size_t)l * 65536 + r] = (bf16_t)hb; rwb[(size_t)l * 65536 + 32768 + r] = (bf16_t)(cvtpk(v - vh, 0.f) & 0xffffu); } }
    for (int i = blockIdx.x * NTHREADS + tid; i < DEPTH * DM * NGRP; i += gridDim.x * NTHREADS) { const int l = i >> 12, k = (i >> 2) & 1023;
        rwg[i] = INP(I_FNORM)[l * 1024 + k] * INP(I_RGW)[i]; }
}

__device__ __forceinline__ void moe_layer(LAS unsigned char* lds, const XcdBarrier& bar, const int L, const bool fin) {
    const LAS int* ts = (const LAS int*)(lds + TS_OFF);
    {   unsigned char* ws = WSP();
        router_pass((const bf16_t*)(ws + WS_XB), (const bf16_t*)(ws + WS_RWT) + (size_t)L * 65536, (const float*)(ws + WS_RWG) + (size_t)L * DM * NGRP, INP(I_RGB) + L * NGRP, INP(I_REB) + L * NEXP,
                    (float*)(ws + WS_RSFFN), (int*)(ws + WS_TOKE), (float*)(ws + WS_TOKW), (int*)(ws + WS_CNT), lds); }
    xcd_barrier(bar);
    {   unsigned char* ws = WSP();
        assign_pass((const int*)(ws + WS_CNT), (const int*)(ws + WS_TOKE), (const float*)(ws + WS_RSFFN), (int*)(ws + WS_TOKS), (int*)(ws + WS_SLOTTOK), (float*)(ws + WS_SLOTRS), lds); }
    xcd_barrier(bar);
    {   unsigned char* ws = WSP();
        GroupSched S; S.init_grid(); S.A = (const char*)(ws + WS_ACT + ACT_X8); S.lda = DM; S.slot_tok = (const int*)(ws + WS_SLOTTOK); S.Bt = (const char*)(ws + WS_WGU) + (size_t)L * NEXP * 1024 * 1024; S.strideE = (size_t)1024 * 1024; S.K = DM / 2; S.ts = ts;
        EpiGateUp E{ws + WS_ACT + ACT_H, (const float*)(ws + WS_SLOTRS)};
        int kx = DM; asm volatile("" : "+s"(kx));
        pg8::gemm_phase<EpiGateUp, GroupSched, true, true>(lds, kx, S, E); }
    xcd_barrier(bar);
    {   unsigned char* ws = WSP();
        GroupSched S; S.init_grid(); S.A = (const char*)(ws + WS_ACT + ACT_H); S.lda = EFF; S.slot_tok = nullptr; S.Bt = (const char*)(ws + WS_WDN) + (size_t)L * NEXP * 1024 * 512; S.strideE = (size_t)1024 * 512; S.K = EFF / 2; S.ts = ts;
        EpiY8 E{ws + WS_ACT + ACT_Y};
        int kx = EFF; asm volatile("" : "+s"(kx));
        pg8::gemm_phase<EpiY8, GroupSched, true, true>(lds, kx, S, E); }
    xcd_barrier(bar);
    {   unsigned char* ws = WSP(); float* xo = OUTP();
        if (fin) row_pass<2>(nullptr, xo, (bf16_t*)(ws + WS_XB), nullptr, (const unsigned char*)(ws + WS_ACT + ACT_Y), (const int*)(ws + WS_TOKS), (const float*)(ws + WS_TOKW), nullptr, lds);
        else { row_pass<1>(nullptr, nullptr, (bf16_t*)(ws + WS_XB), (float*)(ws + WS_RSMIX), (const unsigned char*)(ws + WS_ACT + ACT_Y), (const int*)(ws + WS_TOKS), (const float*)(ws + WS_TOKW), (L & 1) ? nullptr : ws + WS_ACT + ACT_X8, lds); } }
    if (!fin) xcd_barrier(bar);
}

__global__ void __launch_bounds__(NTHREADS, 2) hybrid_fwd(Args a) {
    extern __shared__ __attribute__((aligned(16))) unsigned char lds_raw[];
    LAS unsigned char* lds = (LAS unsigned char*)lds_raw;
    volatile LAS unsigned* MISC = (volatile LAS unsigned*)(lds + MISC_OFF);
    const int tid = threadIdx.x;
    if (tid < 64) MISC[tid] = 0u;
    if (tid < 27) ((LAS unsigned long long*)(lds + ARG_OFF))[tid] = ((const __attribute__((address_space(4))) unsigned long long*)__builtin_amdgcn_kernarg_segment_ptr())[tid];
    __syncthreads();
    XcdBarrier bar = xcd_barrier_post((unsigned*)(a.ws + WS_CTL) + CW_BAR, MISC + 8);

    prologue(lds);
    {   unsigned char* ws = WSP();
        row_pass<0>(INP(I_X), nullptr, (bf16_t*)(ws + WS_XB), (float*)(ws + WS_RSMIX), nullptr, nullptr, nullptr, nullptr, lds); }
    xcd_barrier(bar);

    for (int lp = 0; lp < 2; ++lp) {
        {   unsigned char* ws = WSP();
            PlainSched S; S.init_grid(); S.A = (const char*)(ws + WS_XB); S.lda = DM * 2; S.Bt = (const char*)(ws + WS_WQKV) + (size_t)lp * 3072 * 1024 * 2; S.K = DM; S.nN = 12; S.nrt = NTOK / 256;
            LAS float* gl = (LAS float*)(lds + attn::WSF_OFF);
            { const int t_ = opaque_tid(); if (t_ < 128) gl[t_] = t_ < 64 ? INP(I_QG)[lp * HD + t_] : INP(I_KG)[lp * HD + t_ - 64]; }
            __syncthreads();
            EpiQKV E{(bf16_t*)(ws + WS_ACT + ACT_Q), (const float*)(ws + WS_RSMIX), gl};
            pg8::gemm_phase<EpiQKV, PlainSched, true>(lds, DM, S, E); }
        xcd_barrier(bar);
        {   unsigned char* ws = WSP();
            const float* lq1 = INP(I_LQ1) + lp * HD; const float* lk1 = INP(I_LK1) + lp * HD; const float* lq2 = INP(I_LQ2) + lp * HD; const float* lk2 = INP(I_LK2) + lp * HD;
            float d1 = 0.f, d2 = 0.f;
            for (int i = 0; i < HD; ++i) { d1 += lq1[i] * lk1[i]; d2 += lq2[i] * lk2[i]; }
            const float li = 0.8f - 0.6f * expf(-0.3f * (float)(2 * lp));
            bf16_t* Qb = (bf16_t*)(ws + WS_ACT + ACT_Q);
            attn::Params P{Qb, Qb + (size_t)NTOK * DM, Qb + (size_t)2 * NTOK * DM, Qb, INP(I_RELB), INP(I_SUBLN) + lp * 128, expf(d1) - expf(d2) + li, 1.f - li, lp == 0 ? 0 : 2048, 2048};
            attn::attn_phase(P, lds); }
        xcd_barrier(bar);
        {   unsigned char* ws = WSP(); float* xo = OUTP();
            PlainSched S; S.init_grid(); S.A = (const char*)(ws + WS_ACT + ACT_Q); S.lda = DM * 2; S.Bt = (const char*)(ws + WS_WO) + (size_t)lp * 1024 * 1024 * 2; S.K = DM; S.nN = 4; S.nrt = NTOK / 256;
            EpiRes E{(bf16_t*)(ws + WS_XB), nullptr, ws + WS_ACT + ACT_X8, 1.f};
            pg8::gemm_phase<EpiRes, PlainSched, true>(lds, DM, S, E); }
        xcd_barrier(bar);
        moe_layer(lds, bar, 2 * lp, false);
        {   unsigned char* ws = WSP();
            PlainSched S; S.init_grid(); S.A = (const char*)(ws + WS_ACT + ACT_X8); S.lda = DM; S.Bt = (const char*)(ws + WS_WPC) + (size_t)lp * 1024 * 1024; S.K = DM / 2; S.nN = 4; S.nrt = NTOK / 256;
            EpiBf16 E{(bf16_t*)(ws + WS_ACT + ACT_U), DM, (const float*)(ws + WS_RSMIX), 1.f / (X8_SCALE * WPC8_SCALE)};
            int kx = DM; asm volatile("" : "+s"(kx));
            pg8::gemm_phase<EpiBf16, PlainSched, true, true>(lds, kx, S, E); }
        xcd_barrier(bar);
        {   unsigned char* ws = WSP(); pool_pass((const bf16_t*)(ws + WS_ACT + ACT_U), ws + WS_ACT + ACT_P); }
        xcd_barrier(bar);
        {   unsigned char* ws = WSP(); float* xo = OUTP();
            PlainSched S; S.init_grid(); S.A = (const char*)(ws + WS_ACT + ACT_P); S.lda = DM; S.Bt = (const char*)(ws + WS_WPO) + (size_t)lp * 1024 * 1024; S.K = DM / 2; S.nN = 4; S.nrt = NTOK / 256;
            EpiRes E{(bf16_t*)(ws + WS_XB), INP(I_PSCALE) + lp * DM, ws + WS_ACT + ACT_X8, 1.f / (A8_SCALE * WN8_SCALE)};
            int kx = DM; asm volatile("" : "+s"(kx));
            pg8::gemm_phase<EpiRes, PlainSched, true, true>(lds, kx, S, E); }
        xcd_barrier(bar);
        moe_layer(lds, bar, 2 * lp + 1, lp == 1);
    }
}

extern "C" void kernel_launch(void* const* d_in, const int* in_sizes, int n_in, void* d_out, int out_size, void* d_ws, size_t ws_size, hipStream_t stream) {
    static int grid = 0;
    if (grid == 0) {
        if (n_in != 25 || out_size != NTOK * DM || ws_size < WS_END) { fprintf(stderr, "kernel_launch: unexpected problem (n_in %d, out %d, ws %zu)\n", n_in, out_size, ws_size); grid = -1; return; }
        int dev = 0, cus = 0;
        if (hipGetDevice(&dev) != hipSuccess || hipDeviceGetAttribute(&cus, hipDeviceAttributeMultiprocessorCount, dev) != hipSuccess) { grid = -1; return; }
        if (hipFuncSetAttribute((const void*)hybrid_fwd, hipFuncAttributeMaxDynamicSharedMemorySize, LDS_BYTES) != hipSuccess) { fprintf(stderr, "kernel_launch: hipFuncSetAttribute failed\n"); grid = -1; return; }
        int per_cu = 0;
        if (hipOccupancyMaxActiveBlocksPerMultiprocessor(&per_cu, (const void*)hybrid_fwd, NTHREADS, LDS_BYTES) != hipSuccess || per_cu < 1) fprintf(stderr, "kernel_launch: occupancy query says %d\n", per_cu);
        (void)hipGetLastError();
        grid = cus > 256 ? 256 : cus;
    }
    if (grid < 0) return;
    (void)hipMemsetAsync((char*)d_ws + WS_CTL, 0, CTL_ZERO_BYTES, stream);
    Args a{};
    for (int i = 0; i < 25; ++i) a.in[i] = (const float*)d_in[i];
    a.out = (float*)d_out; a.ws = (unsigned char*)d_ws;
    hipLaunchKernelGGL(hybrid_fwd, dim3(grid), dim3(NTHREADS), LDS_BYTES, stream, a);
}
```
